# Optimizing an MI355X kernel written in HIP

```python
import jax, jax.numpy as jnp
from jax import lax
import numpy as np

D_MODEL = 2048
BATCH = 1
SEQ = 16384
DEPTH = 2

MIX_WIDTH = 512
HEAD_DIM = 64
N_BRANCH = 4
POOL_GROUPS = 4
POOL_CH = MIX_WIDTH // POOL_GROUPS
POOL_WINDOWS = (2, 4, 8, 16)
SWA_HEADS = 8
SWA_KV_HEADS = 2
SWA_WINDOW = 128
SWA_BLOCK = 128
ROPE_THETA = 10000.0
MLSTM_HEADS = 4
MLSTM_HEAD_DIM = 128
MLSTM_CHUNK = 64
MLSTM_CONV = 4
FOX_HEADS = 8
FOX_BLOCK = 128
D_FF = 5632
FFN_HALF = 0.5
LN_EPS = 1e-5
DEEPNORM_ALPHA = (2 * DEPTH) ** 0.25
DEEPNORM_BETA = (8 * DEPTH) ** -0.25

SWA_Q = SWA_HEADS * HEAD_DIM
SWA_KV = SWA_KV_HEADS * HEAD_DIM
ML_W = MLSTM_HEADS * MLSTM_HEAD_DIM
FOX_W = FOX_HEADS * HEAD_DIM
IN_SPLITS = (MIX_WIDTH,
             SWA_Q, SWA_KV, SWA_KV,
             ML_W, ML_W, ML_W, ML_W,
             MLSTM_HEADS, MLSTM_HEADS,
             FOX_W, FOX_W, FOX_W, FOX_HEADS)
D_IN = 4880

kernel_name = 'hybrid_pool_swa_mlstm_fox_deepnorm'

F32 = jnp.float32


def layer_norm(x, g, b):
    xf = x.astype(F32)
    mu = jnp.mean(xf, axis=-1, keepdims=True)
    var = jnp.mean(jnp.square(xf - mu), axis=-1, keepdims=True)
    return ((xf - mu) * lax.rsqrt(var + LN_EPS) * g.astype(F32) + b.astype(F32)).astype(x.dtype)


def swiglu(x, w_in, w_out):
    gate, up = jnp.split(x @ w_in, 2, axis=-1)
    return (jax.nn.silu(gate) * up) @ w_out


def split_columns(z):
    parts, off = [], 0
    for size in IN_SPLITS:
        parts.append(z[..., off:off + size])
        off += size
    return parts


def rope(x, pos):
    half = x.shape[-1] // 2
    inv = ROPE_THETA ** (-jnp.arange(half, dtype=F32) / half)
    ang = pos.astype(F32)[:, None] * inv[None, :]
    cos = jnp.cos(ang)[None, :, None, :]
    sin = jnp.sin(ang)[None, :, None, :]
    xf = x.astype(F32)
    x1, x2 = xf[..., :half], xf[..., half:]
    return jnp.concatenate([x1 * cos - x2 * sin, x2 * cos + x1 * sin], axis=-1)


def pool_mixer(u, w_pool, scale):
    B, S, _ = u.shape
    uf = u.astype(F32).reshape(B, S, POOL_GROUPS, POOL_CH)
    cs = jnp.concatenate([jnp.zeros_like(uf[:, :1]), jnp.cumsum(uf, axis=1)], axis=1)
    t1 = jnp.arange(1, S + 1, dtype=jnp.int32)[:, None]
    win = jnp.array(POOL_WINDOWS, dtype=jnp.int32)[None, :]
    lo = jnp.maximum(t1 - win, 0)
    lo_val = cs[:, lo, jnp.arange(POOL_GROUPS)[None, :], :]
    count = (t1 - lo).astype(F32)[None, :, :, None]
    pooled = (cs[:, 1:] - lo_val) / count - uf
    y = jnp.einsum('bsgc,gcd->bsgd', pooled, w_pool.astype(F32))
    return (y.reshape(B, S, MIX_WIDTH) * scale.astype(F32)).astype(u.dtype)


def swa_attention(q, k, v, sinks, pos):
    B, S, _ = q.shape
    NB = S // SWA_BLOCK
    G = SWA_HEADS // SWA_KV_HEADS
    qr = rope(q.reshape(B, S, SWA_HEADS, HEAD_DIM), pos) * HEAD_DIM ** -0.5
    kr = rope(k.reshape(B, S, SWA_KV_HEADS, HEAD_DIM), pos)
    vr = v.astype(F32).reshape(B, S, SWA_KV_HEADS, HEAD_DIM)
    qb = qr.reshape(B, NB, SWA_BLOCK, SWA_KV_HEADS, G, HEAD_DIM)

    def band(t):
        tb = t.reshape(B, NB, SWA_BLOCK, SWA_KV_HEADS, HEAD_DIM)
        prev = jnp.concatenate([jnp.zeros_like(tb[:, :1]), tb[:, :-1]], axis=1)
        return jnp.concatenate([prev, tb], axis=2)

    kb, vb = band(kr), band(vr)
    s = jnp.einsum('bnqhgd,bnkhd->bnhgqk', qb, kb)
    tq = jnp.arange(SWA_BLOCK)[:, None]
    sk = jnp.arange(2 * SWA_BLOCK)[None, :]
    rel = SWA_BLOCK + tq - sk
    in_win = (rel >= 0) & (rel < SWA_WINDOW)
    blk = jnp.arange(NB)[:, None, None]
    valid = in_win[None] & ((blk * SWA_BLOCK - SWA_BLOCK + sk[None]) >= 0)
    s = jnp.where(valid[None, :, None, None], s, -jnp.inf)
    sink = sinks.astype(F32).reshape(1, 1, SWA_KV_HEADS, G, 1, 1)
    m = jnp.maximum(jnp.max(s, axis=-1, keepdims=True), sink)
    p = jnp.exp(s - m)
    den = jnp.sum(p, axis=-1, keepdims=True) + jnp.exp(sink - m)
    o = jnp.einsum('bnhgqk,bnkhd->bnqhgd', p / den, vb)
    return o.reshape(B, S, SWA_Q).astype(q.dtype)


def causal_depthwise_conv(x, w):
    K, C = w.shape
    return lax.conv_general_dilated(x, w[:, None, :].astype(x.dtype), window_strides=(1,),
                                    padding=[(K - 1, 0)],
                                    dimension_numbers=('NWC', 'WIO', 'NWC'),
                                    feature_group_count=C)


def mlstm(q, k, v, o_pre, i_pre, f_pre, conv_w, i_bias, f_bias):
    B, S, _ = q.shape
    H, dh, L = MLSTM_HEADS, MLSTM_HEAD_DIM, MLSTM_CHUNK
    NC = S // L
    qk = jax.nn.silu(causal_depthwise_conv(jnp.concatenate([q, k], axis=-1), conv_w))
    qc_in, kc_in = jnp.split(qk, 2, axis=-1)

    def chunks(t, d):
        return t.astype(F32).reshape(B, NC, L, H, d).transpose(1, 0, 3, 2, 4)

    qc = chunks(qc_in, dh) * dh ** -0.5
    kc = chunks(kc_in, dh)
    vc = chunks(v, dh)
    ig = chunks(i_pre.astype(F32) + i_bias.astype(F32), 1)[..., 0]
    lf = jax.nn.log_sigmoid(chunks(f_pre.astype(F32) + f_bias.astype(F32), 1)[..., 0])
    causal = jnp.tril(jnp.ones((L, L), dtype=bool))

    def step(carry, inp):
        C, n, m = carry
        qx, kx, vx, ix, fx = inp
        b = jnp.cumsum(fx, axis=-1)
        dlog = jnp.where(causal, b[..., :, None] - b[..., None, :] + ix[..., None, :], -jnp.inf)
        inter = b + m[..., None]
        m_comb = jnp.maximum(inter, jnp.max(dlog, axis=-1))
        sm = jnp.einsum('bhtd,bhsd->bhts', qx, kx) * jnp.exp(dlog - m_comb[..., None])
        w_inter = jnp.exp(inter - m_comb)
        num = jnp.einsum('bhts,bhsd->bhtd', sm, vx) + w_inter[..., None] * jnp.einsum('bhvk,bhtk->bhtv', C, qx)
        den = jnp.sum(sm, axis=-1) + w_inter * jnp.einsum('bhk,bhtk->bht', n, qx)
        h = num / jnp.maximum(jnp.abs(den), jnp.exp(-m_comb))[..., None]
        bl = b[..., -1]
        g = bl[..., None] - b + ix
        m_new = jnp.maximum(bl + m, jnp.max(g, axis=-1))
        wk = jnp.exp(g - m_new[..., None])
        decay = jnp.exp(bl + m - m_new)
        C = decay[..., None, None] * C + jnp.einsum('bhs,bhsv,bhsk->bhvk', wk, vx, kx)
        n = decay[..., None] * n + jnp.einsum('bhs,bhsk->bhk', wk, kx)
        return (C, n, m_new), h

    init = (jnp.zeros((B, H, dh, dh), F32), jnp.zeros((B, H, dh), F32), jnp.zeros((B, H), F32))
    _, h = lax.scan(step, init, (qc, kc, vc, ig, lf))
    h = h.transpose(1, 0, 3, 2, 4).reshape(B, S, ML_W)
    return (jax.nn.sigmoid(o_pre.astype(F32)) * h).astype(q.dtype)


def forgetting_attention(q, k, v, f_pre, f_bias):
    B, S, _ = q.shape
    H, d, Qb = FOX_HEADS, HEAD_DIM, FOX_BLOCK
    NB = S // Qb
    qh = q.astype(F32).reshape(B, S, H, d).transpose(0, 2, 1, 3) * d ** -0.5
    kh = k.astype(F32).reshape(B, S, H, d).transpose(0, 2, 1, 3)
    vh = v.astype(F32).reshape(B, S, H, d).transpose(0, 2, 1, 3)
    c = jnp.cumsum(jax.nn.log_sigmoid(f_pre.astype(F32) + f_bias.astype(F32)), axis=1).transpose(0, 2, 1)
    q_blocks = qh.reshape(B, H, NB, Qb, d).transpose(2, 0, 1, 3, 4)
    c_blocks = c.reshape(B, H, NB, Qb).transpose(2, 0, 1, 3)
    key_pos = jnp.arange(S)

    def block(args):
        qb, cb, i = args
        s = jnp.einsum('bhqd,bhkd->bhqk', qb, kh) + cb[..., None] - c[:, :, None, :]
        q_pos = i * Qb + jnp.arange(Qb)
        s = jnp.where(key_pos[None, :] <= q_pos[:, None], s, -jnp.inf)
        return jnp.einsum('bhqk,bhkd->bhqd', jax.nn.softmax(s, axis=-1), vh)

    o = lax.map(block, (q_blocks, c_blocks, jnp.arange(NB)))
    return o.transpose(1, 0, 3, 2, 4).reshape(B, S, FOX_W).astype(q.dtype)


def hybrid_mixer(x, pos, w_in, pool_w, pool_scale, swa_sinks, mlstm_conv,
                 mlstm_i_bias, mlstm_f_bias, fox_f_bias, w_branch, w_gate, w_out):
    z = x @ w_in
    (u_pool, q_swa, k_swa, v_swa, q_ml, k_ml, v_ml, o_ml, i_ml, f_ml,
     q_fox, k_fox, v_fox, f_fox) = split_columns(z)
    branches = (
        pool_mixer(u_pool, pool_w, pool_scale),
        swa_attention(q_swa, k_swa, v_swa, swa_sinks, pos),
        mlstm(q_ml, k_ml, v_ml, o_ml, i_ml, f_ml, mlstm_conv, mlstm_i_bias, mlstm_f_bias),
        forgetting_attention(q_fox, k_fox, v_fox, f_fox, fox_f_bias),
    )
    merged = jnp.zeros_like(x)
    for b in range(N_BRANCH):
        merged = merged + jax.nn.sigmoid(x @ w_gate[b]) * (branches[b] @ w_branch[b])
    return merged @ w_out


def setup_inputs(seed: int = 0) -> dict:
    key = jax.random.key(seed)
    ks = jax.random.split(key, 20)

    def nrm(k, shape, scale):
        return jax.random.normal(k, shape, F32) * scale

    x = nrm(ks[0], (BATCH, SEQ, D_MODEL), 1.0)
    ln_g = 1.0 + nrm(ks[1], (DEPTH, 3, D_MODEL), 0.02)
    ln_b = nrm(ks[2], (DEPTH, 3, D_MODEL), 0.02)
    ffn1_w_in = nrm(ks[3], (DEPTH, D_MODEL, 2 * D_FF), D_MODEL ** -0.5)
    ffn1_w_out = nrm(ks[4], (DEPTH, D_FF, D_MODEL), DEEPNORM_BETA * D_FF ** -0.5)
    w_in = nrm(ks[5], (DEPTH, D_MODEL, D_IN), D_MODEL ** -0.5)
    pool_w = nrm(ks[6], (DEPTH, POOL_GROUPS, POOL_CH, POOL_CH), POOL_CH ** -0.5)
    pool_scale = 1.0 + nrm(ks[7], (DEPTH, MIX_WIDTH), 0.02)
    swa_sinks = nrm(ks[8], (DEPTH, SWA_HEADS), 0.5)
    mlstm_conv = nrm(ks[9], (DEPTH, MLSTM_CONV, 2 * ML_W), MLSTM_CONV ** -0.5)
    mlstm_i_bias = nrm(ks[10], (DEPTH, MLSTM_HEADS), 0.1)
    mlstm_f_bias = jnp.linspace(3.0, 6.0, MLSTM_HEADS, dtype=F32)[None, :] + nrm(ks[11], (DEPTH, MLSTM_HEADS), 0.1)
    fox_f_bias = jnp.linspace(2.0, 6.0, FOX_HEADS, dtype=F32)[None, :] + nrm(ks[12], (DEPTH, FOX_HEADS), 0.1)
    w_branch = nrm(ks[13], (DEPTH, N_BRANCH, MIX_WIDTH, D_MODEL), MIX_WIDTH ** -0.5)
    w_gate = nrm(ks[14], (DEPTH, N_BRANCH, D_MODEL, D_MODEL), D_MODEL ** -0.5)
    w_out = nrm(ks[15], (DEPTH, D_MODEL, D_MODEL), DEEPNORM_BETA * D_MODEL ** -0.5)
    ffn2_w_in = nrm(ks[16], (DEPTH, D_MODEL, 2 * D_FF), D_MODEL ** -0.5)
    ffn2_w_out = nrm(ks[17], (DEPTH, D_FF, D_MODEL), DEEPNORM_BETA * D_FF ** -0.5)
    return {'x': x, 'ln_g': ln_g, 'ln_b': ln_b, 'ffn1_w_in': ffn1_w_in, 'ffn1_w_out': ffn1_w_out,
            'w_in': w_in, 'pool_w': pool_w, 'pool_scale': pool_scale, 'swa_sinks': swa_sinks,
            'mlstm_conv': mlstm_conv, 'mlstm_i_bias': mlstm_i_bias, 'mlstm_f_bias': mlstm_f_bias,
            'fox_f_bias': fox_f_bias, 'w_branch': w_branch, 'w_gate': w_gate, 'w_out': w_out,
            'ffn2_w_in': ffn2_w_in, 'ffn2_w_out': ffn2_w_out}


def reference(x, ln_g, ln_b, ffn1_w_in, ffn1_w_out, w_in, pool_w, pool_scale, swa_sinks,
              mlstm_conv, mlstm_i_bias, mlstm_f_bias, fox_f_bias, w_branch, w_gate, w_out,
              ffn2_w_in, ffn2_w_out):
    pos = jnp.arange(x.shape[1], dtype=jnp.int32)
    h = x
    for l in range(DEPTH):
        h = layer_norm(DEEPNORM_ALPHA * h + FFN_HALF * swiglu(h, ffn1_w_in[l], ffn1_w_out[l]),
                       ln_g[l, 0], ln_b[l, 0])
        mix = hybrid_mixer(h, pos, w_in[l], pool_w[l], pool_scale[l], swa_sinks[l], mlstm_conv[l],
                           mlstm_i_bias[l], mlstm_f_bias[l], fox_f_bias[l], w_branch[l],
                           w_gate[l], w_out[l])
        h = layer_norm(DEEPNORM_ALPHA * h + mix, ln_g[l, 1], ln_b[l, 1])
        h = layer_norm(DEEPNORM_ALPHA * h + FFN_HALF * swiglu(h, ffn2_w_in[l], ffn2_w_out[l]),
                       ln_g[l, 2], ln_b[l, 2])
    return h
```

```cpp
#include <hip/hip_runtime.h>
#include <hip/hip_cooperative_groups.h>
#include <cstdio>
#include <cstdint>
namespace cg = cooperative_groups;
#define DBG_MIX 15
#define DBG_STOP 0
#define REP_PHASE 0
#define REPS(k) for (int rep_ = 0; rep_ < ((REP_PHASE == (k)) ? 2 : 1); ++rep_)

#define LAS __attribute__((address_space(3)))
typedef unsigned short bf16_t;
typedef short bf16x8 __attribute__((ext_vector_type(8)));
typedef float f32x4 __attribute__((ext_vector_type(4)));
typedef float f32x16 __attribute__((ext_vector_type(16)));
typedef unsigned u32x4 __attribute__((ext_vector_type(4)));
typedef unsigned u32x2 __attribute__((ext_vector_type(2)));
typedef float f32x2_t __attribute__((ext_vector_type(2)));
typedef __bf16 bf16x2_t __attribute__((ext_vector_type(2)));

constexpr int S = 16384, DM = 2048, FF = 5632, ZLD = 4864, NL = 2;
constexpr int NWAVES = 8, NTHR = 512;
constexpr float ALPHA = 1.41421356237309515f;
constexpr float LOG2E = 1.4426950408889634f;
constexpr float C2 = 0.125f * LOG2E;
constexpr float LN_EPS = 1e-5f;
constexpr int ZC_QSWA = 512, ZC_KSWA = 1024, ZC_VSWA = 1152, ZC_QML = 1280, ZC_VML = 2304, ZC_OML = 2816, ZC_QFOX = 3328, ZC_KFOX = 3840, ZC_VFOX = 4352;

constexpr size_t MiB = 1u << 20;
constexpr size_t O_ZG = 0;
constexpr size_t O_MLA = 1 * MiB;
constexpr size_t O_MLB = O_MLA + 256 * 1024;
constexpr size_t O_MLD = O_MLB + 256 * 1024;
constexpr size_t O_CL2 = 2 * MiB;
constexpr size_t O_TOT2 = O_CL2 + 512 * 1024;
constexpr size_t O_BLC = O_TOT2 + 16 * 1024;
constexpr size_t O_DMC = O_BLC + 16 * 1024;
constexpr size_t O_MST = O_DMC + 16 * 1024;
constexpr size_t O_NST = 3 * MiB;
constexpr size_t O_UN = O_NST + 512 * 1024;
constexpr size_t O_ST = 4 * MiB;
constexpr size_t O_W = 8 * MiB;
constexpr size_t OW_F1A = O_W, OW_F1B = OW_F1A + 44 * MiB, OW_IN = OW_F1B + 22 * MiB, OW_G = OW_IN + 20 * MiB, OW_BC = OW_G + 32 * MiB,
                 OW_O = OW_BC + 8 * MiB, OW_F2A = OW_O + 8 * MiB, OW_F2B = OW_F2A + 44 * MiB, OW_BD = OW_F2B + 22 * MiB;
constexpr size_t O_H = 210 * MiB;
constexpr size_t O_HB = 338 * MiB;
constexpr size_t O_R1 = 402 * MiB;
constexpr size_t O_YBR = 578 * MiB;
constexpr size_t O_QKC = 642 * MiB;
constexpr size_t O_VTF = 674 * MiB;
constexpr size_t O_VTS = 690 * MiB;
constexpr size_t O_VTM = 694 * MiB;
constexpr size_t O_VTW = 710 * MiB;
constexpr size_t O_KTM = 726 * MiB;
constexpr size_t O_POOL = 742 * MiB;
constexpr size_t O_U = 758 * MiB;
constexpr size_t O_CST = 822 * MiB;
constexpr size_t O_CTL = 854 * MiB;
constexpr size_t O_END = 855 * MiB;
constexpr size_t O_MERGED = O_QKC;
constexpr size_t O_GSC = O_R1;
constexpr size_t O_MSC = O_R1 + 32 * MiB;

constexpr int RING_BYTES = 131072;
constexpr int LDS_P2 = RING_BYTES;
constexpr int LDS_MISC = RING_BYTES + 8192;
constexpr int LDS_BYTES = 147456;

__device__ __forceinline__ unsigned pk2(float lo, float hi) { f32x2_t v = {lo, hi}; bf16x2_t b = __builtin_convertvector(v, bf16x2_t); return __builtin_bit_cast(unsigned, b); }
__device__ __forceinline__ float bf2f(unsigned short b) { return __uint_as_float((unsigned)b << 16); }
__device__ __forceinline__ float bflo(unsigned w) { return __uint_as_float(w << 16); }
__device__ __forceinline__ float bfhi(unsigned w) { return __uint_as_float(w & 0xffff0000u); }
__device__ __forceinline__ unsigned short f2bf(float f) { return (unsigned short)(pk2(f, 0.f) & 0xffffu); }
__device__ __forceinline__ float sigmoidf_(float x) { return __builtin_amdgcn_rcpf(1.f + __builtin_amdgcn_exp2f(-x * LOG2E)); }
__device__ __forceinline__ float logsigmoidf_(float x) { return fminf(x, 0.f) - log1pf(__expf(-fabsf(x))); }
__device__ __forceinline__ int lane_id() { int l; asm volatile("v_mbcnt_lo_u32_b32 %0, -1, 0\n\tv_mbcnt_hi_u32_b32 %0, -1, %0" : "=v"(l)); return l; }
__device__ __forceinline__ int launder_v(int x) { asm volatile("" : "+v"(x)); return x; }
__device__ __forceinline__ int launder_s(int x) { asm volatile("" : "+s"(x)); return x; }
template <class T> __device__ __forceinline__ T* launder_p(T* p) { asm volatile("" : "+s"(p)); return p; }
__device__ __forceinline__ int crow(int r, int hi) { return (r & 3) + 8 * (r >> 2) + 4 * hi; }

namespace pg8 {
constexpr int BM = 256, BK = 64, HALF = 128, HTB = HALF * BK * 2, NXCD = 8, WGM = 8;
__device__ __forceinline__ int lds_byte(int r, int c) { const int st = (r >> 4) * 2 + (c >> 5), rr = r & 15, cc = c & 31, ob = rr * 64 + cc * 2; return st * 1024 + (ob ^ (((ob >> 9) & 1) << 5)); }
__device__ __forceinline__ void stage_rc(int b, int& R, int& C) { const int st = b / 1024, sb = b % 1024, swz = sb ^ (((sb >> 9) & 1) << 5); R = (st >> 1) * 16 + swz / 64; C = (st & 1) * 32 + (swz % 64) / 2; }
__device__ __forceinline__ int perm32(int rho) { const int n = rho >> 4, i = rho & 15; return 8 * (i >> 2) + 4 * n + (i & 3); }

struct Unit { int pm, pn, kind, nt; const char* a; const char* b; };

__device__ __forceinline__ void tile_of(int L, int nM, int nN, int& pm, int& pn) {
    const int nwg = nM * nN; int wgid = L;
    { const int q = nwg / NXCD, r = nwg % NXCD, xcd = wgid % NXCD, off = wgid / NXCD; wgid = (xcd < r ? xcd * (q + 1) : r * (q + 1) + (xcd - r) * q) + off; }
    const int nig = WGM * nN, gid = wgid / nig, fm = gid * WGM, gsz = (nM - fm) < WGM ? (nM - fm) : WGM;
    pm = fm + ((wgid % nig) % gsz); pn = (wgid % nig) / gsz;
}
struct SimpleSched {
    const char* A; const char* Bt; int lda, ldb, nM, nN, G, c, nt;
    __device__ __forceinline__ bool next(int i, Unit& u) const {
        const int L = i * G + c; if (L >= nM * nN) return false;
        tile_of(L, nM, nN, u.pm, u.pn); u.kind = 0; u.nt = nt;
        u.a = A + (size_t)u.pm * 256 * lda * 2; u.b = Bt + (size_t)u.pn * 256 * ldb * 2; return true;
    }
};
struct MergeSched {
    const char* HB; const char* YBR; const char* WG; const char* WBC; int G, c;
    __device__ __forceinline__ bool next(int i, Unit& u) const {
        const int L = (i >> 3) * G + c; if (L >= 64 * 8) return false;
        tile_of(L, 64, 8, u.pm, u.pn); const int sub = i & 7, b = sub >> 1; u.kind = sub;
        if ((sub & 1) == 0) { u.nt = 32; u.a = HB + (size_t)u.pm * 256 * 2048 * 2; u.b = WG + ((size_t)b * 2048 + (size_t)u.pn * 256) * 2048 * 2; }
        else { u.nt = 8; u.a = YBR + ((size_t)u.pm * 256 * 2048 + b * 512) * 2; u.b = WBC + ((size_t)u.pn * 256 * 2048 + b * 512) * 2; }
        return true;
    }
};

template <class Epi, class Sched>
__device__ __forceinline__ void gemm_phase(LAS unsigned char* lds, const int lda, const int ldb, const Sched& S, const Epi& E, const int wave_) {
    const int wid = launder_s(wave_), lane = lane_id(), tid = wid * 64 + lane, wr = wid >> 2, wc = wid & 3, fr = lane & 15, fq = lane >> 4;
    unsigned voffA[2], voffB[2];
#pragma unroll
    for (int i = 0; i < 2; ++i) { int R, C; stage_rc(tid * 16 + i * 8192, R, C); const int Rb = Epi::PERM ? ((R & ~31) + perm32(R & 31)) : R;
        voffA[i] = (unsigned)(R * lda + C) * 2u; voffB[i] = (unsigned)(Rb * ldb + C) * 2u; }
    const size_t kstep = (size_t)(BK * 2);
    const size_t hstepA = (size_t)HALF * lda * 2, hstepB = (size_t)HALF * ldb * 2;
    const unsigned ldsw = (unsigned)wid * 1024u;
    const int aoff = lds_byte(wr * 64 + fr, fq * 8), boff = lds_byte(wc * 32 + fr, fq * 8);
#define PG8_SA(b, h) (((b) * 2 + (h)) * HTB)
#define PG8_SB(b, h) ((4 + (b) * 2 + (h)) * HTB)
#define PG8_STAGE(bufoff, gbase, voff) do { _Pragma("unroll") for (int _i = 0; _i < 2; ++_i) \
        __builtin_amdgcn_global_load_lds((const unsigned*)((const char*)(gbase) + (voff)[_i]), (LAS unsigned*)(lds + (bufoff) + ldsw + _i * 8192), 16, 0, 0); } while (0)
#define PG8_LDA(dst, b, h) do { _Pragma("unroll") for (int m = 0; m < 4; ++m) _Pragma("unroll") for (int k = 0; k < 2; ++k) dst[m][k] = *(const LAS bf16x8*)(lds + PG8_SA(b, h) + aoff + m * 2048 + k * 1024); } while (0)
#define PG8_LDB(dst, b, h) do { _Pragma("unroll") for (int n = 0; n < 2; ++n) _Pragma("unroll") for (int k = 0; k < 2; ++k) dst[n][k] = *(const LAS bf16x8*)(lds + PG8_SB(b, h) + boff + n * 2048 + k * 1024); } while (0)
#define PG8_MMA(ai, bj, At, Bt) do { __builtin_amdgcn_s_setprio(1); _Pragma("unroll") for (int m = 0; m < 4; ++m) _Pragma("unroll") for (int n = 0; n < 2; ++n) _Pragma("unroll") for (int k = 0; k < 2; ++k) \
        acc[ai][bj][m][n] = __builtin_amdgcn_mfma_f32_16x16x32_bf16(Bt[n][k], At[m][k], acc[ai][bj][m][n], 0, 0, 0); __builtin_amdgcn_s_setprio(0); } while (0)
#define PG8_WAIT_V(n) asm volatile("s_waitcnt vmcnt(" #n ")" ::: "memory")
#define PG8_WAIT_L(n) asm volatile("s_waitcnt lgkmcnt(" #n ")" ::: "memory")
#define PG8_BAR __builtin_amdgcn_s_barrier()
#define PG8_SCHED __builtin_amdgcn_sched_barrier(0)
    Unit cur, nxt; int ui = 0;
    if (!S.next(0, cur)) return;
    f32x4 acc[2][2][4][2];
#pragma unroll
    for (int a = 0; a < 2; ++a)
#pragma unroll
        for (int b = 0; b < 2; ++b)
#pragma unroll
            for (int m = 0; m < 4; ++m)
#pragma unroll
                for (int n = 0; n < 2; ++n) acc[a][b][m][n] = (f32x4){0.f, 0.f, 0.f, 0.f};
    bf16x8 At[4][2], B0[2][2], B1[2][2];
    const char* cA = cur.a; const char* cB = cur.b;
    PG8_STAGE(PG8_SB(0, 0), cB, voffB); PG8_STAGE(PG8_SB(0, 1), cB + hstepB, voffB); PG8_STAGE(PG8_SA(0, 0), cA, voffA); PG8_STAGE(PG8_SA(0, 1), cA + hstepA, voffA);
    if (wr == 1) PG8_BAR;
    PG8_WAIT_V(2); PG8_BAR;
    PG8_STAGE(PG8_SB(1, 0), cB + kstep, voffB); PG8_STAGE(PG8_SA(1, 0), cA + kstep, voffA); PG8_STAGE(PG8_SB(1, 1), cB + hstepB + kstep, voffB);
    PG8_WAIT_V(6); PG8_BAR;
    for (;;) {
        const bool has_next = S.next(ui + 1, nxt);
        const char* nA = has_next ? nxt.a : cA; const char* nB = has_next ? nxt.b : cB;
        const int nt = cur.nt;
        for (int t = 0; t < nt; t += 2) {
            const bool last = (t == nt - 2);
            const char* a1 = cA + (size_t)(t + 1) * kstep;
            const char* a2 = last ? nA : cA + (size_t)(t + 2) * kstep; const char* b2 = last ? nB : cB + (size_t)(t + 2) * kstep;
            const char* a3 = a2 + kstep; const char* b3 = b2 + kstep;
            PG8_LDB(B0, 0, 0); PG8_LDB(B1, 0, 1); PG8_SCHED; PG8_LDA(At, 0, 0); PG8_STAGE(PG8_SA(1, 1), a1 + hstepA, voffA);
            PG8_WAIT_V(8); PG8_WAIT_L(0); PG8_BAR; PG8_MMA(0, 0, At, B0); PG8_MMA(0, 1, At, B1); PG8_BAR; PG8_SCHED;
            PG8_LDA(At, 0, 1); PG8_STAGE(PG8_SB(0, 0), b2, voffB); PG8_STAGE(PG8_SB(0, 1), b2 + hstepB, voffB); PG8_STAGE(PG8_SA(0, 0), a2, voffA);
            PG8_WAIT_V(8); PG8_WAIT_L(0); PG8_BAR; PG8_MMA(1, 0, At, B0); PG8_MMA(1, 1, At, B1); PG8_BAR; PG8_SCHED;
            PG8_LDB(B0, 1, 0); PG8_LDB(B1, 1, 1); PG8_SCHED; PG8_LDA(At, 1, 0); PG8_STAGE(PG8_SA(0, 1), a2 + hstepA, voffA);
            PG8_WAIT_V(8); PG8_WAIT_L(0); PG8_BAR; PG8_MMA(0, 0, At, B0); PG8_MMA(0, 1, At, B1); PG8_BAR; PG8_SCHED;
            PG8_LDA(At, 1, 1); PG8_STAGE(PG8_SB(1, 0), b3, voffB); PG8_STAGE(PG8_SB(1, 1), b3 + hstepB, voffB); PG8_STAGE(PG8_SA(1, 0), a3, voffA);
            PG8_WAIT_V(8); PG8_WAIT_L(0); PG8_BAR; PG8_MMA(1, 0, At, B0); PG8_MMA(1, 1, At, B1); PG8_BAR; PG8_SCHED;
        }
        if (wr == 0) PG8_BAR;
        E(acc, cur, wr, wc, fr, fq);
        if (!has_next) break;
#pragma unroll
        for (int a = 0; a < 2; ++a)
#pragma unroll
            for (int b = 0; b < 2; ++b)
#pragma unroll
                for (int m = 0; m < 4; ++m)
#pragma unroll
                    for (int n = 0; n < 2; ++n) acc[a][b][m][n] = (f32x4){0.f, 0.f, 0.f, 0.f};
        cur = nxt; cA = nA; cB = nB; ++ui;
        if (wr == 1) PG8_BAR;
    }
    PG8_WAIT_V(0);
    PG8_BAR;
#undef PG8_SA
#undef PG8_SB
#undef PG8_STAGE
#undef PG8_LDA
#undef PG8_LDB
#undef PG8_MMA
#undef PG8_WAIT_V
#undef PG8_WAIT_L
#undef PG8_BAR
#undef PG8_SCHED
}

typedef f32x4 Acc[2][2][4][2];

struct EpiSwiGLU {
    static constexpr bool PERM = true;
    bf16_t* O;
    __device__ __forceinline__ void operator()(const Acc& acc, const Unit& u, int wr, int wc, int fr, int fq) const {
        const int row0 = u.pm * BM + wr * 64 + fr, col0 = u.pn * 128 + wc * 32 + 8 * fq;
#pragma unroll
        for (int ai = 0; ai < 2; ++ai)
#pragma unroll
            for (int m = 0; m < 4; ++m) {
                bf16_t* p = O + (size_t)(row0 + ai * HALF + m * 16) * FF + col0;
                float h[8];
#pragma unroll
                for (int n = 0; n < 2; ++n)
#pragma unroll
                    for (int j = 0; j < 4; ++j) { const float g = acc[ai][0][m][n][j], up = acc[ai][1][m][n][j]; h[n * 4 + j] = g * sigmoidf_(g) * up; }
                u32x4 w; w.x = pk2(h[0], h[1]); w.y = pk2(h[2], h[3]); w.z = pk2(h[4], h[5]); w.w = pk2(h[6], h[7]);
                *(u32x4*)p = w;
            }
    }
};
template <bool LNRES> struct EpiResid {
    static constexpr bool PERM = false;
    const float* res; float* out; float s; const float* st; const float* g; const float* b;
    __device__ __forceinline__ void operator()(const Acc& acc, const Unit& u, int wr, int wc, int fr, int fq) const {
        const int col0 = u.pn * BM + wc * 32 + 4 * fq;
#pragma unroll
        for (int ai = 0; ai < 2; ++ai)
#pragma unroll
            for (int bj = 0; bj < 2; ++bj) {
                f32x4 rv[4][2], gv[2], bv[2]; f32x2_t sv[4];
                const int c = col0 + bj * HALF;
                if (LNRES) {
#pragma unroll
                    for (int n = 0; n < 2; ++n) { gv[n] = *(const f32x4*)(g + c + n * 16); bv[n] = *(const f32x4*)(b + c + n * 16); }
                }
#pragma unroll
                for (int m = 0; m < 4; ++m) { const int row = u.pm * BM + ai * HALF + wr * 64 + m * 16 + fr; const size_t off = (size_t)row * DM + c;
                    if (LNRES) sv[m] = *(const f32x2_t*)(st + 2 * (size_t)row);
#pragma unroll
                    for (int n = 0; n < 2; ++n) rv[m][n] = *(const f32x4*)(res + off + n * 16); }
                asm volatile("" ::: "memory");
#pragma unroll
                for (int m = 0; m < 4; ++m) { const size_t off = (size_t)(u.pm * BM + ai * HALF + wr * 64 + m * 16 + fr) * DM + c;
#pragma unroll
                    for (int n = 0; n < 2; ++n) { f32x4 r = rv[m][n]; if (LNRES) r = (r - sv[m].x) * sv[m].y * gv[n] + bv[n];
                        *(f32x4*)(out + off + n * 16) = r * ALPHA + acc[ai][bj][m][n] * s; } }
                asm volatile("" ::: "memory");
            }
    }
};
struct EpiInProj {
    static constexpr bool PERM = true;
    bf16_t* Z; float* ZG;
    __device__ __forceinline__ void operator()(const Acc& acc, const Unit& u, int wr, int wc, int fr, int fq) const {
        const int row0 = u.pm * BM + wr * 64 + fr;
        if (u.pn < 19) {
            const float sc = (u.pn == 2 || u.pn == 3 || u.pn == 13 || u.pn == 14) ? C2 : 1.f;
            const int col0 = u.pn * BM + wc * 32 + 8 * fq;
#pragma unroll
            for (int ai = 0; ai < 2; ++ai)
#pragma unroll
                for (int m = 0; m < 4; ++m) { bf16_t* p = Z + (size_t)(row0 + ai * HALF + m * 16) * ZLD + col0;
#pragma unroll
                    for (int bj = 0; bj < 2; ++bj) { const f32x4 v0 = acc[ai][bj][m][0] * sc, v1 = acc[ai][bj][m][1] * sc;
                        u32x4 w; w.x = pk2(v0[0], v0[1]); w.y = pk2(v0[2], v0[3]); w.z = pk2(v1[0], v1[1]); w.w = pk2(v1[2], v1[3]);
                        *(u32x4*)(p + bj * HALF) = w; } }
        } else if (wc == 0 && fq < 2) {
#pragma unroll
            for (int ai = 0; ai < 2; ++ai)
#pragma unroll
                for (int m = 0; m < 4; ++m) { float* p = ZG + (size_t)(row0 + ai * HALF + m * 16) * 16 + 8 * fq;
                    *(f32x4*)p = acc[ai][0][m][0]; *(f32x4*)(p + 4) = acc[ai][0][m][1]; }
        }
    }
};
struct EpiPool {
    static constexpr bool PERM = true;
    bf16_t* Y; const float* scale;
    __device__ __forceinline__ void operator()(const Acc& acc, const Unit& u, int wr, int wc, int fr, int fq) const {
        const int row0 = u.pm * BM + wr * 64 + fr, col0 = u.pn * BM + wc * 32 + 8 * fq;
#pragma unroll
        for (int bj = 0; bj < 2; ++bj) {
            const f32x4 s0 = *(const f32x4*)(scale + col0 + bj * HALF), s1 = *(const f32x4*)(scale + col0 + bj * HALF + 4);
#pragma unroll
            for (int ai = 0; ai < 2; ++ai)
#pragma unroll
                for (int m = 0; m < 4; ++m) { bf16_t* p = Y + (size_t)(row0 + ai * HALF + m * 16) * DM + col0 + bj * HALF;
                    const f32x4 v0 = acc[ai][bj][m][0] * s0, v1 = acc[ai][bj][m][1] * s1;
                    u32x4 w; w.x = pk2(v0[0], v0[1]); w.y = pk2(v0[2], v0[3]); w.z = pk2(v1[0], v1[1]); w.w = pk2(v1[2], v1[3]);
                    *(u32x4*)p = w; }
        }
    }
};
struct EpiMerge {
    static constexpr bool PERM = true;
    u32x2* gsc; u32x4* msc; bf16_t* MG;
    __device__ __forceinline__ void operator()(const Acc& acc, const Unit& u, int wr, int wc, int fr, int fq) const {
        const int tid = (wr * 4 + wc) * 64 + fq * 16 + fr;
        u32x2* g = gsc + ((size_t)blockIdx.x * NTHR + tid) * 16;
        u32x4* ms = msc + ((size_t)blockIdx.x * NTHR + tid) * 16;
        const int b = u.kind >> 1;
        if ((u.kind & 1) == 0) {
#pragma unroll
            for (int ai = 0; ai < 2; ++ai)
#pragma unroll
                for (int bj = 0; bj < 2; ++bj)
#pragma unroll
                    for (int m = 0; m < 4; ++m) { const f32x4 a0 = acc[ai][bj][m][0], a1 = acc[ai][bj][m][1];
                        u32x2 w;
                        w.x = (unsigned)(sigmoidf_(a0[0]) * 255.f + 0.5f) | ((unsigned)(sigmoidf_(a0[1]) * 255.f + 0.5f) << 8) | ((unsigned)(sigmoidf_(a0[2]) * 255.f + 0.5f) << 16) | ((unsigned)(sigmoidf_(a0[3]) * 255.f + 0.5f) << 24);
                        w.y = (unsigned)(sigmoidf_(a1[0]) * 255.f + 0.5f) | ((unsigned)(sigmoidf_(a1[1]) * 255.f + 0.5f) << 8) | ((unsigned)(sigmoidf_(a1[2]) * 255.f + 0.5f) << 16) | ((unsigned)(sigmoidf_(a1[3]) * 255.f + 0.5f) << 24);
                        g[(ai * 2 + bj) * 4 + m] = w; }
            asm volatile("" ::: "memory");
        } else {
            const int row0 = u.pm * BM + wr * 64 + fr, col0 = u.pn * BM + wc * 32 + 8 * fq;
            const float k255 = 1.f / 255.f;
#pragma unroll
            for (int ai = 0; ai < 2; ++ai) {
                u32x2 gw[8]; u32x4 pv[8];
#pragma unroll
                for (int sl = 0; sl < 8; ++sl) gw[sl] = g[ai * 8 + sl];
                if (b > 0) {
#pragma unroll
                    for (int sl = 0; sl < 8; ++sl) pv[sl] = ms[ai * 8 + sl];
                }
#pragma unroll
                for (int bj = 0; bj < 2; ++bj)
#pragma unroll
                    for (int m = 0; m < 4; ++m) { const int hs = bj * 4 + m, slot = ai * 8 + hs; const u32x2 w = gw[hs];
                        f32x4 p0 = acc[ai][bj][m][0], p1 = acc[ai][bj][m][1];
                        p0[0] *= (float)(w.x & 255u) * k255; p0[1] *= (float)((w.x >> 8) & 255u) * k255; p0[2] *= (float)((w.x >> 16) & 255u) * k255; p0[3] *= (float)(w.x >> 24) * k255;
                        p1[0] *= (float)(w.y & 255u) * k255; p1[1] *= (float)((w.y >> 8) & 255u) * k255; p1[2] *= (float)((w.y >> 16) & 255u) * k255; p1[3] *= (float)(w.y >> 24) * k255;
                        if (b > 0) { const u32x4 q = pv[hs];
                            p0[0] += bflo(q.x); p0[1] += bfhi(q.x); p0[2] += bflo(q.y); p0[3] += bfhi(q.y); p1[0] += bflo(q.z); p1[1] += bfhi(q.z); p1[2] += bflo(q.w); p1[3] += bfhi(q.w); }
                        u32x4 o; o.x = pk2(p0[0], p0[1]); o.y = pk2(p0[2], p0[3]); o.z = pk2(p1[0], p1[1]); o.w = pk2(p1[2], p1[3]);
                        if (b < 3) ms[slot] = o;
                        else *(u32x4*)(MG + (size_t)(row0 + ai * HALF + m * 16) * DM + col0 + bj * HALF) = o; }
                asm volatile("" ::: "memory");
            }
        }
    }
};
}

struct Params {
    const float* x; const float* ln_g; const float* ln_b; const float* ffn1_w_in; const float* ffn1_w_out; const float* w_in; const float* pool_w; const float* pool_scale;
    const float* swa_sinks; const float* mlstm_conv; const float* mlstm_i_bias; const float* mlstm_f_bias; const float* fox_f_bias; const float* w_branch; const float* w_gate;
    const float* w_out; const float* ffn2_w_in; const float* ffn2_w_out; float* out; unsigned char* ws;
};

__device__ __forceinline__ int maprow(int kind, int n) {
    if (kind == 1) { const int type = n >= FF ? 1 : 0; const int j = n - type * FF; return (j >> 7) * 256 + type * 128 + (j & 127); }
    if (kind == 2) { if (n < 3328) return n; if (n < 3336) return 4864 + (n - 3328); if (n < 4872) return n - 8; return n; }
    return n;
}
__device__ __forceinline__ void tr_item(const float* W, int ldw, int ncols, int nblk, int item, bf16_t* dst, int dpitch, int dcol0, int mapkind, LAS float* scr, int lane) {
    const int kb = item / nblk, nb = item % nblk, k0 = 64 * kb, n0 = 32 * nb;
    const int nsrc = n0 + (lane & 31);
    float wv[32];
#pragma unroll
    for (int i = 0; i < 32; ++i) { const int kk = 2 * i + (lane >> 5); wv[i] = (nsrc < ncols) ? W[(size_t)(k0 + kk) * ldw + nsrc] : 0.f; }
#pragma unroll
    for (int i = 0; i < 32; ++i) { const int kk = 2 * i + (lane >> 5); scr[kk * 33 + (lane & 31)] = wv[i]; }
    asm volatile("s_waitcnt lgkmcnt(0)" ::: "memory");
    const int c = lane & 7;
#pragma unroll
    for (int j = 0; j < 4; ++j) { const int nn = (lane >> 3) + 8 * j; const int n = n0 + nn; const LAS float* s = scr + (8 * c) * 33 + nn;
        u32x4 o; o.x = pk2(s[0 * 33], s[1 * 33]); o.y = pk2(s[2 * 33], s[3 * 33]); o.z = pk2(s[4 * 33], s[5 * 33]); o.w = pk2(s[6 * 33], s[7 * 33]);
        if (n < ncols) *(u32x4*)(dst + (size_t)maprow(mapkind, n) * dpitch + dcol0 + k0 + 8 * c) = o; }
    asm volatile("s_waitcnt lgkmcnt(0)" ::: "memory");
}

__device__ __forceinline__ void phase_weights(const Params& p, int l, LAS unsigned char* lds, int wave_, int lane_, int G) {
    const int lane = lane_id(), wave = launder_s(wave_); (void)lane_;
    unsigned char* ws = launder_p(p.ws);
    LAS float* scr = (LAS float*)(lds + wave * 8448);
    const int gw = blockIdx.x * NWAVES + wave, NGW = G * NWAVES;
    const float* f1a = p.ffn1_w_in + (size_t)l * DM * 2 * FF; const float* f1b = p.ffn1_w_out + (size_t)l * FF * DM;
    const float* f2a = p.ffn2_w_in + (size_t)l * DM * 2 * FF; const float* f2b = p.ffn2_w_out + (size_t)l * FF * DM;
    const float* win = p.w_in + (size_t)l * DM * 4880; const float* wg = p.w_gate + (size_t)l * 4 * DM * DM; const float* wb = p.w_branch + (size_t)l * 4 * 512 * DM;
    const float* wo = p.w_out + (size_t)l * DM * DM; const float* pw = p.pool_w + (size_t)l * 4 * 128 * 128;
    constexpr int I_FA = 32 * 352, I_FB = 88 * 64, I_IN = 32 * 153, I_G = 4 * 32 * 64, I_B = 4 * 8 * 64, I_O = 32 * 64, I_P = 4 * 2 * 4;
    constexpr int NITEMS = 2 * I_FA + 2 * I_FB + I_IN + I_G + I_B + I_O + I_P;
    for (int it = gw; it < NITEMS; it += NGW) {
        int r = it;
        if (r < I_FA) { tr_item(f1a, 2 * FF, 2 * FF, 352, r, (bf16_t*)(ws + OW_F1A), DM, 0, 1, scr, lane); continue; } r -= I_FA;
        if (r < I_FA) { tr_item(f2a, 2 * FF, 2 * FF, 352, r, (bf16_t*)(ws + OW_F2A), DM, 0, 1, scr, lane); continue; } r -= I_FA;
        if (r < I_FB) { tr_item(f1b, DM, DM, 64, r, (bf16_t*)(ws + OW_F1B), FF, 0, 0, scr, lane); continue; } r -= I_FB;
        if (r < I_FB) { tr_item(f2b, DM, DM, 64, r, (bf16_t*)(ws + OW_F2B), FF, 0, 0, scr, lane); continue; } r -= I_FB;
        if (r < I_IN) { tr_item(win, 4880, 4880, 153, r, (bf16_t*)(ws + OW_IN), DM, 0, 2, scr, lane); continue; } r -= I_IN;
        if (r < I_G) { const int b = r / 2048, rr = r % 2048; tr_item(wg + (size_t)b * DM * DM, DM, DM, 64, rr, (bf16_t*)(ws + OW_G) + (size_t)b * DM * DM, DM, 0, 0, scr, lane); continue; } r -= I_G;
        if (r < I_B) { const int b = r / 512, rr = r % 512; tr_item(wb + (size_t)b * 512 * DM, DM, DM, 64, rr, (bf16_t*)(ws + OW_BC), DM, b * 512, 0, scr, lane); continue; } r -= I_B;
        if (r < I_O) { tr_item(wo, DM, DM, 64, r, (bf16_t*)(ws + OW_O), DM, 0, 0, scr, lane); continue; } r -= I_O;
        { const int g = r / 8, rr = r % 8; tr_item(pw + (size_t)g * 128 * 128, 128, 128, 4, rr, (bf16_t*)(ws + OW_BD) + (size_t)g * 128 * 512, 512, g * 128, 0, scr, lane); }
    }
    const int gt = blockIdx.x * NTHR + wave * 64 + lane, NGT = G * NTHR;
    const unsigned z0 = (unsigned)launder_v(0); const u32x4 zz = {z0, z0, z0, z0};
    { u32x4* zr = (u32x4*)((bf16_t*)(ws + OW_IN) + (size_t)4880 * DM); for (int i = gt; i < 240 * DM / 8; i += NGT) zr[i] = zz; }
    { u32x4* bd = (u32x4*)(ws + OW_BD); for (int i = gt; i < 512 * 512 / 8; i += NGT) { const int n = i / 64, k = (i % 64) * 8; if ((n >> 7) != (k >> 7)) bd[i] = zz; } }
    if (l == 0) {
        const f32x4* xs = (const f32x4*)p.x; u32x2* hb = (u32x2*)(ws + O_HB);
        for (int i = gt; i < S * DM / 4; i += NGT) { const f32x4 v = xs[i]; u32x2 w; w.x = pk2(v[0], v[1]); w.y = pk2(v[2], v[3]); hb[i] = w; }
    }
}

__device__ __forceinline__ float wave_sum(float v) {
#pragma unroll
    for (int o = 1; o < 64; o <<= 1) v += __shfl_xor(v, o);
    return v;
}
__device__ __forceinline__ void phase_ln(const float* Yin, float* Hout, bf16_t* hb, float* stats, const float* g, const float* b, int wave_, int lane_, int G) {
    const int lane = lane_id(), wave = launder_s(wave_); (void)lane_;
    const int gw = blockIdx.x * NWAVES + wave, NGW = G * NWAVES;
    for (int row = gw; row < S; row += 2 * NGW) {
        const int rowb = row + NGW;
        const f32x4* xa = (const f32x4*)(Yin + (size_t)row * DM) + lane; const f32x4* xb = (const f32x4*)(Yin + (size_t)rowb * DM) + lane;
        f32x4 va[8], vb[8]; float sa = 0.f, sb = 0.f;
#pragma unroll
        for (int j = 0; j < 8; ++j) { va[j] = xa[64 * j]; vb[j] = xb[64 * j]; }
#pragma unroll
        for (int j = 0; j < 8; ++j) { sa += (va[j][0] + va[j][1]) + (va[j][2] + va[j][3]); sb += (vb[j][0] + vb[j][1]) + (vb[j][2] + vb[j][3]); }
        const float ma = wave_sum(sa) * (1.f / DM), mb = wave_sum(sb) * (1.f / DM); float qa = 0.f, qb = 0.f;
#pragma unroll
        for (int j = 0; j < 8; ++j) { va[j] = va[j] - ma; vb[j] = vb[j] - mb;
            qa += (va[j][0] * va[j][0] + va[j][1] * va[j][1]) + (va[j][2] * va[j][2] + va[j][3] * va[j][3]);
            qb += (vb[j][0] * vb[j][0] + vb[j][1] * vb[j][1]) + (vb[j][2] * vb[j][2] + vb[j][3] * vb[j][3]); }
        const float ra = 1.f / sqrtf(wave_sum(qa) * (1.f / DM) + LN_EPS), rb = 1.f / sqrtf(wave_sum(qb) * (1.f / DM) + LN_EPS);
        if (stats && lane == 0) { stats[2 * (size_t)row] = ma; stats[2 * (size_t)row + 1] = ra; stats[2 * (size_t)rowb] = mb; stats[2 * (size_t)rowb + 1] = rb; }
        f32x4* ha = (f32x4*)(Hout + (size_t)row * DM) + lane; f32x4* hbp = (f32x4*)(Hout + (size_t)rowb * DM) + lane;
        u32x2* ba = (u32x2*)(hb + (size_t)row * DM) + lane; u32x2* bb = (u32x2*)(hb + (size_t)rowb * DM) + lane;
#pragma unroll
        for (int j = 0; j < 8; ++j) { const f32x4 gg = ((const f32x4*)g)[64 * j + lane], bbv = ((const f32x4*)b)[64 * j + lane];
            const f32x4 oa = va[j] * ra * gg + bbv, ob = vb[j] * rb * gg + bbv;
            if (Hout) { ha[64 * j] = oa; hbp[64 * j] = ob; }
            if (hb) { u32x2 w; w.x = pk2(oa[0], oa[1]); w.y = pk2(oa[2], oa[3]); ba[64 * j] = w; w.x = pk2(ob[0], ob[1]); w.y = pk2(ob[2], ob[3]); bb[64 * j] = w; } }
    }
}

__device__ __forceinline__ float scan_sum(float x, int lane) {
#pragma unroll
    for (int o = 1; o < 64; o <<= 1) { const float y = __shfl_up(x, o); if (lane >= o) x += y; }
    return x;
}
__device__ __forceinline__ float scan_max(float x, int lane) {
#pragma unroll
    for (int o = 1; o < 64; o <<= 1) { const float y = __shfl_up(x, o); if (lane >= o) x = fmaxf(x, y); }
    return x;
}
__device__ __forceinline__ void phase_post(const Params& p, int l, LAS unsigned char* lds, int wave_, int lane_, int G) {
    const int lane = lane_id(), wave = launder_s(wave_); (void)lane_;
    unsigned char* ws = launder_p(p.ws);
    bf16_t* Z = (bf16_t*)(ws + O_R1); const float* ZG = (const float*)(ws + O_ZG);
    LAS float* eL = (LAS float*)(lds + LDS_MISC);
    const int tid = wave * 64 + lane;
    LAS float* invL = (LAS float*)(lds + LDS_MISC + 1024);
    if (tid < 32) invL[tid] = exp2f(-(float)tid * 0.41524101186092029f);
    for (int c = blockIdx.x; c < S / 64; c += G) {
        const int t0 = c * 64;
        {
            const int t = t0 + lane;
            if (wave < 4) {
                const int h = wave;
                const float ip = ZG[(size_t)t * 16 + h] + p.mlstm_i_bias[l * 4 + h];
                const float lf = logsigmoidf_(ZG[(size_t)t * 16 + 4 + h] + p.mlstm_f_bias[l * 4 + h]);
                const float b = scan_sum(lf, lane);
                const float d = ip - b;
                const float a = scan_max(d, lane);
                const float dmax = __shfl(a, 63), bl = __shfl(b, 63);
                ((float*)(ws + O_MLA))[h * S + t] = a; ((float*)(ws + O_MLB))[h * S + t] = b; ((float*)(ws + O_MLD))[h * S + t] = d;
                eL[h * 64 + lane] = __expf(d - dmax);
                if (lane == 63) { ((float*)(ws + O_BLC))[c * 4 + h] = bl; ((float*)(ws + O_DMC))[c * 4 + h] = dmax; }
            }
            {
                const int h = wave;
                const float lf = logsigmoidf_(ZG[(size_t)t * 16 + 8 + h] + p.fox_f_bias[l * 8 + h]);
                const float cl = scan_sum(lf, lane) * LOG2E;
                ((float*)(ws + O_CL2))[h * S + t] = cl;
                if (lane == 63) ((float*)(ws + O_TOT2))[c * 8 + h] = cl;
            }
        }
        __syncthreads();
        for (int idx = tid; idx < 64 * 40; idx += NTHR) {
            const int tl = idx / 40, rem = idx % 40, hh = rem >> 2, i0 = (rem & 3) * 8, t = t0 + tl;
            bf16_t* px = Z + (size_t)t * ZLD + (hh < 8 ? ZC_QSWA + hh * 64 : ZC_KSWA + (hh - 8) * 64) + i0;
            const u32x4 a = *(const u32x4*)px, b = *(const u32x4*)(px + 32);
            float x1[8] = {bflo(a.x), bfhi(a.x), bflo(a.y), bfhi(a.y), bflo(a.z), bfhi(a.z), bflo(a.w), bfhi(a.w)};
            float x2[8] = {bflo(b.x), bfhi(b.x), bflo(b.y), bfhi(b.y), bflo(b.z), bfhi(b.z), bflo(b.w), bfhi(b.w)};
            float y1[8], y2[8];
#pragma unroll
            for (int j = 0; j < 8; ++j) {
                const float ang = (float)t * invL[i0 + j];
                double rev = (double)ang * 0.15915494309189535; rev -= rint(rev);
                const float rr = (float)(rev * 6.283185307179586);
                const float cs = __cosf(rr), sn = __sinf(rr);
                y1[j] = x1[j] * cs - x2[j] * sn; y2[j] = x2[j] * cs + x1[j] * sn;
            }
            u32x4 o1, o2;
            o1.x = pk2(y1[0], y1[1]); o1.y = pk2(y1[2], y1[3]); o1.z = pk2(y1[4], y1[5]); o1.w = pk2(y1[6], y1[7]);
            o2.x = pk2(y2[0], y2[1]); o2.y = pk2(y2[2], y2[3]); o2.z = pk2(y2[4], y2[5]); o2.w = pk2(y2[6], y2[7]);
            *(u32x4*)px = o1; *(u32x4*)(px + 32) = o2;
        }
        for (int idx = tid; idx < 128 + 512 + 512; idx += NTHR) {
            int col, h = 0; bf16_t* dst; bf16_t* dst2 = nullptr;
            if (idx < 128) { col = ZC_VSWA + idx; dst = (bf16_t*)(ws + O_VTS) + (size_t)idx * S; }
            else if (idx < 640) { const int cc = idx - 128; col = ZC_VFOX + cc; dst = (bf16_t*)(ws + O_VTF) + (size_t)cc * S; }
            else { const int cc = idx - 640; col = ZC_VML + cc; dst = (bf16_t*)(ws + O_VTM) + (size_t)cc * S; dst2 = (bf16_t*)(ws + O_VTW) + (size_t)cc * S; h = cc >> 7; }
            const bf16_t* __restrict__ src = Z + (size_t)t0 * ZLD + col;
            unsigned short v[64];
#pragma unroll
            for (int j = 0; j < 64; ++j) v[j] = src[(size_t)j * ZLD];
#pragma unroll
            for (int g8 = 0; g8 < 8; ++g8) { u32x4 w;
                w.x = (unsigned)v[8 * g8] | ((unsigned)v[8 * g8 + 1] << 16); w.y = (unsigned)v[8 * g8 + 2] | ((unsigned)v[8 * g8 + 3] << 16);
                w.z = (unsigned)v[8 * g8 + 4] | ((unsigned)v[8 * g8 + 5] << 16); w.w = (unsigned)v[8 * g8 + 6] | ((unsigned)v[8 * g8 + 7] << 16);
                *(u32x4*)(dst + t0 + 8 * g8) = w; }
            if (dst2) {
                const LAS float* e = eL + h * 64;
#pragma unroll
                for (int g8 = 0; g8 < 8; ++g8) { u32x4 w;
                    w.x = pk2(bf2f(v[8 * g8]) * e[8 * g8], bf2f(v[8 * g8 + 1]) * e[8 * g8 + 1]); w.y = pk2(bf2f(v[8 * g8 + 2]) * e[8 * g8 + 2], bf2f(v[8 * g8 + 3]) * e[8 * g8 + 3]);
                    w.z = pk2(bf2f(v[8 * g8 + 4]) * e[8 * g8 + 4], bf2f(v[8 * g8 + 5]) * e[8 * g8 + 5]); w.w = pk2(bf2f(v[8 * g8 + 6]) * e[8 * g8 + 6], bf2f(v[8 * g8 + 7]) * e[8 * g8 + 7]);
                    *(u32x4*)(dst2 + t0 + 8 * g8) = w; }
            }
        }
        for (int cc = tid; cc < 1024; cc += NTHR) {
            const float* cw = p.mlstm_conv + (size_t)l * 4 * 1024 + cc;
            const float w0 = cw[0], w1 = cw[1024], w2 = cw[2048], w3 = cw[3072];
            const bf16_t* __restrict__ src = Z + ZC_QML + cc;
            unsigned short xv[67];
#pragma unroll
            for (int j = 0; j < 67; ++j) { const int tt = t0 - 3 + j; xv[j] = (tt >= 0) ? src[(size_t)tt * ZLD] : (unsigned short)0; }
            const float qs = cc < 512 ? 0.08838834764831845f : 1.f;
            bf16_t* dq = (bf16_t*)(ws + O_QKC) + (size_t)t0 * 1024 + cc;
            const int kc = cc - 512, h = (kc >= 0) ? (kc >> 7) : 0; const LAS float* e = eL + h * 64; float su = 0.f;
#pragma unroll
            for (int g8 = 0; g8 < 8; ++g8) {
                unsigned short ob[8];
#pragma unroll
                for (int j = 0; j < 8; ++j) { const int t = 8 * g8 + j;
                    const float y = w0 * bf2f(xv[t]) + w1 * bf2f(xv[t + 1]) + w2 * bf2f(xv[t + 2]) + w3 * bf2f(xv[t + 3]);
                    ob[j] = f2bf(y * sigmoidf_(y) * qs); dq[(size_t)t * 1024] = ob[j]; }
                if (cc >= 512) {
                    u32x4 w; w.x = (unsigned)ob[0] | ((unsigned)ob[1] << 16); w.y = (unsigned)ob[2] | ((unsigned)ob[3] << 16); w.z = (unsigned)ob[4] | ((unsigned)ob[5] << 16); w.w = (unsigned)ob[6] | ((unsigned)ob[7] << 16);
                    *(u32x4*)((bf16_t*)(ws + O_KTM) + (size_t)kc * S + t0 + 8 * g8) = w;
#pragma unroll
                    for (int j = 0; j < 8; ++j) su += e[8 * g8 + j] * bf2f(ob[j]);
                }
            }
            if (cc >= 512) ((float*)(ws + O_UN))[(size_t)c * 512 + kc] = su;
        }
        for (int cc = tid; cc < 512; cc += NTHR) {
            const int g = cc >> 7, win = 2 << g;
            const bf16_t* __restrict__ src = Z + cc;
            unsigned short xv[79];
#pragma unroll
            for (int j = 0; j < 79; ++j) { const int tt = t0 - 15 + j; xv[j] = (tt >= 0 && j >= 16 - win) ? src[(size_t)tt * ZLD] : (unsigned short)0; }
            float sacc = 0.f;
#pragma unroll
            for (int j = 0; j < 15; ++j) sacc += bf2f(xv[j]);
            bf16_t* dp = (bf16_t*)(ws + O_POOL) + (size_t)t0 * 512 + cc;
#pragma unroll
            for (int j = 0; j < 64; ++j) { const int t = t0 + j; const float x0 = bf2f(xv[15 + j]); sacc += x0;
                const int cnt = (t + 1) < win ? (t + 1) : win; dp[(size_t)j * 512] = f2bf(sacc / (float)cnt - x0);
                const float lv = (g == 0) ? bf2f(xv[15 + j - 1]) : (g == 1) ? bf2f(xv[15 + j - 3]) : (g == 2) ? bf2f(xv[15 + j - 7]) : bf2f(xv[15 + j - 15]);
                sacc -= lv; }
        }
        __syncthreads();
    }
}

#define MFMA32(a, b, c) __builtin_amdgcn_mfma_f32_32x32x16_bf16((a), (b), (c), 0, 0, 0)
template <bool FOX>
__device__ __forceinline__ void attn_unit(int h, int qb, const bf16_t* Z, const bf16_t* Vt, const float* cl2, const LAS float* P2L, float sink2, bf16_t* ybr, int lane) {
    const int q = lane & 31, hi = lane >> 5, t0 = qb * 32, t = t0 + q;
    const int qcol = FOX ? (ZC_QFOX + h * 64) : (ZC_QSWA + h * 64);
    const int kcol = FOX ? (ZC_KFOX + h * 64) : (ZC_KSWA + (h >> 2) * 64);
    const int ocol = FOX ? (1536 + h * 64) : (512 + h * 64);
    const bf16_t* Vth = Vt + (size_t)((FOX ? h : (h >> 2)) * 64 + q) * S + 16 * hi;
    const int pim = 16 * ((q >> 2) & 1) + 4 * (q >> 3) + (q & 3);
    const bf16_t* Kp = Z + (size_t)pim * ZLD + kcol + 8 * hi;
    const float* clh = cl2 + (size_t)h * S + 16 * hi;
    bf16x8 qf[4];
#pragma unroll
    for (int d0 = 0; d0 < 4; ++d0) qf[d0] = *(const bf16x8*)(Z + (size_t)t * ZLD + qcol + 16 * d0 + 8 * hi);
    const int kv_lo = FOX ? 0 : (t0 >= 128 ? t0 - 128 : 0);
    const int ntiles = (t0 - kv_lo) / 32 + 1;
    float mhat = FOX ? 0.f : sink2, l = FOX ? 0.f : (hi == 0 ? 1.f : 0.f);
    float cq = 0.f; if (FOX) cq = cl2[(size_t)h * S + t] + P2L[(t >> 6) * 8 + h];
    f32x16 o0, o1;
#pragma unroll
    for (int r = 0; r < 16; ++r) { o0[r] = 0.f; o1[r] = 0.f; }
    bf16x8 kf[4], vf[4]; f32x4 ck[4];
    {
        const int kv0 = kv_lo;
#pragma unroll
        for (int d0 = 0; d0 < 4; ++d0) kf[d0] = *(const bf16x8*)(Kp + (size_t)kv0 * ZLD + 16 * d0);
#pragma unroll
        for (int i = 0; i < 4; ++i) vf[i] = *(const bf16x8*)(Vth + (size_t)(i >> 1) * 32 * S + kv0 + 8 * (i & 1));
        if (FOX) {
#pragma unroll
            for (int i = 0; i < 4; ++i) ck[i] = *(const f32x4*)(clh + kv0 + 4 * i);
        }
    }
    for (int it = 0; it < ntiles; ++it) {
        const int kv0 = kv_lo + 32 * it;
        const int itn = (it + 1 < ntiles) ? it + 1 : it; const int kvn = kv_lo + 32 * itn;
        bf16x8 kfn[4], vfn[4]; f32x4 ckn[4];
#pragma unroll
        for (int d0 = 0; d0 < 4; ++d0) kfn[d0] = *(const bf16x8*)(Kp + (size_t)kvn * ZLD + 16 * d0);
#pragma unroll
        for (int i = 0; i < 4; ++i) vfn[i] = *(const bf16x8*)(Vth + (size_t)(i >> 1) * 32 * S + kvn + 8 * (i & 1));
        if (FOX) {
#pragma unroll
            for (int i = 0; i < 4; ++i) ckn[i] = *(const f32x4*)(clh + kvn + 4 * i);
        }
        f32x16 acc;
        if (FOX) {
            const float base = (cq - P2L[(kv0 >> 6) * 8 + h]) - mhat;
#pragma unroll
            for (int r = 0; r < 16; ++r) acc[r] = base - ck[r >> 2][r & 3];
        } else {
#pragma unroll
            for (int r = 0; r < 16; ++r) acc[r] = -mhat;
        }
#pragma unroll
        for (int d0 = 0; d0 < 4; ++d0) acc = MFMA32(kf[d0], qf[d0], acc);
        if (FOX) {
            if (it == ntiles - 1) {
#pragma unroll
                for (int r = 0; r < 16; ++r) if (16 * hi + r > q) acc[r] = -INFINITY;
            }
        } else {
#pragma unroll
            for (int r = 0; r < 16; ++r) { const int kv = kv0 + 16 * hi + r; if (kv > t || kv + 127 < t) acc[r] = -INFINITY; }
        }
        float mt = acc[0];
#pragma unroll
        for (int r = 1; r < 16; ++r) mt = fmaxf(mt, acc[r]);
        mt = fmaxf(mt, __shfl_xor(mt, 32));
        const bool first = FOX && (it == 0);
        if (first || __any(mt > 8.f)) {
            const float delta = first ? mt : fmaxf(mt, 0.f);
            mhat += delta;
            const float al = first ? 1.f : __builtin_amdgcn_exp2f(-delta);
            l *= al;
#pragma unroll
            for (int r = 0; r < 16; ++r) { acc[r] -= delta; o0[r] *= al; o1[r] *= al; }
        }
        float ps = 0.f;
#pragma unroll
        for (int r = 0; r < 16; ++r) { acc[r] = __builtin_amdgcn_exp2f(acc[r]); ps += acc[r]; }
        l += ps;
        u32x4 w0, w1;
        w0.x = pk2(acc[0], acc[1]); w0.y = pk2(acc[2], acc[3]); w0.z = pk2(acc[4], acc[5]); w0.w = pk2(acc[6], acc[7]);
        w1.x = pk2(acc[8], acc[9]); w1.y = pk2(acc[10], acc[11]); w1.z = pk2(acc[12], acc[13]); w1.w = pk2(acc[14], acc[15]);
        const bf16x8 pb0 = __builtin_bit_cast(bf16x8, w0), pb1 = __builtin_bit_cast(bf16x8, w1);
        o0 = MFMA32(vf[0], pb0, o0); o0 = MFMA32(vf[1], pb1, o0);
        o1 = MFMA32(vf[2], pb0, o1); o1 = MFMA32(vf[3], pb1, o1);
#pragma unroll
        for (int i = 0; i < 4; ++i) { kf[i] = kfn[i]; vf[i] = vfn[i]; if (FOX) ck[i] = ckn[i]; }
    }
    l += __shfl_xor(l, 32);
    const float inv = 1.f / l;
    bf16_t* op = ybr + (size_t)t * DM + ocol + 4 * hi;
#pragma unroll
    for (int g = 0; g < 4; ++g) {
        u32x2 w; w.x = pk2(o0[4 * g] * inv, o0[4 * g + 1] * inv); w.y = pk2(o0[4 * g + 2] * inv, o0[4 * g + 3] * inv); *(u32x2*)(op + 8 * g) = w;
        w.x = pk2(o1[4 * g] * inv, o1[4 * g + 1] * inv); w.y = pk2(o1[4 * g + 2] * inv, o1[4 * g + 3] * inv); *(u32x2*)(op + 32 + 8 * g) = w;
    }
}


__device__ __forceinline__ void fox_unit(int h, int Q, const bf16_t* Z, const bf16_t* Vt, const LAS float* clL, const LAS float* P2L, bf16_t* ybr, LAS unsigned char* lds, int wave, int lane) {
    const int q = lane & 31, hi = lane >> 5, t = Q * 256 + wave * 32 + q;
    const int kx = (q >> 1) & 7;
    const int my_last = 4 * Q + (wave >> 1), ntile = 4 * Q + 4;
    const int P = wave * 64 + lane, lrow = P >> 3, piece = (P & 7) ^ ((lrow >> 1) & 7);
    const int lr = lrow & 31, grow = 32 * (lrow >> 5) + 16 * ((lr >> 2) & 1) + 4 * (lr >> 3) + (lr & 3);
    const bf16_t* ksrc = Z + (size_t)grow * ZLD + ZC_KFOX + h * 64 + piece * 8;
    const bf16_t* vsrc = Vt + (size_t)(h * 64 + lrow) * S + piece * 8;
    const LAS float* clh = clL + 16 * hi;
    bf16x8 qf[4];
#pragma unroll
    for (int d0 = 0; d0 < 4; ++d0) qf[d0] = *(const bf16x8*)(Z + (size_t)t * ZLD + ZC_QFOX + h * 64 + 16 * d0 + 8 * hi);
    const float cq = clL[t] + P2L[(t >> 6) * 8 + h];
    float mhat = 0.f, l = 0.f;
    f32x16 o0, o1;
#pragma unroll
    for (int r = 0; r < 16; ++r) { o0[r] = 0.f; o1[r] = 0.f; }
    asm volatile("s_waitcnt vmcnt(0)" ::: "memory");
    asm volatile("" : "+v"(qf[0]), "+v"(qf[1]), "+v"(qf[2]), "+v"(qf[3]));
    __builtin_amdgcn_global_load_lds((const unsigned*)ksrc, (LAS unsigned*)(lds + wave * 1024), 16, 0, 0);
    __builtin_amdgcn_global_load_lds((const unsigned*)vsrc, (LAS unsigned*)(lds + 8192 + wave * 1024), 16, 0, 0);
    __builtin_amdgcn_global_load_lds((const unsigned*)(ksrc + (size_t)64 * ZLD), (LAS unsigned*)(lds + 16384 + wave * 1024), 16, 0, 0);
    __builtin_amdgcn_global_load_lds((const unsigned*)(vsrc + 64), (LAS unsigned*)(lds + 16384 + 8192 + wave * 1024), 16, 0, 0);
    const int koff = q * 128, voff = 8192 + q * 128;
    int s_cur = 0, s_nxt2 = 2 * 16384;
    for (int i = 0; i < ntile; ++i) {
        if (i + 1 < ntile) asm volatile("s_waitcnt vmcnt(2) lgkmcnt(0)\n\ts_barrier" ::: "memory");
        else asm volatile("s_waitcnt vmcnt(0) lgkmcnt(0)\n\ts_barrier" ::: "memory");
        if (i + 2 < ntile) {
            const int kvn = 64 * (i + 2);
            LAS unsigned char* dst = lds + s_nxt2 + wave * 1024;
            __builtin_amdgcn_global_load_lds((const unsigned*)(ksrc + (size_t)kvn * ZLD), (LAS unsigned*)dst, 16, 0, 0);
            __builtin_amdgcn_global_load_lds((const unsigned*)(vsrc + kvn), (LAS unsigned*)(dst + 8192), 16, 0, 0);
        }
        const bool active = (i <= my_last);
        f32x16 a0, a1;
        if (active) {
            const float base = (cq - P2L[i * 8 + h]) - mhat;
            const LAS float* cp = clh + 64 * i;
#pragma unroll
            for (int j = 0; j < 4; ++j) { const f32x4 c0 = *(const LAS f32x4*)(cp + 4 * j), c1 = *(const LAS f32x4*)(cp + 32 + 4 * j);
#pragma unroll
                for (int e = 0; e < 4; ++e) { a0[4 * j + e] = base - c0[e]; a1[4 * j + e] = base - c1[e]; } }
        }
        if (active) {
            const LAS unsigned char* sl = lds + s_cur;
            bf16x8 kfa[4], kfb[4];
#pragma unroll
            for (int d0 = 0; d0 < 4; ++d0) { const int so = ((2 * d0 + hi) ^ kx) * 16; kfa[d0] = *(const LAS bf16x8*)(sl + koff + so); kfb[d0] = *(const LAS bf16x8*)(sl + 4096 + koff + so); }
            __builtin_amdgcn_s_setprio(1);
#pragma unroll
            for (int d0 = 0; d0 < 4; ++d0) { a0 = MFMA32(kfa[d0], qf[d0], a0); a1 = MFMA32(kfb[d0], qf[d0], a1); }
            __builtin_amdgcn_s_setprio(0);
            if (i == my_last) {
#pragma unroll
                for (int r = 0; r < 16; ++r) { const int kv = 64 * i + 16 * hi + r; if (kv > t) a0[r] = -INFINITY; if (kv + 32 > t) a1[r] = -INFINITY; }
            }
            float mt = fmaxf(a0[0], a1[0]);
#pragma unroll
            for (int r = 1; r < 16; ++r) mt = fmaxf(mt, fmaxf(a0[r], a1[r]));
            mt = fmaxf(mt, __shfl_xor(mt, 32));
            const bool first = (i == 0);
            if (first || __any(mt > 30.f)) {
                const float delta = first ? mt : (mt > 0.f ? mt + 30.f : 0.f);
                mhat += delta;
                const float al = first ? 1.f : __builtin_amdgcn_exp2f(-delta);
                l *= al;
#pragma unroll
                for (int r = 0; r < 16; ++r) { a0[r] -= delta; a1[r] -= delta; o0[r] *= al; o1[r] *= al; }
            }
            float ps = 0.f;
#pragma unroll
            for (int r = 0; r < 16; ++r) { a0[r] = __builtin_amdgcn_exp2f(a0[r]); a1[r] = __builtin_amdgcn_exp2f(a1[r]); ps += a0[r] + a1[r]; }
            l += ps;
            u32x4 w0, w1, w2, w3;
            w0.x = pk2(a0[0], a0[1]); w0.y = pk2(a0[2], a0[3]); w0.z = pk2(a0[4], a0[5]); w0.w = pk2(a0[6], a0[7]);
            w1.x = pk2(a0[8], a0[9]); w1.y = pk2(a0[10], a0[11]); w1.z = pk2(a0[12], a0[13]); w1.w = pk2(a0[14], a0[15]);
            w2.x = pk2(a1[0], a1[1]); w2.y = pk2(a1[2], a1[3]); w2.z = pk2(a1[4], a1[5]); w2.w = pk2(a1[6], a1[7]);
            w3.x = pk2(a1[8], a1[9]); w3.y = pk2(a1[10], a1[11]); w3.z = pk2(a1[12], a1[13]); w3.w = pk2(a1[14], a1[15]);
            const bf16x8 pb0 = __builtin_bit_cast(bf16x8, w0), pb1 = __builtin_bit_cast(bf16x8, w1), pb2 = __builtin_bit_cast(bf16x8, w2), pb3 = __builtin_bit_cast(bf16x8, w3);
            const int v00 = ((2 * hi) ^ kx) * 16, v01 = ((2 * hi + 1) ^ kx) * 16, v10 = ((4 + 2 * hi) ^ kx) * 16, v11 = ((5 + 2 * hi) ^ kx) * 16;
            const bf16x8 va0 = *(const LAS bf16x8*)(sl + voff + v00), vb0 = *(const LAS bf16x8*)(sl + voff + 4096 + v00), va1 = *(const LAS bf16x8*)(sl + voff + v01), vb1 = *(const LAS bf16x8*)(sl + voff + 4096 + v01);
            const bf16x8 va2 = *(const LAS bf16x8*)(sl + voff + v10), vb2 = *(const LAS bf16x8*)(sl + voff + 4096 + v10), va3 = *(const LAS bf16x8*)(sl + voff + v11), vb3 = *(const LAS bf16x8*)(sl + voff + 4096 + v11);
            __builtin_amdgcn_s_setprio(1);
            o0 = MFMA32(va0, pb0, o0); o1 = MFMA32(vb0, pb0, o1);
            o0 = MFMA32(va1, pb1, o0); o1 = MFMA32(vb1, pb1, o1);
            o0 = MFMA32(va2, pb2, o0); o1 = MFMA32(vb2, pb2, o1);
            o0 = MFMA32(va3, pb3, o0); o1 = MFMA32(vb3, pb3, o1);
            __builtin_amdgcn_s_setprio(0);
        }
        s_cur = (s_cur == 2 * 16384) ? 0 : s_cur + 16384; s_nxt2 = (s_nxt2 == 2 * 16384) ? 0 : s_nxt2 + 16384;
    }
    l += __shfl_xor(l, 32);
    const float inv = 1.f / l;
    bf16_t* op = ybr + (size_t)t * DM + 1536 + h * 64 + 4 * hi;
#pragma unroll
    for (int g = 0; g < 4; ++g) {
        u32x2 w; w.x = pk2(o0[4 * g] * inv, o0[4 * g + 1] * inv); w.y = pk2(o0[4 * g + 2] * inv, o0[4 * g + 3] * inv); *(u32x2*)(op + 8 * g) = w;
        w.x = pk2(o1[4 * g] * inv, o1[4 * g + 1] * inv); w.y = pk2(o1[4 * g + 2] * inv, o1[4 * g + 3] * inv); *(u32x2*)(op + 32 + 8 * g) = w;
    }
    asm volatile("s_waitcnt vmcnt(0) lgkmcnt(0)\n\ts_barrier" ::: "memory");
}

__device__ __forceinline__ void phase_mix1(const Params& p, int l, LAS unsigned char* lds, int wave_, int lane_, int G) {
    const int lane = lane_id(), wave = launder_s(wave_); (void)lane_;
    unsigned char* ws = launder_p(p.ws);
    LAS float* P2L = (LAS float*)(lds + LDS_P2);
    {
        const float* tot = (const float*)(ws + O_TOT2); const int h = wave;
        const float a0 = tot[(4 * lane) * 8 + h], a1 = tot[(4 * lane + 1) * 8 + h], a2 = tot[(4 * lane + 2) * 8 + h], a3 = tot[(4 * lane + 3) * 8 + h];
        const float incl = scan_sum(a0 + a1 + a2 + a3, lane); const float ex = incl - (a0 + a1 + a2 + a3);
        P2L[(4 * lane) * 8 + h] = ex; P2L[(4 * lane + 1) * 8 + h] = ex + a0; P2L[(4 * lane + 2) * 8 + h] = ex + a0 + a1; P2L[(4 * lane + 3) * 8 + h] = ex + a0 + a1 + a2;
    }
    __syncthreads();
    if (DBG_MIX & 1) {
        pg8::SimpleSched Sd{(const char*)(ws + O_POOL), (const char*)(ws + OW_BD), 512, 512, 64, 2, G, (int)blockIdx.x, 8};
        pg8::EpiPool E{(bf16_t*)(ws + O_YBR), p.pool_scale + (size_t)l * 512};
        pg8::gemm_phase(lds, 512, 512, Sd, E, wave);
    }
    const int gw = blockIdx.x * NWAVES + wave, NGW = G * NWAVES;
    const int q = lane & 31, hi = lane >> 5;
    if (DBG_MIX & 2) for (int task = gw; task < 4096; task += NGW) {
        const int vb = task & 3, h = (task >> 2) & 3, c = task >> 4;
        const bf16_t* Ap = (const bf16_t*)(ws + O_VTW) + (size_t)(h * 128 + 32 * vb + q) * S + c * 64 + 8 * hi;
        bf16x8 af[4];
#pragma unroll
        for (int ks = 0; ks < 4; ++ks) af[ks] = *(const bf16x8*)(Ap + 16 * ks);
        float* Uo = (float*)(ws + O_U) + ((size_t)(c * 4 + h) * 128 + 32 * vb) * 128;
#pragma unroll
        for (int kb = 0; kb < 4; ++kb) {
            const bf16_t* Bp = (const bf16_t*)(ws + O_KTM) + (size_t)(h * 128 + 32 * kb + q) * S + c * 64 + 8 * hi;
            f32x16 acc;
#pragma unroll
            for (int r = 0; r < 16; ++r) acc[r] = 0.f;
#pragma unroll
            for (int ks = 0; ks < 4; ++ks) acc = MFMA32(af[ks], *(const bf16x8*)(Bp + 16 * ks), acc);
#pragma unroll
            for (int r = 0; r < 16; ++r) Uo[(size_t)crow(r, hi) * 128 + 32 * kb + q] = acc[r];
        }
    }
    if (DBG_MIX & 4) for (int task = gw; task < 4096; task += NGW) {
        const int h = task & 7, qb = task >> 3;
        attn_unit<false>(h, qb, (const bf16_t*)(ws + O_R1), (const bf16_t*)(ws + O_VTS), nullptr, P2L, p.swa_sinks[l * 8 + h] * LOG2E, (bf16_t*)(ws + O_YBR), lane);
    }
    __syncthreads();
    if (DBG_MIX & 8) {
        const int h = blockIdx.x & 7;
        LAS float* clL = (LAS float*)(lds + 49152);
        { const f32x4* src = (const f32x4*)((const float*)(ws + O_CL2) + (size_t)h * S); const int tid = wave * 64 + lane;
#pragma unroll
          for (int j = 0; j < 8; ++j) *(LAS f32x4*)(clL + 4 * (tid + j * NTHR)) = src[tid + j * NTHR]; }
        __syncthreads();
        for (int pr = (blockIdx.x >> 3); pr < 32; pr += (G >> 3)) {
            fox_unit(h, 63 - pr, (const bf16_t*)(ws + O_R1), (const bf16_t*)(ws + O_VTF), clL, P2L, (bf16_t*)(ws + O_YBR), lds, wave, lane);
            fox_unit(h, pr, (const bf16_t*)(ws + O_R1), (const bf16_t*)(ws + O_VTF), clL, P2L, (bf16_t*)(ws + O_YBR), lds, wave, lane);
        }
    }
}

__device__ __forceinline__ void phase_scan(const Params& p, LAS unsigned char* lds, int wave_, int G) {
    unsigned char* ws = launder_p(p.ws); const int tid = launder_s(wave_) * 64 + lane_id();
    if ((int)blockIdx.x * NTHR >= 4 * 16512) return;
    LAS float* decL = (LAS float*)lds; LAS float* sclL = decL + 1024; LAS float* blL = sclL + 1024; LAS float* dmL = blL + 1024;
    for (int i = tid; i < 1024; i += NTHR) { blL[i] = ((const float*)(ws + O_BLC))[i]; dmL[i] = ((const float*)(ws + O_DMC))[i]; }
    __syncthreads();
    if (tid < 4) {
        const int h = tid; float m = 0.f;
        for (int c = 0; c < 256; ++c) {
            const float bl = blL[c * 4 + h], dm = dmL[c * 4 + h]; const float mn = fmaxf(bl + m, bl + dm);
            decL[c * 4 + h] = __expf(bl + m - mn); sclL[c * 4 + h] = __expf(bl + dm - mn);
            if (blockIdx.x == 0) ((float*)(ws + O_MST))[c * 4 + h] = m;
            m = mn;
        }
    }
    __syncthreads();
    const int e = blockIdx.x * NTHR + tid;
    if (e < 4 * 16512) {
        const int h = e / 16512, idx = e % 16512;
        float st = 0.f;
        if (idx < 16384) {
            const float* src = (const float*)(ws + O_U) + (size_t)h * 16384 + idx; bf16_t* dst = (bf16_t*)(ws + O_CST) + (size_t)h * 16384 + idx;
            for (int c0 = 0; c0 < 256; c0 += 32) {
                float u[32];
#pragma unroll
                for (int j = 0; j < 32; ++j) u[j] = src[(size_t)(c0 + j) * 65536];
#pragma unroll
                for (int j = 0; j < 32; ++j) { dst[(size_t)(c0 + j) * 65536] = f2bf(st); st = decL[(c0 + j) * 4 + h] * st + sclL[(c0 + j) * 4 + h] * u[j]; }
            }
        } else {
            const int k = idx - 16384;
            const float* src = (const float*)(ws + O_UN) + h * 128 + k; float* dst = (float*)(ws + O_NST) + h * 128 + k;
            for (int c0 = 0; c0 < 256; c0 += 8) {
                float u[8];
#pragma unroll
                for (int j = 0; j < 8; ++j) u[j] = src[(size_t)(c0 + j) * 512];
#pragma unroll
                for (int j = 0; j < 8; ++j) { dst[(size_t)(c0 + j) * 512] = st; st = decL[(c0 + j) * 4 + h] * st + sclL[(c0 + j) * 4 + h] * u[j]; }
            }
        }
    }
}

__device__ __forceinline__ void phase_mlout(const Params& p, int wave_, int lane_, int G) {
    const int lane = lane_id(), wave = launder_s(wave_); (void)lane_;
    unsigned char* ws = launder_p(p.ws);
    const int gw = blockIdx.x * NWAVES + wave, NGW = G * NWAVES;
    const int q = lane & 31, hi = lane >> 5;
    const int pim = 16 * ((q >> 2) & 1) + 4 * (q >> 3) + (q & 3);
    const bf16_t* QKC = (const bf16_t*)(ws + O_QKC); const bf16_t* Z = (const bf16_t*)(ws + O_R1);
    for (int task = gw; task < 2048; task += NGW) {
        const int tb = task & 1, h = (task >> 1) & 3, c = task >> 3;
        const int t = c * 64 + 32 * tb + q;
        bf16x8 qf[8];
#pragma unroll
        for (int kk = 0; kk < 8; ++kk) qf[kk] = *(const bf16x8*)(QKC + (size_t)t * 1024 + h * 128 + 16 * kk + 8 * hi);
        const float m_c = ((const float*)(ws + O_MST))[c * 4 + h];
        const float a_t = ((const float*)(ws + O_MLA))[h * S + t], b_t = ((const float*)(ws + O_MLB))[h * S + t];
        const float Mt = fmaxf(m_c, a_t), w_inter = __expf(m_c - Mt);
        f32x16 o[4];
#pragma unroll
        for (int vb = 0; vb < 4; ++vb) {
#pragma unroll
            for (int r = 0; r < 16; ++r) o[vb][r] = 0.f;
            const bf16_t* Cp = (const bf16_t*)(ws + O_CST) + ((size_t)(c * 4 + h) * 128 + 32 * vb + q) * 128 + 8 * hi;
#pragma unroll
            for (int kk = 0; kk < 8; ++kk) o[vb] = MFMA32(*(const bf16x8*)(Cp + 16 * kk), qf[kk], o[vb]);
#pragma unroll
            for (int r = 0; r < 16; ++r) o[vb][r] *= w_inter;
        }
        float nq = 0.f;
        {
            const float* np = (const float*)(ws + O_NST) + (size_t)(c * 4 + h) * 128 + 8 * hi;
#pragma unroll
            for (int kk = 0; kk < 8; ++kk) { const f32x4 n0 = *(const f32x4*)(np + 16 * kk), n1 = *(const f32x4*)(np + 16 * kk + 4);
                const bf16x8 qq = qf[kk];
                nq += n0[0] * bf2f((unsigned short)qq[0]) + n0[1] * bf2f((unsigned short)qq[1]) + n0[2] * bf2f((unsigned short)qq[2]) + n0[3] * bf2f((unsigned short)qq[3])
                    + n1[0] * bf2f((unsigned short)qq[4]) + n1[1] * bf2f((unsigned short)qq[5]) + n1[2] * bf2f((unsigned short)qq[6]) + n1[3] * bf2f((unsigned short)qq[7]); }
            nq += __shfl_xor(nq, 32);
        }
        float den = 0.f;
        for (int sb = 0; sb <= tb; ++sb) {
            const int s0 = c * 64 + 32 * sb;
            f32x16 acc;
#pragma unroll
            for (int r = 0; r < 16; ++r) acc[r] = 0.f;
            const bf16_t* Kp = QKC + (size_t)(s0 + pim) * 1024 + 512 + h * 128 + 8 * hi;
#pragma unroll
            for (int kk = 0; kk < 8; ++kk) acc = MFMA32(*(const bf16x8*)(Kp + 16 * kk), qf[kk], acc);
            const float* dp = (const float*)(ws + O_MLD) + (size_t)h * S + s0 + 16 * hi;
#pragma unroll
            for (int r = 0; r < 16; ++r) { const int s = s0 + 16 * hi + r; const float w = (s <= t) ? __expf(dp[r] - Mt) : 0.f; acc[r] *= w; den += acc[r]; }
            u32x4 w0, w1;
            w0.x = pk2(acc[0], acc[1]); w0.y = pk2(acc[2], acc[3]); w0.z = pk2(acc[4], acc[5]); w0.w = pk2(acc[6], acc[7]);
            w1.x = pk2(acc[8], acc[9]); w1.y = pk2(acc[10], acc[11]); w1.z = pk2(acc[12], acc[13]); w1.w = pk2(acc[14], acc[15]);
            const bf16x8 pb0 = __builtin_bit_cast(bf16x8, w0), pb1 = __builtin_bit_cast(bf16x8, w1);
#pragma unroll
            for (int vb = 0; vb < 4; ++vb) {
                const bf16_t* Vp = (const bf16_t*)(ws + O_VTM) + (size_t)(h * 128 + 32 * vb + q) * S + s0 + 16 * hi;
                o[vb] = MFMA32(*(const bf16x8*)Vp, pb0, o[vb]); o[vb] = MFMA32(*(const bf16x8*)(Vp + 8), pb1, o[vb]);
            }
        }
        den += __shfl_xor(den, 32);
        den += w_inter * nq;
        const float hd = fmaxf(fabsf(den), __expf(-(b_t + Mt))); const float inv = 1.f / hd;
        const bf16_t* opre = Z + (size_t)t * ZLD + ZC_OML + h * 128 + 4 * hi;
        bf16_t* op = (bf16_t*)(ws + O_YBR) + (size_t)t * DM + 1024 + h * 128 + 4 * hi;
#pragma unroll
        for (int vb = 0; vb < 4; ++vb)
#pragma unroll
            for (int g = 0; g < 4; ++g) {
                const u32x2 og = *(const u32x2*)(opre + 32 * vb + 8 * g);
                u32x2 w; w.x = pk2(sigmoidf_(bflo(og.x)) * o[vb][4 * g] * inv, sigmoidf_(bfhi(og.x)) * o[vb][4 * g + 1] * inv);
                w.y = pk2(sigmoidf_(bflo(og.y)) * o[vb][4 * g + 2] * inv, sigmoidf_(bfhi(og.y)) * o[vb][4 * g + 3] * inv);
                *(u32x2*)(op + 32 * vb + 8 * g) = w;
            }
    }
}


__device__ __forceinline__ void dbg_dump(float* out, const void* src, int mode, int wave, int G) {
    const int gt = blockIdx.x * NTHR + wave * 64 + lane_id(), NGT = G * NTHR;
    for (int i = gt; i < S * DM; i += NGT) out[i] = mode ? bf2f(((const bf16_t*)src)[i]) : ((const float*)src)[i];
}
#define DBG_AT(k, off, mode) do { if (DBG_STOP == (k) && l == 0) { GRID_SYNC(15); dbg_dump(p.out, p.ws + (off), (mode), wave, G); return; } } while (0)
#define XB_TMO      128
#define XB_XCNT(j)  (256  + 64 * (j))
#define XB_XSUB(j)  (1280 + 64 * (j))
#define XB_XGEN(j)  (2304 + 64 * (j))
#define XB_TOP      3328
#define XB_TOPGEN   3392
#define XB_SPIN_CAP (1u << 22)
__device__ __forceinline__ unsigned xb_ld(unsigned* p)              { return __hip_atomic_load(p, __ATOMIC_RELAXED, __HIP_MEMORY_SCOPE_AGENT); }
__device__ __forceinline__ unsigned xb_add(unsigned* p, unsigned v) { return __hip_atomic_fetch_add(p, v, __ATOMIC_RELAXED, __HIP_MEMORY_SCOPE_AGENT); }
__device__ __forceinline__ unsigned xb_xcc_id() { return (unsigned)__builtin_amdgcn_s_getreg((3 << 11) | 20) & 0xFu; }
#define XB_SPIN(cond, bar) do { unsigned _sp = 0; while (cond) { __builtin_amdgcn_s_sleep(1); \
    if ((++_sp & 255u) == 0u) { if (xb_ld(&(bar)[XB_TMO])) break; if (_sp > XB_SPIN_CAP) { atomicAdd(&(bar)[XB_TMO], 1u); break; } } } } while (0)
__device__ __forceinline__ void xcd_census(unsigned* bar, unsigned x, unsigned G, unsigned& nloc, unsigned& nx) {
    unsigned sum, cnt, mine, sp = 0u;
    for (;;) {
        sum = 0u; cnt = 0u; mine = 0u;
#pragma unroll
        for (unsigned j = 0; j < 16; ++j) { const unsigned c = xb_ld(&bar[XB_XCNT(j)]); sum += c; cnt += (c > 0u) ? 1u : 0u; mine = (j == x) ? c : mine; }
        if (sum == G) break;
        __builtin_amdgcn_s_sleep(1);
        if ((++sp & 255u) == 0u) { if (xb_ld(&bar[XB_TMO])) break; if (sp > XB_SPIN_CAP) { atomicAdd(&bar[XB_TMO], 1u); break; } }
    }
    nloc = mine > 0u ? mine : 1u; nx = cnt > 0u ? cnt : 1u;
}
__device__ __forceinline__ void grid_barrier(unsigned* bar, volatile LAS unsigned* st, unsigned G, int wave) {
    asm volatile("s_waitcnt vmcnt(0) lgkmcnt(0)" ::: "memory");
    __syncthreads();
    if (wave == 0 && lane_id() == 0) {
        const unsigned x = xb_xcc_id();
        unsigned nloc = st[0], nx = st[1];
        if (nloc == 0u) { xcd_census(bar, x, G, nloc, nx); st[0] = nloc; st[1] = nx; }
        const unsigned old = xb_add(&bar[XB_XSUB(x)], 1u);
        const unsigned gen = old / nloc;
        if (old + 1u == (gen + 1u) * nloc) {
            __builtin_amdgcn_fence(__ATOMIC_RELEASE, "agent");
            asm volatile("s_waitcnt vmcnt(0)" ::: "memory");
            const unsigned og = xb_add(&bar[XB_TOP], 1u);
            const unsigned tg = og / nx;
            if (og + 1u == (tg + 1u) * nx) xb_add(&bar[XB_TOPGEN], 1u);
            else XB_SPIN(xb_ld(&bar[XB_TOPGEN]) == tg, bar);
            __builtin_amdgcn_fence(__ATOMIC_ACQUIRE, "agent");
            xb_add(&bar[XB_XGEN(x)], 1u);
            asm volatile("s_waitcnt vmcnt(0)" ::: "memory");
        } else {
            XB_SPIN(xb_ld(&bar[XB_XGEN(x)]) == gen, bar);
            __builtin_amdgcn_fence(__ATOMIC_ACQUIRE, "agent");
            asm volatile("s_waitcnt vmcnt(0)" ::: "memory");
        }
    }
    __syncthreads();
}
#define GRID_SYNC(k) grid_barrier((unsigned*)(p.ws + O_CTL), (volatile LAS unsigned*)(lds + LDS_MISC + 2048), (unsigned)G, wave)
__global__ void __launch_bounds__(NTHR, 2) fwd_megakernel(Params p) {
    extern __shared__ __attribute__((aligned(16))) unsigned char lds_raw[];
    LAS unsigned char* lds = (LAS unsigned char*)lds_raw;
    cg::grid_group grid = cg::this_grid();
    const int wave = __builtin_amdgcn_readfirstlane((int)threadIdx.x >> 6), lane = 0;
    const int G = gridDim.x, bx = blockIdx.x;
    grid.sync();
    if (wave == 0 && lane_id() == 0) { volatile LAS unsigned* st = (volatile LAS unsigned*)(lds + LDS_MISC + 2048); st[0] = 0u; st[1] = 0u; (void)xb_add((unsigned*)(p.ws + O_CTL) + XB_XCNT(xb_xcc_id()), 1u); }
    __syncthreads();

    for (int l = 0; l < NL; ++l) {
        if (l == 0) { REPS(3) phase_weights(p, 0, lds, wave, lane, G);
            GRID_SYNC(0); }
        REPS(2) { unsigned char* ws = launder_p(p.ws); pg8::SimpleSched Sd{(const char*)(ws + O_HB), (const char*)(ws + OW_F1A), DM, DM, 64, 44, G, bx, 32}; pg8::EpiSwiGLU E{(bf16_t*)(ws + O_R1)}; pg8::gemm_phase(lds, DM, DM, Sd, E, wave); }
        GRID_SYNC(1);
        if (l == 0) { unsigned char* ws = launder_p(p.ws); pg8::SimpleSched Sd{(const char*)(ws + O_R1), (const char*)(ws + OW_F1B), FF, FF, 64, 8, G, bx, 88}; pg8::EpiResid<false> E{p.x, (float*)(ws + O_H), 0.5f, nullptr, nullptr, nullptr}; pg8::gemm_phase(lds, FF, FF, Sd, E, wave); }
        else { unsigned char* ws = launder_p(p.ws); pg8::SimpleSched Sd{(const char*)(ws + O_R1), (const char*)(ws + OW_F1B), FF, FF, 64, 8, G, bx, 88}; pg8::EpiResid<true> E{(const float*)(ws + O_H), (float*)(ws + O_H), 0.5f, (const float*)(ws + O_ST), p.ln_g + (size_t)(l * 3 - 1) * DM, p.ln_b + (size_t)(l * 3 - 1) * DM}; pg8::gemm_phase(lds, FF, FF, Sd, E, wave); }
        GRID_SYNC(2);
        REPS(7) { unsigned char* ws = launder_p(p.ws); const bool dummy = (REP_PHASE == 7) && (rep_ == 0); phase_ln((const float*)(ws + O_H), dummy ? (float*)(ws + O_YBR) : nullptr, (bf16_t*)(ws + (dummy ? O_U : O_HB)), (float*)(ws + O_ST), p.ln_g + (size_t)(l * 3 + 0) * DM, p.ln_b + (size_t)(l * 3 + 0) * DM, wave, lane, G); }
        GRID_SYNC(3);
        DBG_AT(1, O_H, 0);
        { unsigned char* ws = launder_p(p.ws); pg8::SimpleSched Sd{(const char*)(ws + O_HB), (const char*)(ws + OW_IN), DM, DM, 64, 20, G, bx, 32}; pg8::EpiInProj E{(bf16_t*)(ws + O_R1), (float*)(ws + O_ZG)}; pg8::gemm_phase(lds, DM, DM, Sd, E, wave); }
        GRID_SYNC(4);
        DBG_AT(2, O_R1, 1);
        phase_post(p, l, lds, wave, lane, G);
        GRID_SYNC(5);
        DBG_AT(3, O_QKC, 1);
        REPS(1) phase_mix1(p, l, lds, wave, lane, G);
        GRID_SYNC(6);
        DBG_AT(4, O_YBR, 1);
        REPS(6) phase_scan(p, lds, wave, G);
        GRID_SYNC(7);
        REPS(5) phase_mlout(p, wave, lane, G);
        GRID_SYNC(8);
        DBG_AT(5, O_YBR, 1);
        REPS(4) { unsigned char* ws = launder_p(p.ws); pg8::MergeSched Sd{(const char*)(ws + O_HB), (const char*)(ws + O_YBR), (const char*)(ws + OW_G), (const char*)(ws + OW_BC), G, bx};
          pg8::EpiMerge E{(u32x2*)(ws + O_GSC), (u32x4*)(ws + O_MSC), (bf16_t*)(ws + O_MERGED)}; pg8::gemm_phase(lds, DM, DM, Sd, E, wave); }
        GRID_SYNC(9);
        DBG_AT(6, O_MERGED, 1);
        { unsigned char* ws = launder_p(p.ws); pg8::SimpleSched Sd{(const char*)(ws + O_MERGED), (const char*)(ws + OW_O), DM, DM, 64, 8, G, bx, 32}; pg8::EpiResid<true> E{(const float*)(ws + O_H), (float*)(ws + O_H), 1.0f, (const float*)(ws + O_ST), p.ln_g + (size_t)(l * 3 + 0) * DM, p.ln_b + (size_t)(l * 3 + 0) * DM}; pg8::gemm_phase(lds, DM, DM, Sd, E, wave); }
        GRID_SYNC(10);
        { unsigned char* ws = launder_p(p.ws); phase_ln((const float*)(ws + O_H), nullptr, (bf16_t*)(ws + O_HB), (float*)(ws + O_ST), p.ln_g + (size_t)(l * 3 + 1) * DM, p.ln_b + (size_t)(l * 3 + 1) * DM, wave, lane, G); }
        GRID_SYNC(11);
        DBG_AT(7, O_H, 0);
        { unsigned char* ws = launder_p(p.ws); pg8::SimpleSched Sd{(const char*)(ws + O_HB), (const char*)(ws + OW_F2A), DM, DM, 64, 44, G, bx, 32}; pg8::EpiSwiGLU E{(bf16_t*)(ws + O_R1)}; pg8::gemm_phase(lds, DM, DM, Sd, E, wave); }
        GRID_SYNC(12);
        { unsigned char* ws = launder_p(p.ws); pg8::SimpleSched Sd{(const char*)(ws + O_R1), (const char*)(ws + OW_F2B), FF, FF, 64, 8, G, bx, 88}; pg8::EpiResid<true> E{(const float*)(ws + O_H), (float*)(ws + O_H), 0.5f, (const float*)(ws + O_ST), p.ln_g + (size_t)(l * 3 + 1) * DM, p.ln_b + (size_t)(l * 3 + 1) * DM}; pg8::gemm_phase(lds, FF, FF, Sd, E, wave); }
        GRID_SYNC(13);
        { unsigned char* ws = launder_p(p.ws); phase_ln((const float*)(ws + O_H), (l == NL - 1) ? p.out : nullptr, (l == NL - 1) ? nullptr : (bf16_t*)(ws + O_HB), (l == NL - 1) ? nullptr : (float*)(ws + O_ST), p.ln_g + (size_t)(l * 3 + 2) * DM, p.ln_b + (size_t)(l * 3 + 2) * DM, wave, lane, G); }
        if (l + 1 < NL) phase_weights(p, l + 1, lds, wave, lane, G);
        GRID_SYNC(14);
    }
}

extern "C" void kernel_launch(void* const* d_in, const int* in_sizes, int n_in, void* d_out, int out_size, void* d_ws, size_t ws_size, hipStream_t stream) {
    static int grid_blocks = 0;
    if (grid_blocks == 0) {
        if (n_in != 18 || ws_size < O_END) { fprintf(stderr, "kernel_launch: unexpected inputs (n_in %d, ws %zu, need %zu)\n", n_in, ws_size, (size_t)O_END); grid_blocks = -1; return; }
        int dev = 0, cus = 0, per_cu = 0;
        hipGetDevice(&dev);
        hipDeviceGetAttribute(&cus, hipDeviceAttributeMultiprocessorCount, dev);
        hipFuncSetAttribute((const void*)fwd_megakernel, hipFuncAttributeMaxDynamicSharedMemorySize, LDS_BYTES);
        hipOccupancyMaxActiveBlocksPerMultiprocessor(&per_cu, (const void*)fwd_megakernel, NTHR, LDS_BYTES);
        if (per_cu < 1) per_cu = 1;
        grid_blocks = cus * 1;
        (void)hipGetLastError();
    }
    if (grid_blocks < 0) return;
    Params p{};
    p.x = (const float*)d_in[0]; p.ln_g = (const float*)d_in[1]; p.ln_b = (const float*)d_in[2]; p.ffn1_w_in = (const float*)d_in[3]; p.ffn1_w_out = (const float*)d_in[4];
    p.w_in = (const float*)d_in[5]; p.pool_w = (const float*)d_in[6]; p.pool_scale = (const float*)d_in[7]; p.swa_sinks = (const float*)d_in[8]; p.mlstm_conv = (const float*)d_in[9];
    p.mlstm_i_bias = (const float*)d_in[10]; p.mlstm_f_bias = (const float*)d_in[11]; p.fox_f_bias = (const float*)d_in[12]; p.w_branch = (const float*)d_in[13]; p.w_gate = (const float*)d_in[14];
    p.w_out = (const float*)d_in[15]; p.ffn2_w_in = (const float*)d_in[16]; p.ffn2_w_out = (const float*)d_in[17]; p.out = (float*)d_out; p.ws = (unsigned char*)d_ws;
    (void)hipMemsetAsync((unsigned char*)d_ws + O_CTL, 0, 16384, stream);
    void* args[] = {&p};
    hipError_t e = hipLaunchCooperativeKernel((const void*)fwd_megakernel, dim3(grid_blocks), dim3(NTHR), args, LDS_BYTES, stream);
    if (e != hipSuccess) fprintf(stderr, "cooperative launch failed: %s (grid %d)\n", hipGetErrorString(e), grid_blocks);
}
```

```cpp
#include <hip/hip_runtime.h>
#include <hip/hip_cooperative_groups.h>
#include <cstdio>
#include <cstdint>
namespace cg = cooperative_groups;
#define DBG_MIX 15
#define DBG_STOP 0
#define REP_PHASE 0
#define REPS(k) for (int rep_ = 0; rep_ < ((REP_PHASE == (k)) ? 2 : 1); ++rep_)

#define LAS __attribute__((address_space(3)))
typedef unsigned short bf16_t;
typedef short bf16x8 __attribute__((ext_vector_type(8)));
typedef float f32x4 __attribute__((ext_vector_type(4)));
typedef float f32x16 __attribute__((ext_vector_type(16)));
typedef unsigned u32x4 __attribute__((ext_vector_type(4)));
typedef unsigned u32x2 __attribute__((ext_vector_type(2)));
typedef float f32x2_t __attribute__((ext_vector_type(2)));
typedef __bf16 bf16x2_t __attribute__((ext_vector_type(2)));

constexpr int S = 16384, DM = 2048, FF = 5632, ZLD = 4864, NL = 2;
constexpr int NWAVES = 8, NTHR = 512;
constexpr float ALPHA = 1.41421356237309515f;
constexpr float LOG2E = 1.4426950408889634f;
constexpr float C2 = 0.125f * LOG2E;
constexpr float LN_EPS = 1e-5f;
constexpr int ZC_QSWA = 512, ZC_KSWA = 1024, ZC_VSWA = 1152, ZC_QML = 1280, ZC_VML = 2304, ZC_OML = 2816, ZC_QFOX = 3328, ZC_KFOX = 3840, ZC_VFOX = 4352;

constexpr size_t MiB = 1u << 20;
constexpr size_t O_ZG = 0;
constexpr size_t O_MLA = 1 * MiB;
constexpr size_t O_MLB = O_MLA + 256 * 1024;
constexpr size_t O_MLD = O_MLB + 256 * 1024;
constexpr size_t O_CL2 = 2 * MiB;
constexpr size_t O_TOT2 = O_CL2 + 512 * 1024;
constexpr size_t O_BLC = O_TOT2 + 16 * 1024;
constexpr size_t O_DMC = O_BLC + 16 * 1024;
constexpr size_t O_MST = O_DMC + 16 * 1024;
constexpr size_t O_NST = 3 * MiB;
constexpr size_t O_UN = O_NST + 512 * 1024;
constexpr size_t O_ST = 4 * MiB;
constexpr size_t O_W = 8 * MiB;
constexpr size_t OW_F1A = O_W, OW_F1B = OW_F1A + 44 * MiB, OW_IN = OW_F1B + 22 * MiB, OW_G = OW_IN + 20 * MiB, OW_BC = OW_G + 32 * MiB,
                 OW_O = OW_BC + 8 * MiB, OW_F2A = OW_O + 8 * MiB, OW_F2B = OW_F2A + 44 * MiB, OW_BD = OW_F2B + 22 * MiB;
constexpr size_t O_H = 210 * MiB;
constexpr size_t O_HB = 338 * MiB;
constexpr size_t O_R1 = 402 * MiB;
constexpr size_t O_YBR = 578 * MiB;
constexpr size_t O_QKC = 642 * MiB;
constexpr size_t O_VTF = 674 * MiB;
constexpr size_t O_VTS = 690 * MiB;
constexpr size_t O_VTM = 694 * MiB;
constexpr size_t O_VTW = 710 * MiB;
constexpr size_t O_KTM = 726 * MiB;
constexpr size_t O_POOL = 742 * MiB;
constexpr size_t O_U = 758 * MiB;
constexpr size_t O_CST = 822 * MiB;
constexpr size_t O_CTL = 854 * MiB;
constexpr size_t O_END = 855 * MiB;
constexpr size_t O_MERGED = O_QKC;
constexpr size_t O_GSC = O_R1;
constexpr size_t O_MSC = O_R1 + 32 * MiB;

constexpr int RING_BYTES = 131072;
constexpr int LDS_P2 = RING_BYTES;
constexpr int LDS_MISC = RING_BYTES + 8192;
constexpr int LDS_BYTES = 147456;

__device__ __forceinline__ unsigned pk2(float lo, float hi) { f32x2_t v = {lo, hi}; bf16x2_t b = __builtin_convertvector(v, bf16x2_t); return __builtin_bit_cast(unsigned, b); }
__device__ __forceinline__ float bf2f(unsigned short b) { return __uint_as_float((unsigned)b << 16); }
__device__ __forceinline__ float bflo(unsigned w) { return __uint_as_float(w << 16); }
__device__ __forceinline__ float bfhi(unsigned w) { return __uint_as_float(w & 0xffff0000u); }
__device__ __forceinline__ unsigned short f2bf(float f) { return (unsigned short)(pk2(f, 0.f) & 0xffffu); }
__device__ __forceinline__ float sigmoidf_(float x) { return __builtin_amdgcn_rcpf(1.f + __builtin_amdgcn_exp2f(-x * LOG2E)); }
__device__ __forceinline__ float logsigmoidf_(float x) { return fminf(x, 0.f) - log1pf(__expf(-fabsf(x))); }
__device__ __forceinline__ int lane_id() { int l; asm volatile("v_mbcnt_lo_u32_b32 %0, -1, 0\n\tv_mbcnt_hi_u32_b32 %0, -1, %0" : "=v"(l)); return l; }
__device__ __forceinline__ int launder_v(int x) { asm volatile("" : "+v"(x)); return x; }
__device__ __forceinline__ int launder_s(int x) { asm volatile("" : "+s"(x)); return x; }
template <class T> __device__ __forceinline__ T* launder_p(T* p) { asm volatile("" : "+s"(p)); return p; }
__device__ __forceinline__ int crow(int r, int hi) { return (r & 3) + 8 * (r >> 2) + 4 * hi; }

namespace pg8 {
constexpr int BM = 256, BK = 64, HALF = 128, HTB = HALF * BK * 2, NXCD = 8, WGM = 8;
__device__ __forceinline__ int lds_byte(int r, int c) { const int st = (r >> 4) * 2 + (c >> 5), rr = r & 15, cc = c & 31, ob = rr * 64 + cc * 2; return st * 1024 + (ob ^ (((ob >> 9) & 1) << 5)); }
__device__ __forceinline__ void stage_rc(int b, int& R, int& C) { const int st = b / 1024, sb = b % 1024, swz = sb ^ (((sb >> 9) & 1) << 5); R = (st >> 1) * 16 + swz / 64; C = (st & 1) * 32 + (swz % 64) / 2; }
__device__ __forceinline__ int perm32(int rho) { const int n = rho >> 4, i = rho & 15; return 8 * (i >> 2) + 4 * n + (i & 3); }

struct Unit { int pm, pn, kind, nt; const char* a; const char* b; };

__device__ __forceinline__ void tile_of(int L, int nM, int nN, int& pm, int& pn) {
    const int nwg = nM * nN; int wgid = L;
    { const int q = nwg / NXCD, r = nwg % NXCD, xcd = wgid % NXCD, off = wgid / NXCD; wgid = (xcd < r ? xcd * (q + 1) : r * (q + 1) + (xcd - r) * q) + off; }
    const int nig = WGM * nN, gid = wgid / nig, fm = gid * WGM, gsz = (nM - fm) < WGM ? (nM - fm) : WGM;
    pm = fm + ((wgid % nig) % gsz); pn = (wgid % nig) / gsz;
}
struct SimpleSched {
    const char* A; const char* Bt; int lda, ldb, nM, nN, G, c, nt;
    __device__ __forceinline__ bool next(int i, Unit& u) const {
        const int L = i * G + c; if (L >= nM * nN) return false;
        tile_of(L, nM, nN, u.pm, u.pn); u.kind = 0; u.nt = nt;
        u.a = A + (size_t)u.pm * 256 * lda * 2; u.b = Bt + (size_t)u.pn * 256 * ldb * 2; return true;
    }
};
struct MergeSched {
    const char* HB; const char* YBR; const char* WG; const char* WBC; int G, c;
    __device__ __forceinline__ bool next(int i, Unit& u) const {
        const int L = (i >> 3) * G + c; if (L >= 64 * 8) return false;
        tile_of(L, 64, 8, u.pm, u.pn); const int sub = i & 7, b = sub >> 1; u.kind = sub;
        if ((sub & 1) == 0) { u.nt = 32; u.a = HB + (size_t)u.pm * 256 * 2048 * 2; u.b = WG + ((size_t)b * 2048 + (size_t)u.pn * 256) * 2048 * 2; }
        else { u.nt = 8; u.a = YBR + ((size_t)u.pm * 256 * 2048 + b * 512) * 2; u.b = WBC + ((size_t)u.pn * 256 * 2048 + b * 512) * 2; }
        return true;
    }
};

template <class Epi, class Sched>
__device__ __forceinline__ void gemm_phase(LAS unsigned char* lds, const int lda, const int ldb, const Sched& S, const Epi& E, const int wave_) {
    const int wid = launder_s(wave_), lane = lane_id(), tid = wid * 64 + lane, wr = wid >> 2, wc = wid & 3, fr = lane & 15, fq = lane >> 4;
    unsigned voffA[2], voffB[2];
#pragma unroll
    for (int i = 0; i < 2; ++i) { int R, C; stage_rc(tid * 16 + i * 8192, R, C); const int Rb = Epi::PERM ? ((R & ~31) + perm32(R & 31)) : R;
        voffA[i] = (unsigned)(R * lda + C) * 2u; voffB[i] = (unsigned)(Rb * ldb + C) * 2u; }
    const size_t kstep = (size_t)(BK * 2);
    const size_t hstepA = (size_t)HALF * lda * 2, hstepB = (size_t)HALF * ldb * 2;
    const unsigned ldsw = (unsigned)wid * 1024u;
    const int aoff = lds_byte(wr * 64 + fr, fq * 8), boff = lds_byte(wc * 32 + fr, fq * 8);
#define PG8_SA(b, h) (((b) * 2 + (h)) * HTB)
#define PG8_SB(b, h) ((4 + (b) * 2 + (h)) * HTB)
#define PG8_STAGE(bufoff, gbase, voff) do { _Pragma("unroll") for (int _i = 0; _i < 2; ++_i) \
        __builtin_amdgcn_global_load_lds((const unsigned*)((const char*)(gbase) + (voff)[_i]), (LAS unsigned*)(lds + (bufoff) + ldsw + _i * 8192), 16, 0, 0); } while (0)
#define PG8_LDA(dst, b, h) do { _Pragma("unroll") for (int m = 0; m < 4; ++m) _Pragma("unroll") for (int k = 0; k < 2; ++k) dst[m][k] = *(const LAS bf16x8*)(lds + PG8_SA(b, h) + aoff + m * 2048 + k * 1024); } while (0)
#define PG8_LDB(dst, b, h) do { _Pragma("unroll") for (int n = 0; n < 2; ++n) _Pragma("unroll") for (int k = 0; k < 2; ++k) dst[n][k] = *(const LAS bf16x8*)(lds + PG8_SB(b, h) + boff + n * 2048 + k * 1024); } while (0)
#define PG8_MMA(ai, bj, At, Bt) do { __builtin_amdgcn_s_setprio(1); _Pragma("unroll") for (int m = 0; m < 4; ++m) _Pragma("unroll") for (int n = 0; n < 2; ++n) _Pragma("unroll") for (int k = 0; k < 2; ++k) \
        acc[ai][bj][m][n] = __builtin_amdgcn_mfma_f32_16x16x32_bf16(Bt[n][k], At[m][k], acc[ai][bj][m][n], 0, 0, 0); __builtin_amdgcn_s_setprio(0); } while (0)
#define PG8_WAIT_V(n) asm volatile("s_waitcnt vmcnt(" #n ")" ::: "memory")
#define PG8_WAIT_L(n) asm volatile("s_waitcnt lgkmcnt(" #n ")" ::: "memory")
#define PG8_BAR __builtin_amdgcn_s_barrier()
#define PG8_SCHED __builtin_amdgcn_sched_barrier(0)
    Unit cur, nxt; int ui = 0;
    if (!S.next(0, cur)) return;
    f32x4 acc[2][2][4][2];
#pragma unroll
    for (int a = 0; a < 2; ++a)
#pragma unroll
        for (int b = 0; b < 2; ++b)
#pragma unroll
            for (int m = 0; m < 4; ++m)
#pragma unroll
                for (int n = 0; n < 2; ++n) acc[a][b][m][n] = (f32x4){0.f, 0.f, 0.f, 0.f};
    bf16x8 At[4][2], B0[2][2], B1[2][2];
    const char* cA = cur.a; const char* cB = cur.b;
    PG8_STAGE(PG8_SB(0, 0), cB, voffB); PG8_STAGE(PG8_SB(0, 1), cB + hstepB, voffB); PG8_STAGE(PG8_SA(0, 0), cA, voffA); PG8_STAGE(PG8_SA(0, 1), cA + hstepA, voffA);
    if (wr == 1) PG8_BAR;
    PG8_WAIT_V(2); PG8_BAR;
    PG8_STAGE(PG8_SB(1, 0), cB + kstep, voffB); PG8_STAGE(PG8_SA(1, 0), cA + kstep, voffA); PG8_STAGE(PG8_SB(1, 1), cB + hstepB + kstep, voffB);
    PG8_WAIT_V(6); PG8_BAR;
    for (;;) {
        const bool has_next = S.next(ui + 1, nxt);
        const char* nA = has_next ? nxt.a : cA; const char* nB = has_next ? nxt.b : cB;
        const int nt = cur.nt;
        for (int t = 0; t < nt; t += 2) {
            const bool last = (t == nt - 2);
            const char* a1 = cA + (size_t)(t + 1) * kstep;
            const char* a2 = last ? nA : cA + (size_t)(t + 2) * kstep; const char* b2 = last ? nB : cB + (size_t)(t + 2) * kstep;
            const char* a3 = a2 + kstep; const char* b3 = b2 + kstep;
            PG8_LDB(B0, 0, 0); PG8_LDB(B1, 0, 1); PG8_SCHED; PG8_LDA(At, 0, 0); PG8_STAGE(PG8_SA(1, 1), a1 + hstepA, voffA);
            PG8_WAIT_V(8); PG8_WAIT_L(0); PG8_BAR; PG8_MMA(0, 0, At, B0); PG8_MMA(0, 1, At, B1); PG8_BAR; PG8_SCHED;
            PG8_LDA(At, 0, 1); PG8_STAGE(PG8_SB(0, 0), b2, voffB); PG8_STAGE(PG8_SB(0, 1), b2 + hstepB, voffB); PG8_STAGE(PG8_SA(0, 0), a2, voffA);
            PG8_WAIT_V(8); PG8_WAIT_L(0); PG8_BAR; PG8_MMA(1, 0, At, B0); PG8_MMA(1, 1, At, B1); PG8_BAR; PG8_SCHED;
            PG8_LDB(B0, 1, 0); PG8_LDB(B1, 1, 1); PG8_SCHED; PG8_LDA(At, 1, 0); PG8_STAGE(PG8_SA(0, 1), a2 + hstepA, voffA);
            PG8_WAIT_V(8); PG8_WAIT_L(0); PG8_BAR; PG8_MMA(0, 0, At, B0); PG8_MMA(0, 1, At, B1); PG8_BAR; PG8_SCHED;
            PG8_LDA(At, 1, 1); PG8_STAGE(PG8_SB(1, 0), b3, voffB); PG8_STAGE(PG8_SB(1, 1), b3 + hstepB, voffB); PG8_STAGE(PG8_SA(1, 0), a3, voffA);
            PG8_WAIT_V(8); PG8_WAIT_L(0); PG8_BAR; PG8_MMA(1, 0, At, B0); PG8_MMA(1, 1, At, B1); PG8_BAR; PG8_SCHED;
        }
        if (wr == 0) PG8_BAR;
        E(acc, cur, wr, wc, fr, fq);
        if (!has_next) break;
#pragma unroll
        for (int a = 0; a < 2; ++a)
#pragma unroll
            for (int b = 0; b < 2; ++b)
#pragma unroll
                for (int m = 0; m < 4; ++m)
#pragma unroll
                    for (int n = 0; n < 2; ++n) acc[a][b][m][n] = (f32x4){0.f, 0.f, 0.f, 0.f};
        cur = nxt; cA = nA; cB = nB; ++ui;
        if (wr == 1) PG8_BAR;
    }
    PG8_WAIT_V(0);
    PG8_BAR;
#undef PG8_SA
#undef PG8_SB
#undef PG8_STAGE
#undef PG8_LDA
#undef PG8_LDB
#undef PG8_MMA
#undef PG8_WAIT_V
#undef PG8_WAIT_L
#undef PG8_BAR
#undef PG8_SCHED
}

typedef f32x4 Acc[2][2][4][2];

struct EpiSwiGLU {
    static constexpr bool PERM = true;
    bf16_t* O;
    __device__ __forceinline__ void operator()(const Acc& acc, const Unit& u, int wr, int wc, int fr, int fq) const {
        const int row0 = u.pm * BM + wr * 64 + fr, col0 = u.pn * 128 + wc * 32 + 8 * fq;
#pragma unroll
        for (int ai = 0; ai < 2; ++ai)
#pragma unroll
            for (int m = 0; m < 4; ++m) {
                bf16_t* p = O + (size_t)(row0 + ai * HALF + m * 16) * FF + col0;
                float h[8];
#pragma unroll
                for (int n = 0; n < 2; ++n)
#pragma unroll
                    for (int j = 0; j < 4; ++j) { const float g = acc[ai][0][m][n][j], up = acc[ai][1][m][n][j]; h[n * 4 + j] = g * sigmoidf_(g) * up; }
                u32x4 w; w.x = pk2(h[0], h[1]); w.y = pk2(h[2], h[3]); w.z = pk2(h[4], h[5]); w.w = pk2(h[6], h[7]);
                *(u32x4*)p = w;
            }
    }
};
template <bool LNRES> struct EpiResid {
    static constexpr bool PERM = false;
    const float* res; float* out; float s; const float* st; const float* g; const float* b;
    __device__ __forceinline__ void operator()(const Acc& acc, const Unit& u, int wr, int wc, int fr, int fq) const {
        const int col0 = u.pn * BM + wc * 32 + 4 * fq;
#pragma unroll
        for (int ai = 0; ai < 2; ++ai)
#pragma unroll
            for (int bj = 0; bj < 2; ++bj) {
                f32x4 rv[4][2], gv[2], bv[2]; f32x2_t sv[4];
                const int c = col0 + bj * HALF;
                if (LNRES) {
#pragma unroll
                    for (int n = 0; n < 2; ++n) { gv[n] = *(const f32x4*)(g + c + n * 16); bv[n] = *(const f32x4*)(b + c + n * 16); }
                }
#pragma unroll
                for (int m = 0; m < 4; ++m) { const int row = u.pm * BM + ai * HALF + wr * 64 + m * 16 + fr; const size_t off = (size_t)row * DM + c;
                    if (LNRES) sv[m] = *(const f32x2_t*)(st + 2 * (size_t)row);
#pragma unroll
                    for (int n = 0; n < 2; ++n) rv[m][n] = *(const f32x4*)(res + off + n * 16); }
                asm volatile("" ::: "memory");
#pragma unroll
                for (int m = 0; m < 4; ++m) { const size_t off = (size_t)(u.pm * BM + ai * HALF + wr * 64 + m * 16 + fr) * DM + c;
#pragma unroll
                    for (int n = 0; n < 2; ++n) { f32x4 r = rv[m][n]; if (LNRES) r = (r - sv[m].x) * sv[m].y * gv[n] + bv[n];
                        *(f32x4*)(out + off + n * 16) = r * ALPHA + acc[ai][bj][m][n] * s; } }
                asm volatile("" ::: "memory");
            }
    }
};
struct EpiInProj {
    static constexpr bool PERM = true;
    bf16_t* Z; float* ZG;
    __device__ __forceinline__ void operator()(const Acc& acc, const Unit& u, int wr, int wc, int fr, int fq) const {
        const int row0 = u.pm * BM + wr * 64 + fr;
        if (u.pn < 19) {
            const float sc = (u.pn == 2 || u.pn == 3 || u.pn == 13 || u.pn == 14) ? C2 : 1.f;
            const int col0 = u.pn * BM + wc * 32 + 8 * fq;
#pragma unroll
            for (int ai = 0; ai < 2; ++ai)
#pragma unroll
                for (int m = 0; m < 4; ++m) { bf16_t* p = Z + (size_t)(row0 + ai * HALF + m * 16) * ZLD + col0;
#pragma unroll
                    for (int bj = 0; bj < 2; ++bj) { const f32x4 v0 = acc[ai][bj][m][0] * sc, v1 = acc[ai][bj][m][1] * sc;
                        u32x4 w; w.x = pk2(v0[0], v0[1]); w.y = pk2(v0[2], v0[3]); w.z = pk2(v1[0], v1[1]); w.w = pk2(v1[2], v1[3]);
                        *(u32x4*)(p + bj * HALF) = w; } }
        } else if (wc == 0 && fq < 2) {
#pragma unroll
            for (int ai = 0; ai < 2; ++ai)
#pragma unroll
                for (int m = 0; m < 4; ++m) { float* p = ZG + (size_t)(row0 + ai * HALF + m * 16) * 16 + 8 * fq;
                    *(f32x4*)p = acc[ai][0][m][0]; *(f32x4*)(p + 4) = acc[ai][0][m][1]; }
        }
    }
};
struct EpiPool {
    static constexpr bool PERM = true;
    bf16_t* Y; const float* scale;
    __device__ __forceinline__ void operator()(const Acc& acc, const Unit& u, int wr, int wc, int fr, int fq) const {
        const int row0 = u.pm * BM + wr * 64 + fr, col0 = u.pn * BM + wc * 32 + 8 * fq;
#pragma unroll
        for (int bj = 0; bj < 2; ++bj) {
            const f32x4 s0 = *(const f32x4*)(scale + col0 + bj * HALF), s1 = *(const f32x4*)(scale + col0 + bj * HALF + 4);
#pragma unroll
            for (int ai = 0; ai < 2; ++ai)
#pragma unroll
                for (int m = 0; m < 4; ++m) { bf16_t* p = Y + (size_t)(row0 + ai * HALF + m * 16) * DM + col0 + bj * HALF;
                    const f32x4 v0 = acc[ai][bj][m][0] * s0, v1 = acc[ai][bj][m][1] * s1;
                    u32x4 w; w.x = pk2(v0[0], v0[1]); w.y = pk2(v0[2], v0[3]); w.z = pk2(v1[0], v1[1]); w.w = pk2(v1[2], v1[3]);
                    *(u32x4*)p = w; }
        }
    }
};
struct EpiMerge {
    static constexpr bool PERM = true;
    u32x2* gsc; u32x4* msc; bf16_t* MG;
    __device__ __forceinline__ void operator()(const Acc& acc, const Unit& u, int wr, int wc, int fr, int fq) const {
        const int tid = (wr * 4 + wc) * 64 + fq * 16 + fr;
        u32x2* g = gsc + ((size_t)blockIdx.x * NTHR + tid) * 16;
        u32x4* ms = msc + ((size_t)blockIdx.x * NTHR + tid) * 16;
        const int b = u.kind >> 1;
        if ((u.kind & 1) == 0) {
#pragma unroll
            for (int ai = 0; ai < 2; ++ai)
#pragma unroll
                for (int bj = 0; bj < 2; ++bj)
#pragma unroll
                    for (int m = 0; m < 4; ++m) { const f32x4 a0 = acc[ai][bj][m][0], a1 = acc[ai][bj][m][1];
                        u32x2 w;
                        w.x = (unsigned)(sigmoidf_(a0[0]) * 255.f + 0.5f) | ((unsigned)(sigmoidf_(a0[1]) * 255.f + 0.5f) << 8) | ((unsigned)(sigmoidf_(a0[2]) * 255.f + 0.5f) << 16) | ((unsigned)(sigmoidf_(a0[3]) * 255.f + 0.5f) << 24);
                        w.y = (unsigned)(sigmoidf_(a1[0]) * 255.f + 0.5f) | ((unsigned)(sigmoidf_(a1[1]) * 255.f + 0.5f) << 8) | ((unsigned)(sigmoidf_(a1[2]) * 255.f + 0.5f) << 16) | ((unsigned)(sigmoidf_(a1[3]) * 255.f + 0.5f) << 24);
                        g[(ai * 2 + bj) * 4 + m] = w; }
            asm volatile("" ::: "memory");
        } else {
            const int row0 = u.pm * BM + wr * 64 + fr, col0 = u.pn * BM + wc * 32 + 8 * fq;
            const float k255 = 1.f / 255.f;
#pragma unroll
            for (int ai = 0; ai < 2; ++ai) {
                u32x2 gw[8]; u32x4 pv[8];
#pragma unroll
                for (int sl = 0; sl < 8; ++sl) gw[sl] = g[ai * 8 + sl];
                if (b > 0) {
#pragma unroll
                    for (int sl = 0; sl < 8; ++sl) pv[sl] = ms[ai * 8 + sl];
                }
#pragma unroll
                for (int bj = 0; bj < 2; ++bj)
#pragma unroll
                    for (int m = 0; m < 4; ++m) { const int hs = bj * 4 + m, slot = ai * 8 + hs; const u32x2 w = gw[hs];
                        f32x4 p0 = acc[ai][bj][m][0], p1 = acc[ai][bj][m][1];
                        p0[0] *= (float)(w.x & 255u) * k255; p0[1] *= (float)((w.x >> 8) & 255u) * k255; p0[2] *= (float)((w.x >> 16) & 255u) * k255; p0[3] *= (float)(w.x >> 24) * k255;
                        p1[0] *= (float)(w.y & 255u) * k255; p1[1] *= (float)((w.y >> 8) & 255u) * k255; p1[2] *= (float)((w.y >> 16) & 255u) * k255; p1[3] *= (float)(w.y >> 24) * k255;
                        if (b > 0) { const u32x4 q = pv[hs];
                            p0[0] += bflo(q.x); p0[1] += bfhi(q.x); p0[2] += bflo(q.y); p0[3] += bfhi(q.y); p1[0] += bflo(q.z); p1[1] += bfhi(q.z); p1[2] += bflo(q.w); p1[3] += bfhi(q.w); }
                        u32x4 o; o.x = pk2(p0[0], p0[1]); o.y = pk2(p0[2], p0[3]); o.z = pk2(p1[0], p1[1]); o.w = pk2(p1[2], p1[3]);
                        if (b < 3) ms[slot] = o;
                        else *(u32x4*)(MG + (size_t)(row0 + ai * HALF + m * 16) * DM + col0 + bj * HALF) = o; }
                asm volatile("" ::: "memory");
            }
        }
    }
};
}

struct Params {
    const float* x; const float* ln_g; const float* ln_b; const float* ffn1_w_in; const float* ffn1_w_out; const float* w_in; const float* pool_w; const float* pool_scale;
    const float* swa_sinks; const float* mlstm_conv; const float* mlstm_i_bias; const float* mlstm_f_bias; const float* fox_f_bias; const float* w_branch; const float* w_gate;
    const float* w_out; const float* ffn2_w_in; const float* ffn2_w_out; float* out; unsigned char* ws;
};

__device__ __forceinline__ int maprow(int kind, int n) {
    if (kind == 1) { const int type = n >= FF ? 1 : 0; const int j = n - type * FF; return (j >> 7) * 256 + type * 128 + (j & 127); }
    if (kind == 2) { if (n < 3328) return n; if (n < 3336) return 4864 + (n - 3328); if (n < 4872) return n - 8; return n; }
    return n;
}
__device__ __forceinline__ void tr_item(const float* W, int ldw, int ncols, int nblk, int item, bf16_t* dst, int dpitch, int dcol0, int mapkind, LAS float* scr, int lane) {
    const int kb = item / nblk, nb = item % nblk, k0 = 64 * kb, n0 = 32 * nb;
    const int nsrc = n0 + (lane & 31);
    float wv[32];
#pragma unroll
    for (int i = 0; i < 32; ++i) { const int kk = 2 * i + (lane >> 5); wv[i] = (nsrc < ncols) ? W[(size_t)(k0 + kk) * ldw + nsrc] : 0.f; }
#pragma unroll
    for (int i = 0; i < 32; ++i) { const int kk = 2 * i + (lane >> 5); scr[kk * 33 + (lane & 31)] = wv[i]; }
    asm volatile("s_waitcnt lgkmcnt(0)" ::: "memory");
    const int c = lane & 7;
#pragma unroll
    for (int j = 0; j < 4; ++j) { const int nn = (lane >> 3) + 8 * j; const int n = n0 + nn; const LAS float* s = scr + (8 * c) * 33 + nn;
        u32x4 o; o.x = pk2(s[0 * 33], s[1 * 33]); o.y = pk2(s[2 * 33], s[3 * 33]); o.z = pk2(s[4 * 33], s[5 * 33]); o.w = pk2(s[6 * 33], s[7 * 33]);
        if (n < ncols) *(u32x4*)(dst + (size_t)maprow(mapkind, n) * dpitch + dcol0 + k0 + 8 * c) = o; }
    asm volatile("s_waitcnt lgkmcnt(0)" ::: "memory");
}

__device__ __forceinline__ void phase_weights(const Params& p, int l, LAS unsigned char* lds, int wave_, int lane_, int G) {
    const int lane = lane_id(), wave = launder_s(wave_); (void)lane_;
    unsigned char* ws = launder_p(p.ws);
    LAS float* scr = (LAS float*)(lds + wave * 8448);
    const int gw = blockIdx.x * NWAVES + wave, NGW = G * NWAVES;
    const float* f1a = p.ffn1_w_in + (size_t)l * DM * 2 * FF; const float* f1b = p.ffn1_w_out + (size_t)l * FF * DM;
    const float* f2a = p.ffn2_w_in + (size_t)l * DM * 2 * FF; const float* f2b = p.ffn2_w_out + (size_t)l * FF * DM;
    const float* win = p.w_in + (size_t)l * DM * 4880; const float* wg = p.w_gate + (size_t)l * 4 * DM * DM; const float* wb = p.w_branch + (size_t)l * 4 * 512 * DM;
    const float* wo = p.w_out + (size_t)l * DM * DM; const float* pw = p.pool_w + (size_t)l * 4 * 128 * 128;
    constexpr int I_FA = 32 * 352, I_FB = 88 * 64, I_IN = 32 * 153, I_G = 4 * 32 * 64, I_B = 4 * 8 * 64, I_O = 32 * 64, I_P = 4 * 2 * 4;
    constexpr int NITEMS = 2 * I_FA + 2 * I_FB + I_IN + I_G + I_B + I_O + I_P;
    for (int it = gw; it < NITEMS; it += NGW) {
        int r = it;
        if (r < I_FA) { tr_item(f1a, 2 * FF, 2 * FF, 352, r, (bf16_t*)(ws + OW_F1A), DM, 0, 1, scr, lane); continue; } r -= I_FA;
        if (r < I_FA) { tr_item(f2a, 2 * FF, 2 * FF, 352, r, (bf16_t*)(ws + OW_F2A), DM, 0, 1, scr, lane); continue; } r -= I_FA;
        if (r < I_FB) { tr_item(f1b, DM, DM, 64, r, (bf16_t*)(ws + OW_F1B), FF, 0, 0, scr, lane); continue; } r -= I_FB;
        if (r < I_FB) { tr_item(f2b, DM, DM, 64, r, (bf16_t*)(ws + OW_F2B), FF, 0, 0, scr, lane); continue; } r -= I_FB;
        if (r < I_IN) { tr_item(win, 4880, 4880, 153, r, (bf16_t*)(ws + OW_IN), DM, 0, 2, scr, lane); continue; } r -= I_IN;
        if (r < I_G) { const int b = r / 2048, rr = r % 2048; tr_item(wg + (size_t)b * DM * DM, DM, DM, 64, rr, (bf16_t*)(ws + OW_G) + (size_t)b * DM * DM, DM, 0, 0, scr, lane); continue; } r -= I_G;
        if (r < I_B) { const int b = r / 512, rr = r % 512; tr_item(wb + (size_t)b * 512 * DM, DM, DM, 64, rr, (bf16_t*)(ws + OW_BC), DM, b * 512, 0, scr, lane); continue; } r -= I_B;
        if (r < I_O) { tr_item(wo, DM, DM, 64, r, (bf16_t*)(ws + OW_O), DM, 0, 0, scr, lane); continue; } r -= I_O;
        { const int g = r / 8, rr = r % 8; tr_item(pw + (size_t)g * 128 * 128, 128, 128, 4, rr, (bf16_t*)(ws + OW_BD) + (size_t)g * 128 * 512, 512, g * 128, 0, scr, lane); }
    }
    const int gt = blockIdx.x * NTHR + wave * 64 + lane, NGT = G * NTHR;
    const unsigned z0 = (unsigned)launder_v(0); const u32x4 zz = {z0, z0, z0, z0};
    { u32x4* zr = (u32x4*)((bf16_t*)(ws + OW_IN) + (size_t)4880 * DM); for (int i = gt; i < 240 * DM / 8; i += NGT) zr[i] = zz; }
    { u32x4* bd = (u32x4*)(ws + OW_BD); for (int i = gt; i < 512 * 512 / 8; i += NGT) { const int n = i / 64, k = (i % 64) * 8; if ((n >> 7) != (k >> 7)) bd[i] = zz; } }
    if (l == 0) {
        const f32x4* xs = (const f32x4*)p.x; u32x2* hb = (u32x2*)(ws + O_HB);
        for (int i = gt; i < S * DM / 4; i += NGT) { const f32x4 v = xs[i]; u32x2 w; w.x = pk2(v[0], v[1]); w.y = pk2(v[2], v[3]); hb[i] = w; }
    }
}

__device__ __forceinline__ float wave_sum(float v) {
#pragma unroll
    for (int o = 1; o < 64; o <<= 1) v += __shfl_xor(v, o);
    return v;
}
__device__ __forceinline__ void phase_ln(const float* Yin, float* Hout, bf16_t* hb, float* stats, const float* g, const float* b, int wave_, int lane_, int G) {
    const int lane = lane_id(), wave = launder_s(wave_); (void)lane_;
    const int gw = blockIdx.x * NWAVES + wave, NGW = G * NWAVES;
    for (int row = gw; row < S; row += 2 * NGW) {
        const int rowb = row + NGW;
        const f32x4* xa = (const f32x4*)(Yin + (size_t)row * DM) + lane; const f32x4* xb = (const f32x4*)(Yin + (size_t)rowb * DM) + lane;
        f32x4 va[8], vb[8]; float sa = 0.f, sb = 0.f;
#pragma unroll
        for (int j = 0; j < 8; ++j) { va[j] = xa[64 * j]; vb[j] = xb[64 * j]; }
#pragma unroll
        for (int j = 0; j < 8; ++j) { sa += (va[j][0] + va[j][1]) + (va[j][2] + va[j][3]); sb += (vb[j][0] + vb[j][1]) + (vb[j][2] + vb[j][3]); }
        const float ma = wave_sum(sa) * (1.f / DM), mb = wave_sum(sb) * (1.f / DM); float qa = 0.f, qb = 0.f;
#pragma unroll
        for (int j = 0; j < 8; ++j) { va[j] = va[j] - ma; vb[j] = vb[j] - mb;
            qa += (va[j][0] * va[j][0] + va[j][1] * va[j][1]) + (va[j][2] * va[j][2] + va[j][3] * va[j][3]);
            qb += (vb[j][0] * vb[j][0] + vb[j][1] * vb[j][1]) + (vb[j][2] * vb[j][2] + vb[j][3] * vb[j][3]); }
        const float ra = 1.f / sqrtf(wave_sum(qa) * (1.f / DM) + LN_EPS), rb = 1.f / sqrtf(wave_sum(qb) * (1.f / DM) + LN_EPS);
        if (stats && lane == 0) { stats[2 * (size_t)row] = ma; stats[2 * (size_t)row + 1] = ra; stats[2 * (size_t)rowb] = mb; stats[2 * (size_t)rowb + 1] = rb; }
        f32x4* ha = (f32x4*)(Hout + (size_t)row * DM) + lane; f32x4* hbp = (f32x4*)(Hout + (size_t)rowb * DM) + lane;
        u32x2* ba = (u32x2*)(hb + (size_t)row * DM) + lane; u32x2* bb = (u32x2*)(hb + (size_t)rowb * DM) + lane;
#pragma unroll
        for (int j = 0; j < 8; ++j) { const f32x4 gg = ((const f32x4*)g)[64 * j + lane], bbv = ((const f32x4*)b)[64 * j + lane];
            const f32x4 oa = va[j] * ra * gg + bbv, ob = vb[j] * rb * gg + bbv;
            if (Hout) { ha[64 * j] = oa; hbp[64 * j] = ob; }
            if (hb) { u32x2 w; w.x = pk2(oa[0], oa[1]); w.y = pk2(oa[2], oa[3]); ba[64 * j] = w; w.x = pk2(ob[0], ob[1]); w.y = pk2(ob[2], ob[3]); bb[64 * j] = w; } }
    }
}

__device__ __forceinline__ float scan_sum(float x, int lane) {
#pragma unroll
    for (int o = 1; o < 64; o <<= 1) { const float y = __shfl_up(x, o); if (lane >= o) x += y; }
    return x;
}
__device__ __forceinline__ float scan_max(float x, int lane) {
#pragma unroll
    for (int o = 1; o < 64; o <<= 1) { const float y = __shfl_up(x, o); if (lane >= o) x = fmaxf(x, y); }
    return x;
}
__device__ __forceinline__ void phase_post(const Params& p, int l, LAS unsigned char* lds, int wave_, int lane_, int G) {
    const int lane = lane_id(), wave = launder_s(wave_); (void)lane_;
    unsigned char* ws = launder_p(p.ws);
    bf16_t* Z = (bf16_t*)(ws + O_R1); const float* ZG = (const float*)(ws + O_ZG);
    LAS float* eL = (LAS float*)(lds + LDS_MISC);
    const int tid = wave * 64 + lane;
    LAS float* invL = (LAS float*)(lds + LDS_MISC + 1024);
    if (tid < 32) invL[tid] = exp2f(-(float)tid * 0.41524101186092029f);
    for (int c = blockIdx.x; c < S / 64; c += G) {
        const int t0 = c * 64;
        {
            const int t = t0 + lane;
            if (wave < 4) {
                const int h = wave;
                const float ip = ZG[(size_t)t * 16 + h] + p.mlstm_i_bias[l * 4 + h];
                const float lf = logsigmoidf_(ZG[(size_t)t * 16 + 4 + h] + p.mlstm_f_bias[l * 4 + h]);
                const float b = scan_sum(lf, lane);
                const float d = ip - b;
                const float a = scan_max(d, lane);
                const float dmax = __shfl(a, 63), bl = __shfl(b, 63);
                ((float*)(ws + O_MLA))[h * S + t] = a; ((float*)(ws + O_MLB))[h * S + t] = b; ((float*)(ws + O_MLD))[h * S + t] = d;
                eL[h * 64 + lane] = __expf(d - dmax);
                if (lane == 63) { ((float*)(ws + O_BLC))[c * 4 + h] = bl; ((float*)(ws + O_DMC))[c * 4 + h] = dmax; }
            }
            {
                const int h = wave;
                const float lf = logsigmoidf_(ZG[(size_t)t * 16 + 8 + h] + p.fox_f_bias[l * 8 + h]);
                const float cl = scan_sum(lf, lane) * LOG2E;
                ((float*)(ws + O_CL2))[h * S + t] = cl;
                if (lane == 63) ((float*)(ws + O_TOT2))[c * 8 + h] = cl;
            }
        }
        __syncthreads();
        for (int idx = tid; idx < 64 * 40; idx += NTHR) {
            const int tl = idx / 40, rem = idx % 40, hh = rem >> 2, i0 = (rem & 3) * 8, t = t0 + tl;
            bf16_t* px = Z + (size_t)t * ZLD + (hh < 8 ? ZC_QSWA + hh * 64 : ZC_KSWA + (hh - 8) * 64) + i0;
            const u32x4 a = *(const u32x4*)px, b = *(const u32x4*)(px + 32);
            float x1[8] = {bflo(a.x), bfhi(a.x), bflo(a.y), bfhi(a.y), bflo(a.z), bfhi(a.z), bflo(a.w), bfhi(a.w)};
            float x2[8] = {bflo(b.x), bfhi(b.x), bflo(b.y), bfhi(b.y), bflo(b.z), bfhi(b.z), bflo(b.w), bfhi(b.w)};
            float y1[8], y2[8];
#pragma unroll
            for (int j = 0; j < 8; ++j) {
                const float ang = (float)t * invL[i0 + j];
                double rev = (double)ang * 0.15915494309189535; rev -= rint(rev);
                const float rr = (float)(rev * 6.283185307179586);
                const float cs = __cosf(rr), sn = __sinf(rr);
                y1[j] = x1[j] * cs - x2[j] * sn; y2[j] = x2[j] * cs + x1[j] * sn;
            }
            u32x4 o1, o2;
            o1.x = pk2(y1[0], y1[1]); o1.y = pk2(y1[2], y1[3]); o1.z = pk2(y1[4], y1[5]); o1.w = pk2(y1[6], y1[7]);
            o2.x = pk2(y2[0], y2[1]); o2.y = pk2(y2[2], y2[3]); o2.z = pk2(y2[4], y2[5]); o2.w = pk2(y2[6], y2[7]);
            *(u32x4*)px = o1; *(u32x4*)(px + 32) = o2;
        }
        for (int idx = tid; idx < 128 + 512 + 512; idx += NTHR) {
            int col, h = 0; bf16_t* dst; bf16_t* dst2 = nullptr;
            if (idx < 128) { col = ZC_VSWA + idx; dst = (bf16_t*)(ws + O_VTS) + (size_t)idx * S; }
            else if (idx < 640) { const int cc = idx - 128; col = ZC_VFOX + cc; dst = (bf16_t*)(ws + O_VTF) + (size_t)cc * S; }
            else { const int cc = idx - 640; col = ZC_VML + cc; dst = (bf16_t*)(ws + O_VTM) + (size_t)cc * S; dst2 = (bf16_t*)(ws + O_VTW) + (size_t)cc * S; h = cc >> 7; }
            const bf16_t* __restrict__ src = Z + (size_t)t0 * ZLD + col;
            unsigned short v[64];
#pragma unroll
            for (int j = 0; j < 64; ++j) v[j] = src[(size_t)j * ZLD];
#pragma unroll
            for (int g8 = 0; g8 < 8; ++g8) { u32x4 w;
                w.x = (unsigned)v[8 * g8] | ((unsigned)v[8 * g8 + 1] << 16); w.y = (unsigned)v[8 * g8 + 2] | ((unsigned)v[8 * g8 + 3] << 16);
                w.z = (unsigned)v[8 * g8 + 4] | ((unsigned)v[8 * g8 + 5] << 16); w.w = (unsigned)v[8 * g8 + 6] | ((unsigned)v[8 * g8 + 7] << 16);
                *(u32x4*)(dst + t0 + 8 * g8) = w; }
            if (dst2) {
                const LAS float* e = eL + h * 64;
#pragma unroll
                for (int g8 = 0; g8 < 8; ++g8) { u32x4 w;
                    w.x = pk2(bf2f(v[8 * g8]) * e[8 * g8], bf2f(v[8 * g8 + 1]) * e[8 * g8 + 1]); w.y = pk2(bf2f(v[8 * g8 + 2]) * e[8 * g8 + 2], bf2f(v[8 * g8 + 3]) * e[8 * g8 + 3]);
                    w.z = pk2(bf2f(v[8 * g8 + 4]) * e[8 * g8 + 4], bf2f(v[8 * g8 + 5]) * e[8 * g8 + 5]); w.w = pk2(bf2f(v[8 * g8 + 6]) * e[8 * g8 + 6], bf2f(v[8 * g8 + 7]) * e[8 * g8 + 7]);
                    *(u32x4*)(dst2 + t0 + 8 * g8) = w; }
            }
        }
        for (int cc = tid; cc < 1024; cc += NTHR) {
            const float* cw = p.mlstm_conv + (size_t)l * 4 * 1024 + cc;
            const float w0 = cw[0], w1 = cw[1024], w2 = cw[2048], w3 = cw[3072];
            const bf16_t* __restrict__ src = Z + ZC_QML + cc;
            unsigned short xv[67];
#pragma unroll
            for (int j = 0; j < 67; ++j) { const int tt = t0 - 3 + j; xv[j] = (tt >= 0) ? src[(size_t)tt * ZLD] : (unsigned short)0; }
            const float qs = cc < 512 ? 0.08838834764831845f : 1.f;
            bf16_t* dq = (bf16_t*)(ws + O_QKC) + (size_t)t0 * 1024 + cc;
            const int kc = cc - 512, h = (kc >= 0) ? (kc >> 7) : 0; const LAS float* e = eL + h * 64; float su = 0.f;
#pragma unroll
            for (int g8 = 0; g8 < 8; ++g8) {
                unsigned short ob[8];
#pragma unroll
                for (int j = 0; j < 8; ++j) { const int t = 8 * g8 + j;
                    const float y = w0 * bf2f(xv[t]) + w1 * bf2f(xv[t + 1]) + w2 * bf2f(xv[t + 2]) + w3 * bf2f(xv[t + 3]);
                    ob[j] = f2bf(y * sigmoidf_(y) * qs); dq[(size_t)t * 1024] = ob[j]; }
                if (cc >= 512) {
                    u32x4 w; w.x = (unsigned)ob[0] | ((unsigned)ob[1] << 16); w.y = (unsigned)ob[2] | ((unsigned)ob[3] << 16); w.z = (unsigned)ob[4] | ((unsigned)ob[5] << 16); w.w = (unsigned)ob[6] | ((unsigned)ob[7] << 16);
                    *(u32x4*)((bf16_t*)(ws + O_KTM) + (size_t)kc * S + t0 + 8 * g8) = w;
#pragma unroll
                    for (int j = 0; j < 8; ++j) su += e[8 * g8 + j] * bf2f(ob[j]);
                }
            }
            if (cc >= 512) ((float*)(ws + O_UN))[(size_t)c * 512 + kc] = su;
        }
        for (int cc = tid; cc < 512; cc += NTHR) {
            const int g = cc >> 7, win = 2 << g;
            const bf16_t* __restrict__ src = Z + cc;
            unsigned short xv[79];
#pragma unroll
            for (int j = 0; j < 79; ++j) { const int tt = t0 - 15 + j; xv[j] = (tt >= 0 && j >= 16 - win) ? src[(size_t)tt * ZLD] : (unsigned short)0; }
            float sacc = 0.f;
#pragma unroll
            for (int j = 0; j < 15; ++j) sacc += bf2f(xv[j]);
            bf16_t* dp = (bf16_t*)(ws + O_POOL) + (size_t)t0 * 512 + cc;
#pragma unroll
            for (int j = 0; j < 64; ++j) { const int t = t0 + j; const float x0 = bf2f(xv[15 + j]); sacc += x0;
                const int cnt = (t + 1) < win ? (t + 1) : win; dp[(size_t)j * 512] = f2bf(sacc / (float)cnt - x0);
                const float lv = (g == 0) ? bf2f(xv[15 + j - 1]) : (g == 1) ? bf2f(xv[15 + j - 3]) : (g == 2) ? bf2f(xv[15 + j - 7]) : bf2f(xv[15 + j - 15]);
                sacc -= lv; }
        }
        __syncthreads();
    }
}

#define MFMA32(a, b, c) __builtin_amdgcn_mfma_f32_32x32x16_bf16((a), (b), (c), 0, 0, 0)
template <bool FOX>
__device__ __forceinline__ void attn_unit(int h, int qb, const bf16_t* Z, const bf16_t* Vt, const float* cl2, const LAS float* P2L, float sink2, bf16_t* ybr, int lane) {
    const int q = lane & 31, hi = lane >> 5, t0 = qb * 32, t = t0 + q;
    const int qcol = FOX ? (ZC_QFOX + h * 64) : (ZC_QSWA + h * 64);
    const int kcol = FOX ? (ZC_KFOX + h * 64) : (ZC_KSWA + (h >> 2) * 64);
    const int ocol = FOX ? (1536 + h * 64) : (512 + h * 64);
    const bf16_t* Vth = Vt + (size_t)((FOX ? h : (h >> 2)) * 64 + q) * S + 16 * hi;
    const int pim = 16 * ((q >> 2) & 1) + 4 * (q >> 3) + (q & 3);
    const bf16_t* Kp = Z + (size_t)pim * ZLD + kcol + 8 * hi;
    const float* clh = cl2 + (size_t)h * S + 16 * hi;
    bf16x8 qf[4];
#pragma unroll
    for (int d0 = 0; d0 < 4; ++d0) qf[d0] = *(const bf16x8*)(Z + (size_t)t * ZLD + qcol + 16 * d0 + 8 * hi);
    const int kv_lo = FOX ? 0 : (t0 >= 128 ? t0 - 128 : 0);
    const int ntiles = (t0 - kv_lo) / 32 + 1;
    float mhat = FOX ? 0.f : sink2, l = FOX ? 0.f : (hi == 0 ? 1.f : 0.f);
    float cq = 0.f; if (FOX) cq = cl2[(size_t)h * S + t] + P2L[(t >> 6) * 8 + h];
    f32x16 o0, o1;
#pragma unroll
    for (int r = 0; r < 16; ++r) { o0[r] = 0.f; o1[r] = 0.f; }
    bf16x8 kf[4], vf[4]; f32x4 ck[4];
    {
        const int kv0 = kv_lo;
#pragma unroll
        for (int d0 = 0; d0 < 4; ++d0) kf[d0] = *(const bf16x8*)(Kp + (size_t)kv0 * ZLD + 16 * d0);
#pragma unroll
        for (int i = 0; i < 4; ++i) vf[i] = *(const bf16x8*)(Vth + (size_t)(i >> 1) * 32 * S + kv0 + 8 * (i & 1));
        if (FOX) {
#pragma unroll
            for (int i = 0; i < 4; ++i) ck[i] = *(const f32x4*)(clh + kv0 + 4 * i);
        }
    }
    for (int it = 0; it < ntiles; ++it) {
        const int kv0 = kv_lo + 32 * it;
        const int itn = (it + 1 < ntiles) ? it + 1 : it; const int kvn = kv_lo + 32 * itn;
        bf16x8 kfn[4], vfn[4]; f32x4 ckn[4];
#pragma unroll
        for (int d0 = 0; d0 < 4; ++d0) kfn[d0] = *(const bf16x8*)(Kp + (size_t)kvn * ZLD + 16 * d0);
#pragma unroll
        for (int i = 0; i < 4; ++i) vfn[i] = *(const bf16x8*)(Vth + (size_t)(i >> 1) * 32 * S + kvn + 8 * (i & 1));
        if (FOX) {
#pragma unroll
            for (int i = 0; i < 4; ++i) ckn[i] = *(const f32x4*)(clh + kvn + 4 * i);
        }
        f32x16 acc;
        if (FOX) {
            const float base = (cq - P2L[(kv0 >> 6) * 8 + h]) - mhat;
#pragma unroll
            for (int r = 0; r < 16; ++r) acc[r] = base - ck[r >> 2][r & 3];
        } else {
#pragma unroll
            for (int r = 0; r < 16; ++r) acc[r] = -mhat;
        }
#pragma unroll
        for (int d0 = 0; d0 < 4; ++d0) acc = MFMA32(kf[d0], qf[d0], acc);
        if (FOX) {
            if (it == ntiles - 1) {
#pragma unroll
                for (int r = 0; r < 16; ++r) if (16 * hi + r > q) acc[r] = -INFINITY;
            }
        } else {
#pragma unroll
            for (int r = 0; r < 16; ++r) { const int kv = kv0 + 16 * hi + r; if (kv > t || kv + 127 < t) acc[r] = -INFINITY; }
        }
        float mt = acc[0];
#pragma unroll
        for (int r = 1; r < 16; ++r) mt = fmaxf(mt, acc[r]);
        mt = fmaxf(mt, __shfl_xor(mt, 32));
        const bool first = FOX && (it == 0);
        if (first || __any(mt > 8.f)) {
            const float delta = first ? mt : fmaxf(mt, 0.f);
            mhat += delta;
            const float al = first ? 1.f : __builtin_amdgcn_exp2f(-delta);
            l *= al;
#pragma unroll
            for (int r = 0; r < 16; ++r) { acc[r] -= delta; o0[r] *= al; o1[r] *= al; }
        }
        float ps = 0.f;
#pragma unroll
        for (int r = 0; r < 16; ++r) { acc[r] = __builtin_amdgcn_exp2f(acc[r]); ps += acc[r]; }
        l += ps;
        u32x4 w0, w1;
        w0.x = pk2(acc[0], acc[1]); w0.y = pk2(acc[2], acc[3]); w0.z = pk2(acc[4], acc[5]); w0.w = pk2(acc[6], acc[7]);
        w1.x = pk2(acc[8], acc[9]); w1.y = pk2(acc[10], acc[11]); w1.z = pk2(acc[12], acc[13]); w1.w = pk2(acc[14], acc[15]);
        const bf16x8 pb0 = __builtin_bit_cast(bf16x8, w0), pb1 = __builtin_bit_cast(bf16x8, w1);
        o0 = MFMA32(vf[0], pb0, o0); o0 = MFMA32(vf[1], pb1, o0);
        o1 = MFMA32(vf[2], pb0, o1); o1 = MFMA32(vf[3], pb1, o1);
#pragma unroll
        for (int i = 0; i < 4; ++i) { kf[i] = kfn[i]; vf[i] = vfn[i]; if (FOX) ck[i] = ckn[i]; }
    }
    l += __shfl_xor(l, 32);
    const float inv = 1.f / l;
    bf16_t* op = ybr + (size_t)t * DM + ocol + 4 * hi;
#pragma unroll
    for (int g = 0; g < 4; ++g) {
        u32x2 w; w.x = pk2(o0[4 * g] * inv, o0[4 * g + 1] * inv); w.y = pk2(o0[4 * g + 2] * inv, o0[4 * g + 3] * inv); *(u32x2*)(op + 8 * g) = w;
        w.x = pk2(o1[4 * g] * inv, o1[4 * g + 1] * inv); w.y = pk2(o1[4 * g + 2] * inv, o1[4 * g + 3] * inv); *(u32x2*)(op + 32 + 8 * g) = w;
    }
}


__device__ __forceinline__ void fox_unit(int h, int Q, const bf16_t* Z, const bf16_t* Vt, const LAS float* clL, const LAS float* P2L, bf16_t* ybr, LAS unsigned char* lds, int wave, int lane) {
    const int q = lane & 31, hi = lane >> 5, t = Q * 256 + wave * 32 + q;
    const int kx = (q >> 1) & 7;
    const int my_last = 4 * Q + (wave >> 1), ntile = 4 * Q + 4;
    const int P = wave * 64 + lane, lrow = P >> 3, piece = (P & 7) ^ ((lrow >> 1) & 7);
    const int lr = lrow & 31, grow = 32 * (lrow >> 5) + 16 * ((lr >> 2) & 1) + 4 * (lr >> 3) + (lr & 3);
    const bf16_t* ksrc = Z + (size_t)grow * ZLD + ZC_KFOX + h * 64 + piece * 8;
    const bf16_t* vsrc = Vt + (size_t)(h * 64 + lrow) * S + piece * 8;
    const LAS float* clh = clL + 16 * hi;
    bf16x8 qf[4];
#pragma unroll
    for (int d0 = 0; d0 < 4; ++d0) qf[d0] = *(const bf16x8*)(Z + (size_t)t * ZLD + ZC_QFOX + h * 64 + 16 * d0 + 8 * hi);
    const float cq = clL[t] + P2L[(t >> 6) * 8 + h];
    float mhat = 0.f;
    f32x16 o0, o1, lacc;
#pragma unroll
    for (int r = 0; r < 16; ++r) { o0[r] = 0.f; o1[r] = 0.f; lacc[r] = 0.f; }
    const short one_ = (q == 0) ? (short)0x3F80 : (short)0;
    const bf16x8 ones = {one_, one_, one_, one_, one_, one_, one_, one_};
    asm volatile("s_waitcnt vmcnt(0)" ::: "memory");
    asm volatile("" : "+v"(qf[0]), "+v"(qf[1]), "+v"(qf[2]), "+v"(qf[3]));
    __builtin_amdgcn_global_load_lds((const unsigned*)ksrc, (LAS unsigned*)(lds + wave * 1024), 16, 0, 0);
    __builtin_amdgcn_global_load_lds((const unsigned*)vsrc, (LAS unsigned*)(lds + 8192 + wave * 1024), 16, 0, 0);
    __builtin_amdgcn_global_load_lds((const unsigned*)(ksrc + (size_t)64 * ZLD), (LAS unsigned*)(lds + 16384 + wave * 1024), 16, 0, 0);
    __builtin_amdgcn_global_load_lds((const unsigned*)(vsrc + 64), (LAS unsigned*)(lds + 16384 + 8192 + wave * 1024), 16, 0, 0);
    const int koff = q * 128, voff = 8192 + q * 128;
    int s_cur = 0, s_nxt2 = 2 * 16384;
    for (int i = 0; i < ntile; ++i) {
        if (i + 1 < ntile) asm volatile("s_waitcnt vmcnt(2) lgkmcnt(0)\n\ts_barrier" ::: "memory");
        else asm volatile("s_waitcnt vmcnt(0) lgkmcnt(0)\n\ts_barrier" ::: "memory");
        if (i + 2 < ntile) {
            const int kvn = 64 * (i + 2);
            LAS unsigned char* dst = lds + s_nxt2 + wave * 1024;
            __builtin_amdgcn_global_load_lds((const unsigned*)(ksrc + (size_t)kvn * ZLD), (LAS unsigned*)dst, 16, 0, 0);
            __builtin_amdgcn_global_load_lds((const unsigned*)(vsrc + kvn), (LAS unsigned*)(dst + 8192), 16, 0, 0);
        }
        const bool active = (i <= my_last);
        f32x16 a0, a1;
        if (active) {
            const float base = (cq - P2L[i * 8 + h]) - mhat;
            const LAS float* cp = clh + 64 * i;
#pragma unroll
            for (int j = 0; j < 4; ++j) { const f32x4 c0 = *(const LAS f32x4*)(cp + 4 * j), c1 = *(const LAS f32x4*)(cp + 32 + 4 * j);
#pragma unroll
                for (int e = 0; e < 4; ++e) { a0[4 * j + e] = base - c0[e]; a1[4 * j + e] = base - c1[e]; } }
        }
        if (active) {
            const LAS unsigned char* sl = lds + s_cur;
            bf16x8 kfa[4], kfb[4];
#pragma unroll
            for (int d0 = 0; d0 < 4; ++d0) { const int so = ((2 * d0 + hi) ^ kx) * 16; kfa[d0] = *(const LAS bf16x8*)(sl + koff + so); kfb[d0] = *(const LAS bf16x8*)(sl + 4096 + koff + so); }
#pragma unroll
            for (int d0 = 0; d0 < 4; ++d0) { a0 = MFMA32(kfa[d0], qf[d0], a0); a1 = MFMA32(kfb[d0], qf[d0], a1); }
            if (i == my_last) {
#pragma unroll
                for (int r = 0; r < 16; ++r) { const int kv = 64 * i + 16 * hi + r; if (kv > t) a0[r] = -INFINITY; if (kv + 32 > t) a1[r] = -INFINITY; }
            }
            float mt = fmaxf(a0[0], a1[0]);
#pragma unroll
            for (int r = 1; r < 16; ++r) mt = fmaxf(mt, fmaxf(a0[r], a1[r]));
            mt = fmaxf(mt, __shfl_xor(mt, 32));
            const bool first = (i == 0);
            if (first || __any(mt > 30.f)) {
                const float delta = first ? mt : (mt > 0.f ? mt + 30.f : 0.f);
                mhat += delta;
                const float al = first ? 1.f : __builtin_amdgcn_exp2f(-delta);
                lacc[0] *= al;
#pragma unroll
                for (int r = 0; r < 16; ++r) { a0[r] -= delta; a1[r] -= delta; o0[r] *= al; o1[r] *= al; }
            }
#pragma unroll
            for (int r = 0; r < 16; ++r) { a0[r] = __builtin_amdgcn_exp2f(a0[r]); a1[r] = __builtin_amdgcn_exp2f(a1[r]); }
            u32x4 w0, w1, w2, w3;
            w0.x = pk2(a0[0], a0[1]); w0.y = pk2(a0[2], a0[3]); w0.z = pk2(a0[4], a0[5]); w0.w = pk2(a0[6], a0[7]);
            w1.x = pk2(a0[8], a0[9]); w1.y = pk2(a0[10], a0[11]); w1.z = pk2(a0[12], a0[13]); w1.w = pk2(a0[14], a0[15]);
            w2.x = pk2(a1[0], a1[1]); w2.y = pk2(a1[2], a1[3]); w2.z = pk2(a1[4], a1[5]); w2.w = pk2(a1[6], a1[7]);
            w3.x = pk2(a1[8], a1[9]); w3.y = pk2(a1[10], a1[11]); w3.z = pk2(a1[12], a1[13]); w3.w = pk2(a1[14], a1[15]);
            const bf16x8 pb0 = __builtin_bit_cast(bf16x8, w0), pb1 = __builtin_bit_cast(bf16x8, w1), pb2 = __builtin_bit_cast(bf16x8, w2), pb3 = __builtin_bit_cast(bf16x8, w3);
            const int v00 = ((2 * hi) ^ kx) * 16, v01 = ((2 * hi + 1) ^ kx) * 16, v10 = ((4 + 2 * hi) ^ kx) * 16, v11 = ((5 + 2 * hi) ^ kx) * 16;
            const bf16x8 va0 = *(const LAS bf16x8*)(sl + voff + v00), vb0 = *(const LAS bf16x8*)(sl + voff + 4096 + v00), va1 = *(const LAS bf16x8*)(sl + voff + v01), vb1 = *(const LAS bf16x8*)(sl + voff + 4096 + v01);
            const bf16x8 va2 = *(const LAS bf16x8*)(sl + voff + v10), vb2 = *(const LAS bf16x8*)(sl + voff + 4096 + v10), va3 = *(const LAS bf16x8*)(sl + voff + v11), vb3 = *(const LAS bf16x8*)(sl + voff + 4096 + v11);
            o0 = MFMA32(va0, pb0, o0); o1 = MFMA32(vb0, pb0, o1); lacc = MFMA32(ones, pb0, lacc);
            o0 = MFMA32(va1, pb1, o0); o1 = MFMA32(vb1, pb1, o1); lacc = MFMA32(ones, pb1, lacc);
            o0 = MFMA32(va2, pb2, o0); o1 = MFMA32(vb2, pb2, o1); lacc = MFMA32(ones, pb2, lacc);
            o0 = MFMA32(va3, pb3, o0); o1 = MFMA32(vb3, pb3, o1); lacc = MFMA32(ones, pb3, lacc);
        }
        s_cur = (s_cur == 2 * 16384) ? 0 : s_cur + 16384; s_nxt2 = (s_nxt2 == 2 * 16384) ? 0 : s_nxt2 + 16384;
    }
    float l = (hi == 0) ? lacc[0] : 0.f;
    l += __shfl_xor(l, 32);
    const float inv = 1.f / l;
    bf16_t* op = ybr + (size_t)t * DM + 1536 + h * 64 + 4 * hi;
#pragma unroll
    for (int g = 0; g < 4; ++g) {
        u32x2 w; w.x = pk2(o0[4 * g] * inv, o0[4 * g + 1] * inv); w.y = pk2(o0[4 * g + 2] * inv, o0[4 * g + 3] * inv); *(u32x2*)(op + 8 * g) = w;
        w.x = pk2(o1[4 * g] * inv, o1[4 * g + 1] * inv); w.y = pk2(o1[4 * g + 2] * inv, o1[4 * g + 3] * inv); *(u32x2*)(op + 32 + 8 * g) = w;
    }
    asm volatile("s_waitcnt vmcnt(0) lgkmcnt(0)\n\ts_barrier" ::: "memory");
}

__device__ __forceinline__ void phase_mix1(const Params& p, int l, LAS unsigned char* lds, int wave_, int lane_, int G) {
    const int lane = lane_id(), wave = launder_s(wave_); (void)lane_;
    unsigned char* ws = launder_p(p.ws);
    LAS float* P2L = (LAS float*)(lds + LDS_P2);
    {
        const float* tot = (const float*)(ws + O_TOT2); const int h = wave;
        const float a0 = tot[(4 * lane) * 8 + h], a1 = tot[(4 * lane + 1) * 8 + h], a2 = tot[(4 * lane + 2) * 8 + h], a3 = tot[(4 * lane + 3) * 8 + h];
        const float incl = scan_sum(a0 + a1 + a2 + a3, lane); const float ex = incl - (a0 + a1 + a2 + a3);
        P2L[(4 * lane) * 8 + h] = ex; P2L[(4 * lane + 1) * 8 + h] = ex + a0; P2L[(4 * lane + 2) * 8 + h] = ex + a0 + a1; P2L[(4 * lane + 3) * 8 + h] = ex + a0 + a1 + a2;
    }
    __syncthreads();
    if (DBG_MIX & 1) {
        pg8::SimpleSched Sd{(const char*)(ws + O_POOL), (const char*)(ws + OW_BD), 512, 512, 64, 2, G, (int)blockIdx.x, 8};
        pg8::EpiPool E{(bf16_t*)(ws + O_YBR), p.pool_scale + (size_t)l * 512};
        pg8::gemm_phase(lds, 512, 512, Sd, E, wave);
    }
    const int gw = blockIdx.x * NWAVES + wave, NGW = G * NWAVES;
    const int q = lane & 31, hi = lane >> 5;
    if (DBG_MIX & 2) for (int task = gw; task < 4096; task += NGW) {
        const int vb = task & 3, h = (task >> 2) & 3, c = task >> 4;
        const bf16_t* Ap = (const bf16_t*)(ws + O_VTW) + (size_t)(h * 128 + 32 * vb + q) * S + c * 64 + 8 * hi;
        bf16x8 af[4];
#pragma unroll
        for (int ks = 0; ks < 4; ++ks) af[ks] = *(const bf16x8*)(Ap + 16 * ks);
        float* Uo = (float*)(ws + O_U) + ((size_t)(c * 4 + h) * 128 + 32 * vb) * 128;
#pragma unroll
        for (int kb = 0; kb < 4; ++kb) {
            const bf16_t* Bp = (const bf16_t*)(ws + O_KTM) + (size_t)(h * 128 + 32 * kb + q) * S + c * 64 + 8 * hi;
            f32x16 acc;
#pragma unroll
            for (int r = 0; r < 16; ++r) acc[r] = 0.f;
#pragma unroll
            for (int ks = 0; ks < 4; ++ks) acc = MFMA32(af[ks], *(const bf16x8*)(Bp + 16 * ks), acc);
#pragma unroll
            for (int r = 0; r < 16; ++r) Uo[(size_t)crow(r, hi) * 128 + 32 * kb + q] = acc[r];
        }
    }
    if (DBG_MIX & 4) for (int task = gw; task < 4096; task += NGW) {
        const int h = task & 7, qb = task >> 3;
        attn_unit<false>(h, qb, (const bf16_t*)(ws + O_R1), (const bf16_t*)(ws + O_VTS), nullptr, P2L, p.swa_sinks[l * 8 + h] * LOG2E, (bf16_t*)(ws + O_YBR), lane);
    }
    __syncthreads();
    if (DBG_MIX & 8) {
        const int h = blockIdx.x & 7;
        LAS float* clL = (LAS float*)(lds + 49152);
        { const f32x4* src = (const f32x4*)((const float*)(ws + O_CL2) + (size_t)h * S); const int tid = wave * 64 + lane;
#pragma unroll
          for (int j = 0; j < 8; ++j) *(LAS f32x4*)(clL + 4 * (tid + j * NTHR)) = src[tid + j * NTHR]; }
        __syncthreads();
        for (int pr = (blockIdx.x >> 3); pr < 32; pr += (G >> 3)) {
            fox_unit(h, 63 - pr, (const bf16_t*)(ws + O_R1), (const bf16_t*)(ws + O_VTF), clL, P2L, (bf16_t*)(ws + O_YBR), lds, wave, lane);
            fox_unit(h, pr, (const bf16_t*)(ws + O_R1), (const bf16_t*)(ws + O_VTF), clL, P2L, (bf16_t*)(ws + O_YBR), lds, wave, lane);
        }
    }
}

__device__ __forceinline__ void phase_scan(const Params& p, LAS unsigned char* lds, int wave_, int G) {
    unsigned char* ws = launder_p(p.ws); const int tid = launder_s(wave_) * 64 + lane_id();
    if ((int)blockIdx.x * NTHR >= 4 * 16512) return;
    LAS float* decL = (LAS float*)lds; LAS float* sclL = decL + 1024; LAS float* blL = sclL + 1024; LAS float* dmL = blL + 1024;
    for (int i = tid; i < 1024; i += NTHR) { blL[i] = ((const float*)(ws + O_BLC))[i]; dmL[i] = ((const float*)(ws + O_DMC))[i]; }
    __syncthreads();
    if (tid < 4) {
        const int h = tid; float m = 0.f;
        for (int c = 0; c < 256; ++c) {
            const float bl = blL[c * 4 + h], dm = dmL[c * 4 + h]; const float mn = fmaxf(bl + m, bl + dm);
            decL[c * 4 + h] = __expf(bl + m - mn); sclL[c * 4 + h] = __expf(bl + dm - mn);
            if (blockIdx.x == 0) ((float*)(ws + O_MST))[c * 4 + h] = m;
            m = mn;
        }
    }
    __syncthreads();
    const int e = blockIdx.x * NTHR + tid;
    if (e < 4 * 16512) {
        const int h = e / 16512, idx = e % 16512;
        float st = 0.f;
        if (idx < 16384) {
            const float* src = (const float*)(ws + O_U) + (size_t)h * 16384 + idx; bf16_t* dst = (bf16_t*)(ws + O_CST) + (size_t)h * 16384 + idx;
            for (int c0 = 0; c0 < 256; c0 += 32) {
                float u[32];
#pragma unroll
                for (int j = 0; j < 32; ++j) u[j] = src[(size_t)(c0 + j) * 65536];
#pragma unroll
                for (int j = 0; j < 32; ++j) { dst[(size_t)(c0 + j) * 65536] = f2bf(st); st = decL[(c0 + j) * 4 + h] * st + sclL[(c0 + j) * 4 + h] * u[j]; }
            }
        } else {
            const int k = idx - 16384;
            const float* src = (const float*)(ws + O_UN) + h * 128 + k; float* dst = (float*)(ws + O_NST) + h * 128 + k;
            for (int c0 = 0; c0 < 256; c0 += 8) {
                float u[8];
#pragma unroll
                for (int j = 0; j < 8; ++j) u[j] = src[(size_t)(c0 + j) * 512];
#pragma unroll
                for (int j = 0; j < 8; ++j) { dst[(size_t)(c0 + j) * 512] = st; st = decL[(c0 + j) * 4 + h] * st + sclL[(c0 + j) * 4 + h] * u[j]; }
            }
        }
    }
}

__device__ __forceinline__ void phase_mlout(const Params& p, int wave_, int lane_, int G) {
    const int lane = lane_id(), wave = launder_s(wave_); (void)lane_;
    unsigned char* ws = launder_p(p.ws);
    const int gw = blockIdx.x * NWAVES + wave, NGW = G * NWAVES;
    const int q = lane & 31, hi = lane >> 5;
    const int pim = 16 * ((q >> 2) & 1) + 4 * (q >> 3) + (q & 3);
    const bf16_t* QKC = (const bf16_t*)(ws + O_QKC); const bf16_t* Z = (const bf16_t*)(ws + O_R1);
    for (int task = gw; task < 2048; task += NGW) {
        const int tb = task & 1, h = (task >> 1) & 3, c = task >> 3;
        const int t = c * 64 + 32 * tb + q;
        bf16x8 qf[8];
#pragma unroll
        for (int kk = 0; kk < 8; ++kk) qf[kk] = *(const bf16x8*)(QKC + (size_t)t * 1024 + h * 128 + 16 * kk + 8 * hi);
        const float m_c = ((const float*)(ws + O_MST))[c * 4 + h];
        const float a_t = ((const float*)(ws + O_MLA))[h * S + t], b_t = ((const float*)(ws + O_MLB))[h * S + t];
        const float Mt = fmaxf(m_c, a_t), w_inter = __expf(m_c - Mt);
        f32x16 o[4];
#pragma unroll
        for (int vb = 0; vb < 4; ++vb) {
#pragma unroll
            for (int r = 0; r < 16; ++r) o[vb][r] = 0.f;
            const bf16_t* Cp = (const bf16_t*)(ws + O_CST) + ((size_t)(c * 4 + h) * 128 + 32 * vb + q) * 128 + 8 * hi;
#pragma unroll
            for (int kk = 0; kk < 8; ++kk) o[vb] = MFMA32(*(const bf16x8*)(Cp + 16 * kk), qf[kk], o[vb]);
#pragma unroll
            for (int r = 0; r < 16; ++r) o[vb][r] *= w_inter;
        }
        float nq = 0.f;
        {
            const float* np = (const float*)(ws + O_NST) + (size_t)(c * 4 + h) * 128 + 8 * hi;
#pragma unroll
            for (int kk = 0; kk < 8; ++kk) { const f32x4 n0 = *(const f32x4*)(np + 16 * kk), n1 = *(const f32x4*)(np + 16 * kk + 4);
                const bf16x8 qq = qf[kk];
                nq += n0[0] * bf2f((unsigned short)qq[0]) + n0[1] * bf2f((unsigned short)qq[1]) + n0[2] * bf2f((unsigned short)qq[2]) + n0[3] * bf2f((unsigned short)qq[3])
                    + n1[0] * bf2f((unsigned short)qq[4]) + n1[1] * bf2f((unsigned short)qq[5]) + n1[2] * bf2f((unsigned short)qq[6]) + n1[3] * bf2f((unsigned short)qq[7]); }
            nq += __shfl_xor(nq, 32);
        }
        float den = 0.f;
        for (int sb = 0; sb <= tb; ++sb) {
            const int s0 = c * 64 + 32 * sb;
            f32x16 acc;
#pragma unroll
            for (int r = 0; r < 16; ++r) acc[r] = 0.f;
            const bf16_t* Kp = QKC + (size_t)(s0 + pim) * 1024 + 512 + h * 128 + 8 * hi;
#pragma unroll
            for (int kk = 0; kk < 8; ++kk) acc = MFMA32(*(const bf16x8*)(Kp + 16 * kk), qf[kk], acc);
            const float* dp = (const float*)(ws + O_MLD) + (size_t)h * S + s0 + 16 * hi;
#pragma unroll
            for (int r = 0; r < 16; ++r) { const int s = s0 + 16 * hi + r; const float w = (s <= t) ? __expf(dp[r] - Mt) : 0.f; acc[r] *= w; den += acc[r]; }
            u32x4 w0, w1;
            w0.x = pk2(acc[0], acc[1]); w0.y = pk2(acc[2], acc[3]); w0.z = pk2(acc[4], acc[5]); w0.w = pk2(acc[6], acc[7]);
            w1.x = pk2(acc[8], acc[9]); w1.y = pk2(acc[10], acc[11]); w1.z = pk2(acc[12], acc[13]); w1.w = pk2(acc[14], acc[15]);
            const bf16x8 pb0 = __builtin_bit_cast(bf16x8, w0), pb1 = __builtin_bit_cast(bf16x8, w1);
#pragma unroll
            for (int vb = 0; vb < 4; ++vb) {
                const bf16_t* Vp = (const bf16_t*)(ws + O_VTM) + (size_t)(h * 128 + 32 * vb + q) * S + s0 + 16 * hi;
                o[vb] = MFMA32(*(const bf16x8*)Vp, pb0, o[vb]); o[vb] = MFMA32(*(const bf16x8*)(Vp + 8), pb1, o[vb]);
            }
        }
        den += __shfl_xor(den, 32);
        den += w_inter * nq;
        const float hd = fmaxf(fabsf(den), __expf(-(b_t + Mt))); const float inv = 1.f / hd;
        const bf16_t* opre = Z + (size_t)t * ZLD + ZC_OML + h * 128 + 4 * hi;
        bf16_t* op = (bf16_t*)(ws + O_YBR) + (size_t)t * DM + 1024 + h * 128 + 4 * hi;
#pragma unroll
        for (int vb = 0; vb < 4; ++vb)
#pragma unroll
            for (int g = 0; g < 4; ++g) {
                const u32x2 og = *(const u32x2*)(opre + 32 * vb + 8 * g);
                u32x2 w; w.x = pk2(sigmoidf_(bflo(og.x)) * o[vb][4 * g] * inv, sigmoidf_(bfhi(og.x)) * o[vb][4 * g + 1] * inv);
                w.y = pk2(sigmoidf_(bflo(og.y)) * o[vb][4 * g + 2] * inv, sigmoidf_(bfhi(og.y)) * o[vb][4 * g + 3] * inv);
                *(u32x2*)(op + 32 * vb + 8 * g) = w;
            }
    }
}


__device__ __forceinline__ void dbg_dump(float* out, const void* src, int mode, int wave, int G) {
    const int gt = blockIdx.x * NTHR + wave * 64 + lane_id(), NGT = G * NTHR;
    for (int i = gt; i < S * DM; i += NGT) out[i] = mode ? bf2f(((const bf16_t*)src)[i]) : ((const float*)src)[i];
}
#define DBG_AT(k, off, mode) do { if (DBG_STOP == (k) && l == 0) { GRID_SYNC(15); dbg_dump(p.out, p.ws + (off), (mode), wave, G); return; } } while (0)
#define XB_TMO      128
#define XB_XCNT(j)  (256  + 64 * (j))
#define XB_XSUB(j)  (1280 + 64 * (j))
#define XB_XGEN(j)  (2304 + 64 * (j))
#define XB_TOP      3328
#define XB_TOPGEN   3392
#define XB_SPIN_CAP (1u << 22)
__device__ __forceinline__ unsigned xb_ld(unsigned* p)              { return __hip_atomic_load(p, __ATOMIC_RELAXED, __HIP_MEMORY_SCOPE_AGENT); }
__device__ __forceinline__ unsigned xb_add(unsigned* p, unsigned v) { return __hip_atomic_fetch_add(p, v, __ATOMIC_RELAXED, __HIP_MEMORY_SCOPE_AGENT); }
__device__ __forceinline__ unsigned xb_xcc_id() { return (unsigned)__builtin_amdgcn_s_getreg((3 << 11) | 20) & 0xFu; }
#define XB_SPIN(cond, bar) do { unsigned _sp = 0; while (cond) { __builtin_amdgcn_s_sleep(1); \
    if ((++_sp & 255u) == 0u) { if (xb_ld(&(bar)[XB_TMO])) break; if (_sp > XB_SPIN_CAP) { atomicAdd(&(bar)[XB_TMO], 1u); break; } } } } while (0)
__device__ __forceinline__ void xcd_census(unsigned* bar, unsigned x, unsigned G, unsigned& nloc, unsigned& nx) {
    unsigned sum, cnt, mine, sp = 0u;
    for (;;) {
        sum = 0u; cnt = 0u; mine = 0u;
#pragma unroll
        for (unsigned j = 0; j < 16; ++j) { const unsigned c = xb_ld(&bar[XB_XCNT(j)]); sum += c; cnt += (c > 0u) ? 1u : 0u; mine = (j == x) ? c : mine; }
        if (sum == G) break;
        __builtin_amdgcn_s_sleep(1);
        if ((++sp & 255u) == 0u) { if (xb_ld(&bar[XB_TMO])) break; if (sp > XB_SPIN_CAP) { atomicAdd(&bar[XB_TMO], 1u); break; } }
    }
    nloc = mine > 0u ? mine : 1u; nx = cnt > 0u ? cnt : 1u;
}
__device__ __forceinline__ void grid_barrier(unsigned* bar, volatile LAS unsigned* st, unsigned G, int wave) {
    asm volatile("s_waitcnt vmcnt(0) lgkmcnt(0)" ::: "memory");
    __syncthreads();
    if (wave == 0 && lane_id() == 0) {
        const unsigned x = xb_xcc_id();
        unsigned nloc = st[0], nx = st[1];
        if (nloc == 0u) { xcd_census(bar, x, G, nloc, nx); st[0] = nloc; st[1] = nx; }
        const unsigned old = xb_add(&bar[XB_XSUB(x)], 1u);
        const unsigned gen = old / nloc;
        if (old + 1u == (gen + 1u) * nloc) {
            __builtin_amdgcn_fence(__ATOMIC_RELEASE, "agent");
            asm volatile("s_waitcnt vmcnt(0)" ::: "memory");
            const unsigned og = xb_add(&bar[XB_TOP], 1u);
            const unsigned tg = og / nx;
            if (og + 1u == (tg + 1u) * nx) xb_add(&bar[XB_TOPGEN], 1u);
            else XB_SPIN(xb_ld(&bar[XB_TOPGEN]) == tg, bar);
            __builtin_amdgcn_fence(__ATOMIC_ACQUIRE, "agent");
            xb_add(&bar[XB_XGEN(x)], 1u);
            asm volatile("s_waitcnt vmcnt(0)" ::: "memory");
        } else {
            XB_SPIN(xb_ld(&bar[XB_XGEN(x)]) == gen, bar);
            __builtin_amdgcn_fence(__ATOMIC_ACQUIRE, "agent");
            asm volatile("s_waitcnt vmcnt(0)" ::: "memory");
        }
    }
    __syncthreads();
}
#define GRID_SYNC(k) grid_barrier((unsigned*)(p.ws + O_CTL), (volatile LAS unsigned*)(lds + LDS_MISC + 2048), (unsigned)G, wave)
__global__ void __launch_bounds__(NTHR, 2) fwd_megakernel(Params p) {
    extern __shared__ __attribute__((aligned(16))) unsigned char lds_raw[];
    LAS unsigned char* lds = (LAS unsigned char*)lds_raw;
    cg::grid_group grid = cg::this_grid();
    const int wave = __builtin_amdgcn_readfirstlane((int)threadIdx.x >> 6), lane = 0;
    const int G = gridDim.x, bx = blockIdx.x;
    grid.sync();
    if (wave == 0 && lane_id() == 0) { volatile LAS unsigned* st = (volatile LAS unsigned*)(lds + LDS_MISC + 2048); st[0] = 0u; st[1] = 0u; (void)xb_add((unsigned*)(p.ws + O_CTL) + XB_XCNT(xb_xcc_id()), 1u); }
    __syncthreads();

    for (int l = 0; l < NL; ++l) {
        if (l == 0) { REPS(3) phase_weights(p, 0, lds, wave, lane, G);
            GRID_SYNC(0); }
        REPS(2) { unsigned char* ws = launder_p(p.ws); pg8::SimpleSched Sd{(const char*)(ws + O_HB), (const char*)(ws + OW_F1A), DM, DM, 64, 44, G, bx, 32}; pg8::EpiSwiGLU E{(bf16_t*)(ws + O_R1)}; pg8::gemm_phase(lds, DM, DM, Sd, E, wave); }
        GRID_SYNC(1);
        if (l == 0) { unsigned char* ws = launder_p(p.ws); pg8::SimpleSched Sd{(const char*)(ws + O_R1), (const char*)(ws + OW_F1B), FF, FF, 64, 8, G, bx, 88}; pg8::EpiResid<false> E{p.x, (float*)(ws + O_H), 0.5f, nullptr, nullptr, nullptr}; pg8::gemm_phase(lds, FF, FF, Sd, E, wave); }
        else { unsigned char* ws = launder_p(p.ws); pg8::SimpleSched Sd{(const char*)(ws + O_R1), (const char*)(ws + OW_F1B), FF, FF, 64, 8, G, bx, 88}; pg8::EpiResid<true> E{(const float*)(ws + O_H), (float*)(ws + O_H), 0.5f, (const float*)(ws + O_ST), p.ln_g + (size_t)(l * 3 - 1) * DM, p.ln_b + (size_t)(l * 3 - 1) * DM}; pg8::gemm_phase(lds, FF, FF, Sd, E, wave); }
        GRID_SYNC(2);
        REPS(7) { unsigned char* ws = launder_p(p.ws); const bool dummy = (REP_PHASE == 7) && (rep_ == 0); phase_ln((const float*)(ws + O_H), dummy ? (float*)(ws + O_YBR) : nullptr, (bf16_t*)(ws + (dummy ? O_U : O_HB)), (float*)(ws + O_ST), p.ln_g + (size_t)(l * 3 + 0) * DM, p.ln_b + (size_t)(l * 3 + 0) * DM, wave, lane, G); }
        GRID_SYNC(3);
        DBG_AT(1, O_H, 0);
        { unsigned char* ws = launder_p(p.ws); pg8::SimpleSched Sd{(const char*)(ws + O_HB), (const char*)(ws + OW_IN), DM, DM, 64, 20, G, bx, 32}; pg8::EpiInProj E{(bf16_t*)(ws + O_R1), (float*)(ws + O_ZG)}; pg8::gemm_phase(lds, DM, DM, Sd, E, wave); }
        GRID_SYNC(4);
        DBG_AT(2, O_R1, 1);
        phase_post(p, l, lds, wave, lane, G);
        GRID_SYNC(5);
        DBG_AT(3, O_QKC, 1);
        REPS(1) phase_mix1(p, l, lds, wave, lane, G);
        GRID_SYNC(6);
        DBG_AT(4, O_YBR, 1);
        REPS(6) phase_scan(p, lds, wave, G);
        GRID_SYNC(7);
        REPS(5) phase_mlout(p, wave, lane, G);
        GRID_SYNC(8);
        DBG_AT(5, O_YBR, 1);
        REPS(4) { unsigned char* ws = launder_p(p.ws); pg8::MergeSched Sd{(const char*)(ws + O_HB), (const char*)(ws + O_YBR), (const char*)(ws + OW_G), (const char*)(ws + OW_BC), G, bx};
          pg8::EpiMerge E{(u32x2*)(ws + O_GSC), (u32x4*)(ws + O_MSC), (bf16_t*)(ws + O_MERGED)}; pg8::gemm_phase(lds, DM, DM, Sd, E, wave); }
        GRID_SYNC(9);
        DBG_AT(6, O_MERGED, 1);
        { unsigned char* ws = launder_p(p.ws); pg8::SimpleSched Sd{(const char*)(ws + O_MERGED), (const char*)(ws + OW_O), DM, DM, 64, 8, G, bx, 32}; pg8::EpiResid<true> E{(const float*)(ws + O_H), (float*)(ws + O_H), 1.0f, (const float*)(ws + O_ST), p.ln_g + (size_t)(l * 3 + 0) * DM, p.ln_b + (size_t)(l * 3 + 0) * DM}; pg8::gemm_phase(lds, DM, DM, Sd, E, wave); }
        GRID_SYNC(10);
        { unsigned char* ws = launder_p(p.ws); phase_ln((const float*)(ws + O_H), nullptr, (bf16_t*)(ws + O_HB), (float*)(ws + O_ST), p.ln_g + (size_t)(l * 3 + 1) * DM, p.ln_b + (size_t)(l * 3 + 1) * DM, wave, lane, G); }
        GRID_SYNC(11);
        DBG_AT(7, O_H, 0);
        { unsigned char* ws = launder_p(p.ws); pg8::SimpleSched Sd{(const char*)(ws + O_HB), (const char*)(ws + OW_F2A), DM, DM, 64, 44, G, bx, 32}; pg8::EpiSwiGLU E{(bf16_t*)(ws + O_R1)}; pg8::gemm_phase(lds, DM, DM, Sd, E, wave); }
        GRID_SYNC(12);
        { unsigned char* ws = launder_p(p.ws); pg8::SimpleSched Sd{(const char*)(ws + O_R1), (const char*)(ws + OW_F2B), FF, FF, 64, 8, G, bx, 88}; pg8::EpiResid<true> E{(const float*)(ws + O_H), (float*)(ws + O_H), 0.5f, (const float*)(ws + O_ST), p.ln_g + (size_t)(l * 3 + 1) * DM, p.ln_b + (size_t)(l * 3 + 1) * DM}; pg8::gemm_phase(lds, FF, FF, Sd, E, wave); }
        GRID_SYNC(13);
        { unsigned char* ws = launder_p(p.ws); phase_ln((const float*)(ws + O_H), (l == NL - 1) ? p.out : nullptr, (l == NL - 1) ? nullptr : (bf16_t*)(ws + O_HB), (l == NL - 1) ? nullptr : (float*)(ws + O_ST), p.ln_g + (size_t)(l * 3 + 2) * DM, p.ln_b + (size_t)(l * 3 + 2) * DM, wave, lane, G); }
        if (l + 1 < NL) phase_weights(p, l + 1, lds, wave, lane, G);
        GRID_SYNC(14);
    }
}

extern "C" void kernel_launch(void* const* d_in, const int* in_sizes, int n_in, void* d_out, int out_size, void* d_ws, size_t ws_size, hipStream_t stream) {
    static int grid_blocks = 0;
    if (grid_blocks == 0) {
        if (n_in != 18 || ws_size < O_END) { fprintf(stderr, "kernel_launch: unexpected inputs (n_in %d, ws %zu, need %zu)\n", n_in, ws_size, (size_t)O_END); grid_blocks = -1; return; }
        int dev = 0, cus = 0, per_cu = 0;
        hipGetDevice(&dev);
        hipDeviceGetAttribute(&cus, hipDeviceAttributeMultiprocessorCount, dev);
        hipFuncSetAttribute((const void*)fwd_megakernel, hipFuncAttributeMaxDynamicSharedMemorySize, LDS_BYTES);
        hipOccupancyMaxActiveBlocksPerMultiprocessor(&per_cu, (const void*)fwd_megakernel, NTHR, LDS_BYTES);
        if (per_cu < 1) per_cu = 1;
        grid_blocks = cus * 1;
        (void)hipGetLastError();
    }
    if (grid_blocks < 0) return;
    Params p{};
    p.x = (const float*)d_in[0]; p.ln_g = (const float*)d_in[1]; p.ln_b = (const float*)d_in[2]; p.ffn1_w_in = (const float*)d_in[3]; p.ffn1_w_out = (const float*)d_in[4];
    p.w_in = (const float*)d_in[5]; p.pool_w = (const float*)d_in[6]; p.pool_scale = (const float*)d_in[7]; p.swa_sinks = (const float*)d_in[8]; p.mlstm_conv = (const float*)d_in[9];
    p.mlstm_i_bias = (const float*)d_in[10]; p.mlstm_f_bias = (const float*)d_in[11]; p.fox_f_bias = (const float*)d_in[12]; p.w_branch = (const float*)d_in[13]; p.w_gate = (const float*)d_in[14];
    p.w_out = (const float*)d_in[15]; p.ffn2_w_in = (const float*)d_in[16]; p.ffn2_w_out = (const float*)d_in[17]; p.out = (float*)d_out; p.ws = (unsigned char*)d_ws;
    (void)hipMemsetAsync((unsigned char*)d_ws + O_CTL, 0, 16384, stream);
    void* args[] = {&p};
    hipError_t e = hipLaunchCooperativeKernel((const void*)fwd_megakernel, dim3(grid_blocks), dim3(NTHR), args, LDS_BYTES, stream);
    if (e != hipSuccess) fprintf(stderr, "cooperative launch failed: %s (grid %d)\n", hipGetErrorString(e), grid_blocks);
}
```

```cpp
#include <hip/hip_runtime.h>
#include <hip/hip_cooperative_groups.h>
#include <cstdio>
#include <cstdint>
namespace cg = cooperative_groups;
#define DBG_MIX 15
#define DBG_STOP 0
#define REP_PHASE 0
#define REPS(k) for (int rep_ = 0; rep_ < ((REP_PHASE == (k)) ? 2 : 1); ++rep_)

#define LAS __attribute__((address_space(3)))
typedef unsigned short bf16_t;
typedef short bf16x8 __attribute__((ext_vector_type(8)));
typedef float f32x4 __attribute__((ext_vector_type(4)));
typedef float f32x16 __attribute__((ext_vector_type(16)));
typedef unsigned u32x4 __attribute__((ext_vector_type(4)));
typedef unsigned u32x2 __attribute__((ext_vector_type(2)));
typedef float f32x2_t __attribute__((ext_vector_type(2)));
typedef __bf16 bf16x2_t __attribute__((ext_vector_type(2)));

constexpr int S = 16384, DM = 2048, FF = 5632, ZLD = 4864, NL = 2;
constexpr int NWAVES = 8, NTHR = 512;
constexpr float ALPHA = 1.41421356237309515f;
constexpr float LOG2E = 1.4426950408889634f;
constexpr float C2 = 0.125f * LOG2E;
constexpr float LN_EPS = 1e-5f;
constexpr int ZC_QSWA = 512, ZC_KSWA = 1024, ZC_VSWA = 1152, ZC_QML = 1280, ZC_VML = 2304, ZC_OML = 2816, ZC_QFOX = 3328, ZC_KFOX = 3840, ZC_VFOX = 4352;

constexpr size_t MiB = 1u << 20;
constexpr size_t O_ZG = 0;
constexpr size_t O_MLA = 1 * MiB;
constexpr size_t O_MLB = O_MLA + 256 * 1024;
constexpr size_t O_MLD = O_MLB + 256 * 1024;
constexpr size_t O_CL2 = 2 * MiB;
constexpr size_t O_TOT2 = O_CL2 + 512 * 1024;
constexpr size_t O_BLC = O_TOT2 + 16 * 1024;
constexpr size_t O_DMC = O_BLC + 16 * 1024;
constexpr size_t O_MST = O_DMC + 16 * 1024;
constexpr size_t O_NST = 3 * MiB;
constexpr size_t O_UN = O_NST + 512 * 1024;
constexpr size_t O_ST = 4 * MiB;
constexpr size_t O_W = 8 * MiB;
constexpr size_t OW_F1A = O_W, OW_F1B = OW_F1A + 44 * MiB, OW_IN = OW_F1B + 22 * MiB, OW_G = OW_IN + 20 * MiB, OW_BC = OW_G + 32 * MiB,
                 OW_O = OW_BC + 8 * MiB, OW_F2A = OW_O + 8 * MiB, OW_F2B = OW_F2A + 44 * MiB, OW_BD = OW_F2B + 22 * MiB;
constexpr size_t O_H = 210 * MiB;
constexpr size_t O_HB = 338 * MiB;
constexpr size_t O_R1 = 402 * MiB;
constexpr size_t O_YBR = 578 * MiB;
constexpr size_t O_QKC = 642 * MiB;
constexpr size_t O_VTF = 674 * MiB;
constexpr size_t O_VTS = 690 * MiB;
constexpr size_t O_VTM = 694 * MiB;
constexpr size_t O_VTW = 710 * MiB;
constexpr size_t O_KTM = 726 * MiB;
constexpr size_t O_POOL = 742 * MiB;
constexpr size_t O_U = 758 * MiB;
constexpr size_t O_CST = 822 * MiB;
constexpr size_t O_CTL = 854 * MiB;
constexpr size_t O_END = 855 * MiB;
constexpr size_t O_MERGED = O_QKC;
constexpr size_t O_GSC = O_R1;
constexpr size_t O_MSC = O_R1 + 32 * MiB;

constexpr int RING_BYTES = 131072;
constexpr int LDS_P2 = RING_BYTES;
constexpr int LDS_MISC = RING_BYTES + 8192;
constexpr int LDS_BYTES = 147456;

__device__ __forceinline__ unsigned pk2(float lo, float hi) { f32x2_t v = {lo, hi}; bf16x2_t b = __builtin_convertvector(v, bf16x2_t); return __builtin_bit_cast(unsigned, b); }
__device__ __forceinline__ float bf2f(unsigned short b) { return __uint_as_float((unsigned)b << 16); }
__device__ __forceinline__ float bflo(unsigned w) { return __uint_as_float(w << 16); }
__device__ __forceinline__ float bfhi(unsigned w) { return __uint_as_float(w & 0xffff0000u); }
__device__ __forceinline__ unsigned short f2bf(float f) { return (unsigned short)(pk2(f, 0.f) & 0xffffu); }
__device__ __forceinline__ float sigmoidf_(float x) { return __builtin_amdgcn_rcpf(1.f + __builtin_amdgcn_exp2f(-x * LOG2E)); }
__device__ __forceinline__ float logsigmoidf_(float x) { return fminf(x, 0.f) - log1pf(__expf(-fabsf(x))); }
__device__ __forceinline__ int lane_id() { int l; asm volatile("v_mbcnt_lo_u32_b32 %0, -1, 0\n\tv_mbcnt_hi_u32_b32 %0, -1, %0" : "=v"(l)); return l; }
__device__ __forceinline__ int launder_v(int x) { asm volatile("" : "+v"(x)); return x; }
__device__ __forceinline__ int launder_s(int x) { asm volatile("" : "+s"(x)); return x; }
template <class T> __device__ __forceinline__ T* launder_pv(T* p) { asm volatile("" : "+v"(p)); return p; }
template <class T> __device__ __forceinline__ T* launder_p(T* p) { asm volatile("" : "+s"(p)); return p; }
__device__ __forceinline__ int crow(int r, int hi) { return (r & 3) + 8 * (r >> 2) + 4 * hi; }

namespace pg8 {
constexpr int BM = 256, BK = 64, HALF = 128, HTB = HALF * BK * 2, NXCD = 8, WGM = 8;
__device__ __forceinline__ int lds_byte(int r, int c) { const int st = (r >> 4) * 2 + (c >> 5), rr = r & 15, cc = c & 31, ob = rr * 64 + cc * 2; return st * 1024 + (ob ^ (((ob >> 9) & 1) << 5)); }
__device__ __forceinline__ void stage_rc(int b, int& R, int& C) { const int st = b / 1024, sb = b % 1024, swz = sb ^ (((sb >> 9) & 1) << 5); R = (st >> 1) * 16 + swz / 64; C = (st & 1) * 32 + (swz % 64) / 2; }
__device__ __forceinline__ int perm32(int rho) { const int n = rho >> 4, i = rho & 15; return 8 * (i >> 2) + 4 * n + (i & 3); }

struct Unit { int pm, pn, kind, nt; const char* a; const char* b; };

__device__ __forceinline__ void tile_of(int L, int nM, int nN, int& pm, int& pn) {
    const int nwg = nM * nN; int wgid = L;
    { const int q = nwg / NXCD, r = nwg % NXCD, xcd = wgid % NXCD, off = wgid / NXCD; wgid = (xcd < r ? xcd * (q + 1) : r * (q + 1) + (xcd - r) * q) + off; }
    const int nig = WGM * nN, gid = wgid / nig, fm = gid * WGM, gsz = (nM - fm) < WGM ? (nM - fm) : WGM;
    pm = fm + ((wgid % nig) % gsz); pn = (wgid % nig) / gsz;
}
struct SimpleSched {
    const char* A; const char* Bt; int lda, ldb, nM, nN, G, c, nt;
    __device__ __forceinline__ bool next(int i, Unit& u) const {
        const int L = i * G + c; if (L >= nM * nN) return false;
        tile_of(L, nM, nN, u.pm, u.pn); u.kind = 0; u.nt = nt;
        u.a = A + (size_t)u.pm * 256 * lda * 2; u.b = Bt + (size_t)u.pn * 256 * ldb * 2; return true;
    }
};
struct MergeSched {
    const char* HB; const char* YBR; const char* WG; const char* WBC; int G, c;
    __device__ __forceinline__ bool next(int i, Unit& u) const {
        const int L = (i >> 3) * G + c; if (L >= 64 * 8) return false;
        tile_of(L, 64, 8, u.pm, u.pn); const int sub = i & 7, b = sub >> 1; u.kind = sub;
        if ((sub & 1) == 0) { u.nt = 32; u.a = HB + (size_t)u.pm * 256 * 2048 * 2; u.b = WG + ((size_t)b * 2048 + (size_t)u.pn * 256) * 2048 * 2; }
        else { u.nt = 8; u.a = YBR + ((size_t)u.pm * 256 * 2048 + b * 512) * 2; u.b = WBC + ((size_t)u.pn * 256 * 2048 + b * 512) * 2; }
        return true;
    }
};

template <class Epi, class Sched>
__device__ __forceinline__ void gemm_phase(LAS unsigned char* lds, const int lda, const int ldb, const Sched& S, const Epi& E, const int wave_) {
    const int wid = launder_s(wave_), lane = lane_id(), tid = wid * 64 + lane, wr = wid >> 2, wc = wid & 3, fr = lane & 15, fq = lane >> 4;
    unsigned voffA[2], voffB[2];
#pragma unroll
    for (int i = 0; i < 2; ++i) { int R, C; stage_rc(tid * 16 + i * 8192, R, C); const int Rb = Epi::PERM ? ((R & ~31) + perm32(R & 31)) : R;
        voffA[i] = (unsigned)(R * lda + C) * 2u; voffB[i] = (unsigned)(Rb * ldb + C) * 2u; }
    const size_t kstep = (size_t)(BK * 2);
    const size_t hstepA = (size_t)HALF * lda * 2, hstepB = (size_t)HALF * ldb * 2;
    const unsigned ldsw = (unsigned)wid * 1024u;
    const int aoff = lds_byte(wr * 64 + fr, fq * 8), boff = lds_byte(wc * 32 + fr, fq * 8);
#define PG8_SA(b, h) (((b) * 2 + (h)) * HTB)
#define PG8_SB(b, h) ((4 + (b) * 2 + (h)) * HTB)
#define PG8_STAGE(bufoff, gbase, voff) do { _Pragma("unroll") for (int _i = 0; _i < 2; ++_i) \
        __builtin_amdgcn_global_load_lds((const unsigned*)((const char*)(gbase) + (voff)[_i]), (LAS unsigned*)(lds + (bufoff) + ldsw + _i * 8192), 16, 0, 0); } while (0)
#define PG8_LDA(dst, b, h) do { _Pragma("unroll") for (int m = 0; m < 4; ++m) _Pragma("unroll") for (int k = 0; k < 2; ++k) dst[m][k] = *(const LAS bf16x8*)(lds + PG8_SA(b, h) + aoff + m * 2048 + k * 1024); } while (0)
#define PG8_LDB(dst, b, h) do { _Pragma("unroll") for (int n = 0; n < 2; ++n) _Pragma("unroll") for (int k = 0; k < 2; ++k) dst[n][k] = *(const LAS bf16x8*)(lds + PG8_SB(b, h) + boff + n * 2048 + k * 1024); } while (0)
#define PG8_MMA(ai, bj, At, Bt) do { __builtin_amdgcn_s_setprio(1); _Pragma("unroll") for (int m = 0; m < 4; ++m) _Pragma("unroll") for (int n = 0; n < 2; ++n) _Pragma("unroll") for (int k = 0; k < 2; ++k) \
        acc[ai][bj][m][n] = __builtin_amdgcn_mfma_f32_16x16x32_bf16(Bt[n][k], At[m][k], acc[ai][bj][m][n], 0, 0, 0); __builtin_amdgcn_s_setprio(0); } while (0)
#define PG8_WAIT_V(n) asm volatile("s_waitcnt vmcnt(" #n ")" ::: "memory")
#define PG8_WAIT_L(n) asm volatile("s_waitcnt lgkmcnt(" #n ")" ::: "memory")
#define PG8_BAR __builtin_amdgcn_s_barrier()
#define PG8_SCHED __builtin_amdgcn_sched_barrier(0)
    Unit cur, nxt; int ui = 0;
    if (!S.next(0, cur)) return;
    f32x4 acc[2][2][4][2];
#pragma unroll
    for (int a = 0; a < 2; ++a)
#pragma unroll
        for (int b = 0; b < 2; ++b)
#pragma unroll
            for (int m = 0; m < 4; ++m)
#pragma unroll
                for (int n = 0; n < 2; ++n) acc[a][b][m][n] = (f32x4){0.f, 0.f, 0.f, 0.f};
    bf16x8 At[4][2], B0[2][2], B1[2][2];
    const char* cA = cur.a; const char* cB = cur.b;
    PG8_STAGE(PG8_SB(0, 0), cB, voffB); PG8_STAGE(PG8_SB(0, 1), cB + hstepB, voffB); PG8_STAGE(PG8_SA(0, 0), cA, voffA); PG8_STAGE(PG8_SA(0, 1), cA + hstepA, voffA);
    if (wr == 1) PG8_BAR;
    PG8_WAIT_V(2); PG8_BAR;
    PG8_STAGE(PG8_SB(1, 0), cB + kstep, voffB); PG8_STAGE(PG8_SA(1, 0), cA + kstep, voffA); PG8_STAGE(PG8_SB(1, 1), cB + hstepB + kstep, voffB);
    PG8_WAIT_V(6); PG8_BAR;
    for (;;) {
        const bool has_next = S.next(ui + 1, nxt);
        const char* nA = has_next ? nxt.a : cA; const char* nB = has_next ? nxt.b : cB;
        const int nt = cur.nt;
        for (int t = 0; t < nt; t += 2) {
            const bool last = (t == nt - 2);
            const char* a1 = cA + (size_t)(t + 1) * kstep;
            const char* a2 = last ? nA : cA + (size_t)(t + 2) * kstep; const char* b2 = last ? nB : cB + (size_t)(t + 2) * kstep;
            const char* a3 = a2 + kstep; const char* b3 = b2 + kstep;
            PG8_LDB(B0, 0, 0); PG8_LDB(B1, 0, 1); PG8_SCHED; PG8_LDA(At, 0, 0); PG8_STAGE(PG8_SA(1, 1), a1 + hstepA, voffA);
            PG8_WAIT_V(8); PG8_WAIT_L(0); PG8_BAR; PG8_MMA(0, 0, At, B0); PG8_MMA(0, 1, At, B1); PG8_BAR; PG8_SCHED;
            PG8_LDA(At, 0, 1); PG8_STAGE(PG8_SB(0, 0), b2, voffB); PG8_STAGE(PG8_SB(0, 1), b2 + hstepB, voffB); PG8_STAGE(PG8_SA(0, 0), a2, voffA);
            PG8_WAIT_V(8); PG8_WAIT_L(0); PG8_BAR; PG8_MMA(1, 0, At, B0); PG8_MMA(1, 1, At, B1); PG8_BAR; PG8_SCHED;
            PG8_LDB(B0, 1, 0); PG8_LDB(B1, 1, 1); PG8_SCHED; PG8_LDA(At, 1, 0); PG8_STAGE(PG8_SA(0, 1), a2 + hstepA, voffA);
            PG8_WAIT_V(8); PG8_WAIT_L(0); PG8_BAR; PG8_MMA(0, 0, At, B0); PG8_MMA(0, 1, At, B1); PG8_BAR; PG8_SCHED;
            PG8_LDA(At, 1, 1); PG8_STAGE(PG8_SB(1, 0), b3, voffB); PG8_STAGE(PG8_SB(1, 1), b3 + hstepB, voffB); PG8_STAGE(PG8_SA(1, 0), a3, voffA);
            PG8_WAIT_V(8); PG8_WAIT_L(0); PG8_BAR; PG8_MMA(1, 0, At, B0); PG8_MMA(1, 1, At, B1); PG8_BAR; PG8_SCHED;
        }
        if (wr == 0) PG8_BAR;
        E(acc, cur, wr, wc, fr, fq);
        if (!has_next) break;
#pragma unroll
        for (int a = 0; a < 2; ++a)
#pragma unroll
            for (int b = 0; b < 2; ++b)
#pragma unroll
                for (int m = 0; m < 4; ++m)
#pragma unroll
                    for (int n = 0; n < 2; ++n) acc[a][b][m][n] = (f32x4){0.f, 0.f, 0.f, 0.f};
        cur = nxt; cA = nA; cB = nB; ++ui;
        if (wr == 1) PG8_BAR;
    }
    PG8_WAIT_V(0);
    PG8_BAR;
#undef PG8_SA
#undef PG8_SB
#undef PG8_STAGE
#undef PG8_LDA
#undef PG8_LDB
#undef PG8_MMA
#undef PG8_WAIT_V
#undef PG8_WAIT_L
#undef PG8_BAR
#undef PG8_SCHED
}

typedef f32x4 Acc[2][2][4][2];

struct EpiSwiGLU {
    static constexpr bool PERM = true;
    bf16_t* O;
    __device__ __forceinline__ void operator()(const Acc& acc, const Unit& u, int wr, int wc, int fr, int fq) const {
        const int row0 = u.pm * BM + wr * 64 + fr, col0 = u.pn * 128 + wc * 32 + 8 * fq;
#pragma unroll
        for (int ai = 0; ai < 2; ++ai)
#pragma unroll
            for (int m = 0; m < 4; ++m) {
                bf16_t* p = O + (size_t)(row0 + ai * HALF + m * 16) * FF + col0;
                float h[8];
#pragma unroll
                for (int n = 0; n < 2; ++n)
#pragma unroll
                    for (int j = 0; j < 4; ++j) { const float g = acc[ai][0][m][n][j], up = acc[ai][1][m][n][j]; h[n * 4 + j] = g * sigmoidf_(g) * up; }
                u32x4 w; w.x = pk2(h[0], h[1]); w.y = pk2(h[2], h[3]); w.z = pk2(h[4], h[5]); w.w = pk2(h[6], h[7]);
                *(u32x4*)p = w;
            }
    }
};
template <bool LNRES> struct EpiResid {
    static constexpr bool PERM = false;
    const float* res; float* out; float s; const float* st; const float* g; const float* b;
    __device__ __forceinline__ void operator()(const Acc& acc, const Unit& u, int wr, int wc, int fr, int fq) const {
        const int col0 = u.pn * BM + wc * 32 + 4 * fq;
#pragma unroll
        for (int ai = 0; ai < 2; ++ai)
#pragma unroll
            for (int bj = 0; bj < 2; ++bj) {
                f32x4 rv[4][2], gv[2], bv[2]; f32x2_t sv[4];
                const int c = col0 + bj * HALF;
                if (LNRES) {
#pragma unroll
                    for (int n = 0; n < 2; ++n) { gv[n] = *(const f32x4*)(g + c + n * 16); bv[n] = *(const f32x4*)(b + c + n * 16); }
                }
#pragma unroll
                for (int m = 0; m < 4; ++m) { const int row = u.pm * BM + ai * HALF + wr * 64 + m * 16 + fr; const size_t off = (size_t)row * DM + c;
                    if (LNRES) sv[m] = *(const f32x2_t*)(st + 2 * (size_t)row);
#pragma unroll
                    for (int n = 0; n < 2; ++n) rv[m][n] = *(const f32x4*)(res + off + n * 16); }
                asm volatile("" ::: "memory");
#pragma unroll
                for (int m = 0; m < 4; ++m) { const size_t off = (size_t)(u.pm * BM + ai * HALF + wr * 64 + m * 16 + fr) * DM + c;
#pragma unroll
                    for (int n = 0; n < 2; ++n) { f32x4 r = rv[m][n]; if (LNRES) r = (r - sv[m].x) * sv[m].y * gv[n] + bv[n];
                        *(f32x4*)(out + off + n * 16) = r * ALPHA + acc[ai][bj][m][n] * s; } }
                asm volatile("" ::: "memory");
            }
    }
};
struct EpiInProj {
    static constexpr bool PERM = true;
    bf16_t* Z; float* ZG;
    __device__ __forceinline__ void operator()(const Acc& acc, const Unit& u, int wr, int wc, int fr, int fq) const {
        const int row0 = u.pm * BM + wr * 64 + fr;
        if (u.pn < 19) {
            const float sc = (u.pn == 2 || u.pn == 3 || u.pn == 13 || u.pn == 14) ? C2 : 1.f;
            const int col0 = u.pn * BM + wc * 32 + 8 * fq;
#pragma unroll
            for (int ai = 0; ai < 2; ++ai)
#pragma unroll
                for (int m = 0; m < 4; ++m) { bf16_t* p = Z + (size_t)(row0 + ai * HALF + m * 16) * ZLD + col0;
#pragma unroll
                    for (int bj = 0; bj < 2; ++bj) { const f32x4 v0 = acc[ai][bj][m][0] * sc, v1 = acc[ai][bj][m][1] * sc;
                        u32x4 w; w.x = pk2(v0[0], v0[1]); w.y = pk2(v0[2], v0[3]); w.z = pk2(v1[0], v1[1]); w.w = pk2(v1[2], v1[3]);
                        *(u32x4*)(p + bj * HALF) = w; } }
        } else if (wc == 0 && fq < 2) {
#pragma unroll
            for (int ai = 0; ai < 2; ++ai)
#pragma unroll
                for (int m = 0; m < 4; ++m) { float* p = ZG + (size_t)(row0 + ai * HALF + m * 16) * 16 + 8 * fq;
                    *(f32x4*)p = acc[ai][0][m][0]; *(f32x4*)(p + 4) = acc[ai][0][m][1]; }
        }
    }
};
struct EpiPool {
    static constexpr bool PERM = true;
    bf16_t* Y; const float* scale;
    __device__ __forceinline__ void operator()(const Acc& acc, const Unit& u, int wr, int wc, int fr, int fq) const {
        const int row0 = u.pm * BM + wr * 64 + fr, col0 = u.pn * BM + wc * 32 + 8 * fq;
#pragma unroll
        for (int bj = 0; bj < 2; ++bj) {
            const f32x4 s0 = *(const f32x4*)(scale + col0 + bj * HALF), s1 = *(const f32x4*)(scale + col0 + bj * HALF + 4);
#pragma unroll
            for (int ai = 0; ai < 2; ++ai)
#pragma unroll
                for (int m = 0; m < 4; ++m) { bf16_t* p = Y + (size_t)(row0 + ai * HALF + m * 16) * DM + col0 + bj * HALF;
                    const f32x4 v0 = acc[ai][bj][m][0] * s0, v1 = acc[ai][bj][m][1] * s1;
                    u32x4 w; w.x = pk2(v0[0], v0[1]); w.y = pk2(v0[2], v0[3]); w.z = pk2(v1[0], v1[1]); w.w = pk2(v1[2], v1[3]);
                    *(u32x4*)p = w; }
        }
    }
};
struct EpiMerge {
    static constexpr bool PERM = true;
    u32x2* gsc; u32x4* msc; bf16_t* MG;
    __device__ __forceinline__ void operator()(const Acc& acc, const Unit& u, int wr, int wc, int fr, int fq) const {
        const int tid = (wr * 4 + wc) * 64 + fq * 16 + fr;
        u32x2* g = gsc + ((size_t)blockIdx.x * NTHR + tid) * 16;
        u32x4* ms = msc + ((size_t)blockIdx.x * NTHR + tid) * 16;
        const int b = u.kind >> 1;
        if ((u.kind & 1) == 0) {
#pragma unroll
            for (int ai = 0; ai < 2; ++ai)
#pragma unroll
                for (int bj = 0; bj < 2; ++bj)
#pragma unroll
                    for (int m = 0; m < 4; ++m) { const f32x4 a0 = acc[ai][bj][m][0], a1 = acc[ai][bj][m][1];
                        u32x2 w;
                        w.x = (unsigned)(sigmoidf_(a0[0]) * 255.f + 0.5f) | ((unsigned)(sigmoidf_(a0[1]) * 255.f + 0.5f) << 8) | ((unsigned)(sigmoidf_(a0[2]) * 255.f + 0.5f) << 16) | ((unsigned)(sigmoidf_(a0[3]) * 255.f + 0.5f) << 24);
                        w.y = (unsigned)(sigmoidf_(a1[0]) * 255.f + 0.5f) | ((unsigned)(sigmoidf_(a1[1]) * 255.f + 0.5f) << 8) | ((unsigned)(sigmoidf_(a1[2]) * 255.f + 0.5f) << 16) | ((unsigned)(sigmoidf_(a1[3]) * 255.f + 0.5f) << 24);
                        g[(ai * 2 + bj) * 4 + m] = w; }
            asm volatile("" ::: "memory");
        } else {
            const int row0 = u.pm * BM + wr * 64 + fr, col0 = u.pn * BM + wc * 32 + 8 * fq;
            const float k255 = 1.f / 255.f;
#pragma unroll
            for (int ai = 0; ai < 2; ++ai) {
                u32x2 gw[8]; u32x4 pv[8];
#pragma unroll
                for (int sl = 0; sl < 8; ++sl) gw[sl] = g[ai * 8 + sl];
                if (b > 0) {
#pragma unroll
                    for (int sl = 0; sl < 8; ++sl) pv[sl] = ms[ai * 8 + sl];
                }
#pragma unroll
                for (int bj = 0; bj < 2; ++bj)
#pragma unroll
                    for (int m = 0; m < 4; ++m) { const int hs = bj * 4 + m, slot = ai * 8 + hs; const u32x2 w = gw[hs];
                        f32x4 p0 = acc[ai][bj][m][0], p1 = acc[ai][bj][m][1];
                        p0[0] *= (float)(w.x & 255u) * k255; p0[1] *= (float)((w.x >> 8) & 255u) * k255; p0[2] *= (float)((w.x >> 16) & 255u) * k255; p0[3] *= (float)(w.x >> 24) * k255;
                        p1[0] *= (float)(w.y & 255u) * k255; p1[1] *= (float)((w.y >> 8) & 255u) * k255; p1[2] *= (float)((w.y >> 16) & 255u) * k255; p1[3] *= (float)(w.y >> 24) * k255;
                        if (b > 0) { const u32x4 q = pv[hs];
                            p0[0] += bflo(q.x); p0[1] += bfhi(q.x); p0[2] += bflo(q.y); p0[3] += bfhi(q.y); p1[0] += bflo(q.z); p1[1] += bfhi(q.z); p1[2] += bflo(q.w); p1[3] += bfhi(q.w); }
                        u32x4 o; o.x = pk2(p0[0], p0[1]); o.y = pk2(p0[2], p0[3]); o.z = pk2(p1[0], p1[1]); o.w = pk2(p1[2], p1[3]);
                        if (b < 3) ms[slot] = o;
                        else *(u32x4*)(MG + (size_t)(row0 + ai * HALF + m * 16) * DM + col0 + bj * HALF) = o; }
                asm volatile("" ::: "memory");
            }
        }
    }
};
}

struct Params {
    const float* x; const float* ln_g; const float* ln_b; const float* ffn1_w_in; const float* ffn1_w_out; const float* w_in; const float* pool_w; const float* pool_scale;
    const float* swa_sinks; const float* mlstm_conv; const float* mlstm_i_bias; const float* mlstm_f_bias; const float* fox_f_bias; const float* w_branch; const float* w_gate;
    const float* w_out; const float* ffn2_w_in; const float* ffn2_w_out; float* out; unsigned char* ws;
};

__device__ __forceinline__ int maprow(int kind, int n) {
    if (kind == 1) { const int type = n >= FF ? 1 : 0; const int j = n - type * FF; return (j >> 7) * 256 + type * 128 + (j & 127); }
    if (kind == 2) { if (n < 3328) return n; if (n < 3336) return 4864 + (n - 3328); if (n < 4872) return n - 8; return n; }
    return n;
}
__device__ __forceinline__ void tr_item(const float* W, int ldw, int ncols, int nblk, int item, bf16_t* dst, int dpitch, int dcol0, int mapkind, LAS float* scr, int lane) {
    const int kb = item / nblk, nb = item % nblk, k0 = 64 * kb, n0 = 32 * nb;
    const int nsrc = n0 + (lane & 31);
    float wv[32];
#pragma unroll
    for (int i = 0; i < 32; ++i) { const int kk = 2 * i + (lane >> 5); wv[i] = (nsrc < ncols) ? W[(size_t)(k0 + kk) * ldw + nsrc] : 0.f; }
#pragma unroll
    for (int i = 0; i < 32; ++i) { const int kk = 2 * i + (lane >> 5); scr[kk * 33 + (lane & 31)] = wv[i]; }
    asm volatile("s_waitcnt lgkmcnt(0)" ::: "memory");
    const int c = lane & 7;
#pragma unroll
    for (int j = 0; j < 4; ++j) { const int nn = (lane >> 3) + 8 * j; const int n = n0 + nn; const LAS float* s = scr + (8 * c) * 33 + nn;
        u32x4 o; o.x = pk2(s[0 * 33], s[1 * 33]); o.y = pk2(s[2 * 33], s[3 * 33]); o.z = pk2(s[4 * 33], s[5 * 33]); o.w = pk2(s[6 * 33], s[7 * 33]);
        if (n < ncols) *(u32x4*)(dst + (size_t)maprow(mapkind, n) * dpitch + dcol0 + k0 + 8 * c) = o; }
    asm volatile("s_waitcnt lgkmcnt(0)" ::: "memory");
}

__device__ __forceinline__ void phase_weights(const Params& p, int l, LAS unsigned char* lds, int wave_, int lane_, int G) {
    const int lane = lane_id(), wave = launder_s(wave_); (void)lane_;
    unsigned char* ws = launder_p(p.ws);
    LAS float* scr = (LAS float*)(lds + wave * 8448);
    const int gw = blockIdx.x * NWAVES + wave, NGW = G * NWAVES;
    const float* f1a = p.ffn1_w_in + (size_t)l * DM * 2 * FF; const float* f1b = p.ffn1_w_out + (size_t)l * FF * DM;
    const float* f2a = p.ffn2_w_in + (size_t)l * DM * 2 * FF; const float* f2b = p.ffn2_w_out + (size_t)l * FF * DM;
    const float* win = p.w_in + (size_t)l * DM * 4880; const float* wg = p.w_gate + (size_t)l * 4 * DM * DM; const float* wb = p.w_branch + (size_t)l * 4 * 512 * DM;
    const float* wo = p.w_out + (size_t)l * DM * DM; const float* pw = p.pool_w + (size_t)l * 4 * 128 * 128;
    constexpr int I_FA = 32 * 352, I_FB = 88 * 64, I_IN = 32 * 153, I_G = 4 * 32 * 64, I_B = 4 * 8 * 64, I_O = 32 * 64, I_P = 4 * 2 * 4;
    constexpr int NITEMS = 2 * I_FA + 2 * I_FB + I_IN + I_G + I_B + I_O + I_P;
    for (int it = gw; it < NITEMS; it += NGW) {
        int r = it;
        if (r < I_FA) { tr_item(f1a, 2 * FF, 2 * FF, 352, r, (bf16_t*)(ws + OW_F1A), DM, 0, 1, scr, lane); continue; } r -= I_FA;
        if (r < I_FA) { tr_item(f2a, 2 * FF, 2 * FF, 352, r, (bf16_t*)(ws + OW_F2A), DM, 0, 1, scr, lane); continue; } r -= I_FA;
        if (r < I_FB) { tr_item(f1b, DM, DM, 64, r, (bf16_t*)(ws + OW_F1B), FF, 0, 0, scr, lane); continue; } r -= I_FB;
        if (r < I_FB) { tr_item(f2b, DM, DM, 64, r, (bf16_t*)(ws + OW_F2B), FF, 0, 0, scr, lane); continue; } r -= I_FB;
        if (r < I_IN) { tr_item(win, 4880, 4880, 153, r, (bf16_t*)(ws + OW_IN), DM, 0, 2, scr, lane); continue; } r -= I_IN;
        if (r < I_G) { const int b = r / 2048, rr = r % 2048; tr_item(wg + (size_t)b * DM * DM, DM, DM, 64, rr, (bf16_t*)(ws + OW_G) + (size_t)b * DM * DM, DM, 0, 0, scr, lane); continue; } r -= I_G;
        if (r < I_B) { const int b = r / 512, rr = r % 512; tr_item(wb + (size_t)b * 512 * DM, DM, DM, 64, rr, (bf16_t*)(ws + OW_BC), DM, b * 512, 0, scr, lane); continue; } r -= I_B;
        if (r < I_O) { tr_item(wo, DM, DM, 64, r, (bf16_t*)(ws + OW_O), DM, 0, 0, scr, lane); continue; } r -= I_O;
        { const int g = r / 8, rr = r % 8; tr_item(pw + (size_t)g * 128 * 128, 128, 128, 4, rr, (bf16_t*)(ws + OW_BD) + (size_t)g * 128 * 512, 512, g * 128, 0, scr, lane); }
    }
    const int gt = blockIdx.x * NTHR + wave * 64 + lane, NGT = G * NTHR;
    const unsigned z0 = (unsigned)launder_v(0); const u32x4 zz = {z0, z0, z0, z0};
    { u32x4* zr = (u32x4*)((bf16_t*)(ws + OW_IN) + (size_t)4880 * DM); for (int i = gt; i < 240 * DM / 8; i += NGT) zr[i] = zz; }
    { u32x4* bd = (u32x4*)(ws + OW_BD); for (int i = gt; i < 512 * 512 / 8; i += NGT) { const int n = i / 64, k = (i % 64) * 8; if ((n >> 7) != (k >> 7)) bd[i] = zz; } }
    if (l == 0) {
        const f32x4* xs = (const f32x4*)p.x; u32x2* hb = (u32x2*)(ws + O_HB);
        for (int i = gt; i < S * DM / 4; i += NGT) { const f32x4 v = xs[i]; u32x2 w; w.x = pk2(v[0], v[1]); w.y = pk2(v[2], v[3]); hb[i] = w; }
    }
}

__device__ __forceinline__ float wave_sum(float v) {
#pragma unroll
    for (int o = 1; o < 64; o <<= 1) v += __shfl_xor(v, o);
    return v;
}
__device__ __forceinline__ void phase_ln(const float* Yin, float* Hout, bf16_t* hb, float* stats, const float* g, const float* b, int wave_, int lane_, int G) {
    const int lane = lane_id(), wave = launder_s(wave_); (void)lane_;
    const int gw = blockIdx.x * NWAVES + wave, NGW = G * NWAVES;
    for (int row = gw; row < S; row += 2 * NGW) {
        const int rowb = row + NGW;
        const f32x4* xa = (const f32x4*)(Yin + (size_t)row * DM) + lane; const f32x4* xb = (const f32x4*)(Yin + (size_t)rowb * DM) + lane;
        f32x4 va[8], vb[8]; float sa = 0.f, sb = 0.f;
#pragma unroll
        for (int j = 0; j < 8; ++j) { va[j] = xa[64 * j]; vb[j] = xb[64 * j]; }
#pragma unroll
        for (int j = 0; j < 8; ++j) { sa += (va[j][0] + va[j][1]) + (va[j][2] + va[j][3]); sb += (vb[j][0] + vb[j][1]) + (vb[j][2] + vb[j][3]); }
        const float ma = wave_sum(sa) * (1.f / DM), mb = wave_sum(sb) * (1.f / DM); float qa = 0.f, qb = 0.f;
#pragma unroll
        for (int j = 0; j < 8; ++j) { va[j] = va[j] - ma; vb[j] = vb[j] - mb;
            qa += (va[j][0] * va[j][0] + va[j][1] * va[j][1]) + (va[j][2] * va[j][2] + va[j][3] * va[j][3]);
            qb += (vb[j][0] * vb[j][0] + vb[j][1] * vb[j][1]) + (vb[j][2] * vb[j][2] + vb[j][3] * vb[j][3]); }
        const float ra = 1.f / sqrtf(wave_sum(qa) * (1.f / DM) + LN_EPS), rb = 1.f / sqrtf(wave_sum(qb) * (1.f / DM) + LN_EPS);
        if (stats && lane == 0) { stats[2 * (size_t)row] = ma; stats[2 * (size_t)row + 1] = ra; stats[2 * (size_t)rowb] = mb; stats[2 * (size_t)rowb + 1] = rb; }
        f32x4* ha = (f32x4*)(Hout + (size_t)row * DM) + lane; f32x4* hbp = (f32x4*)(Hout + (size_t)rowb * DM) + lane;
        u32x2* ba = (u32x2*)(hb + (size_t)row * DM) + lane; u32x2* bb = (u32x2*)(hb + (size_t)rowb * DM) + lane;
#pragma unroll
        for (int j = 0; j < 8; ++j) { const f32x4 gg = ((const f32x4*)g)[64 * j + lane], bbv = ((const f32x4*)b)[64 * j + lane];
            const f32x4 oa = va[j] * ra * gg + bbv, ob = vb[j] * rb * gg + bbv;
            if (Hout) { ha[64 * j] = oa; hbp[64 * j] = ob; }
            if (hb) { u32x2 w; w.x = pk2(oa[0], oa[1]); w.y = pk2(oa[2], oa[3]); ba[64 * j] = w; w.x = pk2(ob[0], ob[1]); w.y = pk2(ob[2], ob[3]); bb[64 * j] = w; } }
    }
}

__device__ __forceinline__ float scan_sum(float x, int lane) {
#pragma unroll
    for (int o = 1; o < 64; o <<= 1) { const float y = __shfl_up(x, o); if (lane >= o) x += y; }
    return x;
}
__device__ __forceinline__ float scan_max(float x, int lane) {
#pragma unroll
    for (int o = 1; o < 64; o <<= 1) { const float y = __shfl_up(x, o); if (lane >= o) x = fmaxf(x, y); }
    return x;
}
__device__ __forceinline__ void phase_post(const Params& p, int l, LAS unsigned char* lds, int wave_, int lane_, int G) {
    const int lane = lane_id(), wave = launder_s(wave_); (void)lane_;
    unsigned char* ws = launder_p(p.ws);
    bf16_t* Z = (bf16_t*)(ws + O_R1); const float* ZG = (const float*)(ws + O_ZG);
    LAS float* eL = (LAS float*)(lds + LDS_MISC);
    const int tid = wave * 64 + lane;
    LAS float* invL = (LAS float*)(lds + LDS_MISC + 1024);
    if (tid < 32) invL[tid] = exp2f(-(float)tid * 0.41524101186092029f);
    for (int c = blockIdx.x; c < S / 64; c += G) {
        const int t0 = c * 64;
        {
            const int t = t0 + lane;
            if (wave < 4) {
                const int h = wave;
                const float ip = ZG[(size_t)t * 16 + h] + p.mlstm_i_bias[l * 4 + h];
                const float lf = logsigmoidf_(ZG[(size_t)t * 16 + 4 + h] + p.mlstm_f_bias[l * 4 + h]);
                const float b = scan_sum(lf, lane);
                const float d = ip - b;
                const float a = scan_max(d, lane);
                const float dmax = __shfl(a, 63), bl = __shfl(b, 63);
                ((float*)(ws + O_MLA))[h * S + t] = a; ((float*)(ws + O_MLB))[h * S + t] = b; ((float*)(ws + O_MLD))[h * S + t] = d;
                eL[h * 64 + lane] = __expf(d - dmax);
                if (lane == 63) { ((float*)(ws + O_BLC))[c * 4 + h] = bl; ((float*)(ws + O_DMC))[c * 4 + h] = dmax; }
            }
            {
                const int h = wave;
                const float lf = logsigmoidf_(ZG[(size_t)t * 16 + 8 + h] + p.fox_f_bias[l * 8 + h]);
                const float cl = scan_sum(lf, lane) * LOG2E;
                ((float*)(ws + O_CL2))[h * S + t] = cl;
                if (lane == 63) ((float*)(ws + O_TOT2))[c * 8 + h] = cl;
            }
        }
        __syncthreads();
        for (int idx = tid; idx < 64 * 40; idx += NTHR) {
            const int tl = idx / 40, rem = idx % 40, hh = rem >> 2, i0 = (rem & 3) * 8, t = t0 + tl;
            bf16_t* px = Z + (size_t)t * ZLD + (hh < 8 ? ZC_QSWA + hh * 64 : ZC_KSWA + (hh - 8) * 64) + i0;
            const u32x4 a = *(const u32x4*)px, b = *(const u32x4*)(px + 32);
            float x1[8] = {bflo(a.x), bfhi(a.x), bflo(a.y), bfhi(a.y), bflo(a.z), bfhi(a.z), bflo(a.w), bfhi(a.w)};
            float x2[8] = {bflo(b.x), bfhi(b.x), bflo(b.y), bfhi(b.y), bflo(b.z), bfhi(b.z), bflo(b.w), bfhi(b.w)};
            float y1[8], y2[8];
#pragma unroll
            for (int j = 0; j < 8; ++j) {
                const float ang = (float)t * invL[i0 + j];
                double rev = (double)ang * 0.15915494309189535; rev -= rint(rev);
                const float rr = (float)(rev * 6.283185307179586);
                const float cs = __cosf(rr), sn = __sinf(rr);
                y1[j] = x1[j] * cs - x2[j] * sn; y2[j] = x2[j] * cs + x1[j] * sn;
            }
            u32x4 o1, o2;
            o1.x = pk2(y1[0], y1[1]); o1.y = pk2(y1[2], y1[3]); o1.z = pk2(y1[4], y1[5]); o1.w = pk2(y1[6], y1[7]);
            o2.x = pk2(y2[0], y2[1]); o2.y = pk2(y2[2], y2[3]); o2.z = pk2(y2[4], y2[5]); o2.w = pk2(y2[6], y2[7]);
            *(u32x4*)px = o1; *(u32x4*)(px + 32) = o2;
        }
        for (int idx = tid; idx < 128 + 512 + 512; idx += NTHR) {
            int col, h = 0; bf16_t* dst; bf16_t* dst2 = nullptr;
            if (idx < 128) { col = ZC_VSWA + idx; dst = (bf16_t*)(ws + O_VTS) + (size_t)idx * S; }
            else if (idx < 640) { const int cc = idx - 128; col = ZC_VFOX + cc; dst = (bf16_t*)(ws + O_VTF) + (size_t)cc * S; }
            else { const int cc = idx - 640; col = ZC_VML + cc; dst = (bf16_t*)(ws + O_VTM) + (size_t)cc * S; dst2 = (bf16_t*)(ws + O_VTW) + (size_t)cc * S; h = cc >> 7; }
            const bf16_t* __restrict__ src = launder_pv(Z + (size_t)t0 * ZLD + col);
            unsigned short v[64];
#pragma unroll
            for (int j = 0; j < 64; ++j) { v[j] = *src; src += ZLD; }
#pragma unroll
            for (int g8 = 0; g8 < 8; ++g8) { u32x4 w;
                w.x = (unsigned)v[8 * g8] | ((unsigned)v[8 * g8 + 1] << 16); w.y = (unsigned)v[8 * g8 + 2] | ((unsigned)v[8 * g8 + 3] << 16);
                w.z = (unsigned)v[8 * g8 + 4] | ((unsigned)v[8 * g8 + 5] << 16); w.w = (unsigned)v[8 * g8 + 6] | ((unsigned)v[8 * g8 + 7] << 16);
                *(u32x4*)(dst + t0 + 8 * g8) = w; }
            if (dst2) {
                const LAS float* e = eL + h * 64;
#pragma unroll
                for (int g8 = 0; g8 < 8; ++g8) { u32x4 w;
                    w.x = pk2(bf2f(v[8 * g8]) * e[8 * g8], bf2f(v[8 * g8 + 1]) * e[8 * g8 + 1]); w.y = pk2(bf2f(v[8 * g8 + 2]) * e[8 * g8 + 2], bf2f(v[8 * g8 + 3]) * e[8 * g8 + 3]);
                    w.z = pk2(bf2f(v[8 * g8 + 4]) * e[8 * g8 + 4], bf2f(v[8 * g8 + 5]) * e[8 * g8 + 5]); w.w = pk2(bf2f(v[8 * g8 + 6]) * e[8 * g8 + 6], bf2f(v[8 * g8 + 7]) * e[8 * g8 + 7]);
                    *(u32x4*)(dst2 + t0 + 8 * g8) = w; }
            }
        }
        for (int cc = tid; cc < 1024; cc += NTHR) {
            const float* cw = p.mlstm_conv + (size_t)l * 4 * 1024 + cc;
            const float w0 = cw[0], w1 = cw[1024], w2 = cw[2048], w3 = cw[3072];
            const bf16_t* __restrict__ src = launder_pv(Z + (size_t)(t0 >= 3 ? t0 - 3 : 0) * ZLD + ZC_QML + cc);
            unsigned short xv[67];
#pragma unroll
            for (int j = 0; j < 67; ++j) { const int tt = t0 - 3 + j; if (tt >= 0) { xv[j] = *src; src += ZLD; } else xv[j] = (unsigned short)0; }
            const float qs = cc < 512 ? 0.08838834764831845f : 1.f;
            bf16_t* dq = (bf16_t*)(ws + O_QKC) + (size_t)t0 * 1024 + cc;
            const int kc = cc - 512, h = (kc >= 0) ? (kc >> 7) : 0; const LAS float* e = eL + h * 64; float su = 0.f;
#pragma unroll
            for (int g8 = 0; g8 < 8; ++g8) {
                unsigned short ob[8];
#pragma unroll
                for (int j = 0; j < 8; ++j) { const int t = 8 * g8 + j;
                    const float y = w0 * bf2f(xv[t]) + w1 * bf2f(xv[t + 1]) + w2 * bf2f(xv[t + 2]) + w3 * bf2f(xv[t + 3]);
                    ob[j] = f2bf(y * sigmoidf_(y) * qs); dq[(size_t)t * 1024] = ob[j]; }
                if (cc >= 512) {
                    u32x4 w; w.x = (unsigned)ob[0] | ((unsigned)ob[1] << 16); w.y = (unsigned)ob[2] | ((unsigned)ob[3] << 16); w.z = (unsigned)ob[4] | ((unsigned)ob[5] << 16); w.w = (unsigned)ob[6] | ((unsigned)ob[7] << 16);
                    *(u32x4*)((bf16_t*)(ws + O_KTM) + (size_t)kc * S + t0 + 8 * g8) = w;
#pragma unroll
                    for (int j = 0; j < 8; ++j) su += e[8 * g8 + j] * bf2f(ob[j]);
                }
            }
            if (cc >= 512) ((float*)(ws + O_UN))[(size_t)c * 512 + kc] = su;
        }
        for (int cc = tid; cc < 512; cc += NTHR) {
            const int g = cc >> 7, win = 2 << g;
            const bf16_t* __restrict__ src = launder_pv(Z + (size_t)(t0 >= 15 ? t0 - 15 : 0) * ZLD + cc);
            unsigned short xv[79];
#pragma unroll
            for (int j = 0; j < 79; ++j) { const int tt = t0 - 15 + j; if (tt >= 0) { xv[j] = (j >= 16 - win) ? *src : (unsigned short)0; src += ZLD; } else xv[j] = (unsigned short)0; }
            float sacc = 0.f;
#pragma unroll
            for (int j = 0; j < 15; ++j) sacc += bf2f(xv[j]);
            bf16_t* dp = (bf16_t*)(ws + O_POOL) + (size_t)t0 * 512 + cc;
#pragma unroll
            for (int j = 0; j < 64; ++j) { const int t = t0 + j; const float x0 = bf2f(xv[15 + j]); sacc += x0;
                const int cnt = (t + 1) < win ? (t + 1) : win; dp[(size_t)j * 512] = f2bf(sacc / (float)cnt - x0);
                const float lv = (g == 0) ? bf2f(xv[15 + j - 1]) : (g == 1) ? bf2f(xv[15 + j - 3]) : (g == 2) ? bf2f(xv[15 + j - 7]) : bf2f(xv[15 + j - 15]);
                sacc -= lv; }
        }
        __syncthreads();
    }
}

#define MFMA32(a, b, c) __builtin_amdgcn_mfma_f32_32x32x16_bf16((a), (b), (c), 0, 0, 0)
template <bool FOX>
__device__ __forceinline__ void attn_unit(int h, int qb, const bf16_t* Z, const bf16_t* Vt, const float* cl2, const LAS float* P2L, float sink2, bf16_t* ybr, int lane) {
    const int q = lane & 31, hi = lane >> 5, t0 = qb * 32, t = t0 + q;
    const int qcol = FOX ? (ZC_QFOX + h * 64) : (ZC_QSWA + h * 64);
    const int kcol = FOX ? (ZC_KFOX + h * 64) : (ZC_KSWA + (h >> 2) * 64);
    const int ocol = FOX ? (1536 + h * 64) : (512 + h * 64);
    const bf16_t* Vth = Vt + (size_t)((FOX ? h : (h >> 2)) * 64 + q) * S + 16 * hi;
    const int pim = 16 * ((q >> 2) & 1) + 4 * (q >> 3) + (q & 3);
    const bf16_t* Kp = Z + (size_t)pim * ZLD + kcol + 8 * hi;
    const float* clh = cl2 + (size_t)h * S + 16 * hi;
    bf16x8 qf[4];
#pragma unroll
    for (int d0 = 0; d0 < 4; ++d0) qf[d0] = *(const bf16x8*)(Z + (size_t)t * ZLD + qcol + 16 * d0 + 8 * hi);
    const int kv_lo = FOX ? 0 : (t0 >= 128 ? t0 - 128 : 0);
    const int ntiles = (t0 - kv_lo) / 32 + 1;
    float mhat = FOX ? 0.f : sink2, l = FOX ? 0.f : (hi == 0 ? 1.f : 0.f);
    float cq = 0.f; if (FOX) cq = cl2[(size_t)h * S + t] + P2L[(t >> 6) * 8 + h];
    f32x16 o0, o1;
#pragma unroll
    for (int r = 0; r < 16; ++r) { o0[r] = 0.f; o1[r] = 0.f; }
    bf16x8 kf[4], vf[4]; f32x4 ck[4];
    {
        const int kv0 = kv_lo;
#pragma unroll
        for (int d0 = 0; d0 < 4; ++d0) kf[d0] = *(const bf16x8*)(Kp + (size_t)kv0 * ZLD + 16 * d0);
#pragma unroll
        for (int i = 0; i < 4; ++i) vf[i] = *(const bf16x8*)(Vth + (size_t)(i >> 1) * 32 * S + kv0 + 8 * (i & 1));
        if (FOX) {
#pragma unroll
            for (int i = 0; i < 4; ++i) ck[i] = *(const f32x4*)(clh + kv0 + 4 * i);
        }
    }
    for (int it = 0; it < ntiles; ++it) {
        const int kv0 = kv_lo + 32 * it;
        const int itn = (it + 1 < ntiles) ? it + 1 : it; const int kvn = kv_lo + 32 * itn;
        bf16x8 kfn[4], vfn[4]; f32x4 ckn[4];
#pragma unroll
        for (int d0 = 0; d0 < 4; ++d0) kfn[d0] = *(const bf16x8*)(Kp + (size_t)kvn * ZLD + 16 * d0);
#pragma unroll
        for (int i = 0; i < 4; ++i) vfn[i] = *(const bf16x8*)(Vth + (size_t)(i >> 1) * 32 * S + kvn + 8 * (i & 1));
        if (FOX) {
#pragma unroll
            for (int i = 0; i < 4; ++i) ckn[i] = *(const f32x4*)(clh + kvn + 4 * i);
        }
        f32x16 acc;
        if (FOX) {
            const float base = (cq - P2L[(kv0 >> 6) * 8 + h]) - mhat;
#pragma unroll
            for (int r = 0; r < 16; ++r) acc[r] = base - ck[r >> 2][r & 3];
        } else {
#pragma unroll
            for (int r = 0; r < 16; ++r) acc[r] = -mhat;
        }
#pragma unroll
        for (int d0 = 0; d0 < 4; ++d0) acc = MFMA32(kf[d0], qf[d0], acc);
        if (FOX) {
            if (it == ntiles - 1) {
#pragma unroll
                for (int r = 0; r < 16; ++r) if (16 * hi + r > q) acc[r] = -INFINITY;
            }
        } else {
#pragma unroll
            for (int r = 0; r < 16; ++r) { const int kv = kv0 + 16 * hi + r; if (kv > t || kv + 127 < t) acc[r] = -INFINITY; }
        }
        float mt = acc[0];
#pragma unroll
        for (int r = 1; r < 16; ++r) mt = fmaxf(mt, acc[r]);
        mt = fmaxf(mt, __shfl_xor(mt, 32));
        const bool first = FOX && (it == 0);
        if (first || __any(mt > 8.f)) {
            const float delta = first ? mt : fmaxf(mt, 0.f);
            mhat += delta;
            const float al = first ? 1.f : __builtin_amdgcn_exp2f(-delta);
            l *= al;
#pragma unroll
            for (int r = 0; r < 16; ++r) { acc[r] -= delta; o0[r] *= al; o1[r] *= al; }
        }
        float ps = 0.f;
#pragma unroll
        for (int r = 0; r < 16; ++r) { acc[r] = __builtin_amdgcn_exp2f(acc[r]); ps += acc[r]; }
        l += ps;
        u32x4 w0, w1;
        w0.x = pk2(acc[0], acc[1]); w0.y = pk2(acc[2], acc[3]); w0.z = pk2(acc[4], acc[5]); w0.w = pk2(acc[6], acc[7]);
        w1.x = pk2(acc[8], acc[9]); w1.y = pk2(acc[10], acc[11]); w1.z = pk2(acc[12], acc[13]); w1.w = pk2(acc[14], acc[15]);
        const bf16x8 pb0 = __builtin_bit_cast(bf16x8, w0), pb1 = __builtin_bit_cast(bf16x8, w1);
        o0 = MFMA32(vf[0], pb0, o0); o0 = MFMA32(vf[1], pb1, o0);
        o1 = MFMA32(vf[2], pb0, o1); o1 = MFMA32(vf[3], pb1, o1);
#pragma unroll
        for (int i = 0; i < 4; ++i) { kf[i] = kfn[i]; vf[i] = vfn[i]; if (FOX) ck[i] = ckn[i]; }
    }
    l += __shfl_xor(l, 32);
    const float inv = 1.f / l;
    bf16_t* op = ybr + (size_t)t * DM + ocol + 4 * hi;
#pragma unroll
    for (int g = 0; g < 4; ++g) {
        u32x2 w; w.x = pk2(o0[4 * g] * inv, o0[4 * g + 1] * inv); w.y = pk2(o0[4 * g + 2] * inv, o0[4 * g + 3] * inv); *(u32x2*)(op + 8 * g) = w;
        w.x = pk2(o1[4 * g] * inv, o1[4 * g + 1] * inv); w.y = pk2(o1[4 * g + 2] * inv, o1[4 * g + 3] * inv); *(u32x2*)(op + 32 + 8 * g) = w;
    }
}


__device__ __forceinline__ void fox_unit(int h, int Q, const bf16_t* Z, const bf16_t* Vt, const LAS float* clL, const LAS float* P2L, bf16_t* ybr, LAS unsigned char* lds, int wave, int lane) {
    const int q = lane & 31, hi = lane >> 5, t = Q * 256 + wave * 32 + q;
    const int kx = (q >> 1) & 7;
    const int my_last = 4 * Q + (wave >> 1), ntile = 4 * Q + 4;
    const int P = wave * 64 + lane, lrow = P >> 3, piece = (P & 7) ^ ((lrow >> 1) & 7);
    const int lr = lrow & 31, grow = 32 * (lrow >> 5) + 16 * ((lr >> 2) & 1) + 4 * (lr >> 3) + (lr & 3);
    const bf16_t* ksrc = Z + (size_t)grow * ZLD + ZC_KFOX + h * 64 + piece * 8;
    const bf16_t* vsrc = Vt + (size_t)(h * 64 + lrow) * S + piece * 8;
    const LAS float* clh = clL + 16 * hi;
    bf16x8 qf[4];
#pragma unroll
    for (int d0 = 0; d0 < 4; ++d0) qf[d0] = *(const bf16x8*)(Z + (size_t)t * ZLD + ZC_QFOX + h * 64 + 16 * d0 + 8 * hi);
    const float cq = clL[t] + P2L[(t >> 6) * 8 + h];
    float mhat = 0.f;
    f32x16 o0, o1, lacc;
#pragma unroll
    for (int r = 0; r < 16; ++r) { o0[r] = 0.f; o1[r] = 0.f; lacc[r] = 0.f; }
    const short one_ = (q == 0) ? (short)0x3F80 : (short)0;
    const bf16x8 ones = {one_, one_, one_, one_, one_, one_, one_, one_};
    asm volatile("s_waitcnt vmcnt(0)" ::: "memory");
    asm volatile("" : "+v"(qf[0]), "+v"(qf[1]), "+v"(qf[2]), "+v"(qf[3]));
    __builtin_amdgcn_global_load_lds((const unsigned*)ksrc, (LAS unsigned*)(lds + wave * 1024), 16, 0, 0);
    __builtin_amdgcn_global_load_lds((const unsigned*)vsrc, (LAS unsigned*)(lds + 8192 + wave * 1024), 16, 0, 0);
    __builtin_amdgcn_global_load_lds((const unsigned*)(ksrc + (size_t)64 * ZLD), (LAS unsigned*)(lds + 16384 + wave * 1024), 16, 0, 0);
    __builtin_amdgcn_global_load_lds((const unsigned*)(vsrc + 64), (LAS unsigned*)(lds + 16384 + 8192 + wave * 1024), 16, 0, 0);
    const int koff = q * 128, voff = 8192 + q * 128;
    int s_cur = 0, s_nxt2 = 2 * 16384;
    for (int i = 0; i < ntile; ++i) {
        if (i + 1 < ntile) asm volatile("s_waitcnt vmcnt(2) lgkmcnt(0)\n\ts_barrier" ::: "memory");
        else asm volatile("s_waitcnt vmcnt(0) lgkmcnt(0)\n\ts_barrier" ::: "memory");
        if (i + 2 < ntile) {
            const int kvn = 64 * (i + 2);
            LAS unsigned char* dst = lds + s_nxt2 + wave * 1024;
            __builtin_amdgcn_global_load_lds((const unsigned*)(ksrc + (size_t)kvn * ZLD), (LAS unsigned*)dst, 16, 0, 0);
            __builtin_amdgcn_global_load_lds((const unsigned*)(vsrc + kvn), (LAS unsigned*)(dst + 8192), 16, 0, 0);
        }
        const bool active = (i <= my_last);
        f32x16 a0, a1;
        if (active) {
            const float base = (cq - P2L[i * 8 + h]) - mhat;
            const LAS float* cp = clh + 64 * i;
#pragma unroll
            for (int j = 0; j < 4; ++j) { const f32x4 c0 = *(const LAS f32x4*)(cp + 4 * j), c1 = *(const LAS f32x4*)(cp + 32 + 4 * j);
#pragma unroll
                for (int e = 0; e < 4; ++e) { a0[4 * j + e] = base - c0[e]; a1[4 * j + e] = base - c1[e]; } }
        }
        if (active) {
            const LAS unsigned char* sl = lds + s_cur;
            bf16x8 kfa[4], kfb[4];
#pragma unroll
            for (int d0 = 0; d0 < 4; ++d0) { const int so = ((2 * d0 + hi) ^ kx) * 16; kfa[d0] = *(const LAS bf16x8*)(sl + koff + so); kfb[d0] = *(const LAS bf16x8*)(sl + 4096 + koff + so); }
#pragma unroll
            for (int d0 = 0; d0 < 4; ++d0) { a0 = MFMA32(kfa[d0], qf[d0], a0); a1 = MFMA32(kfb[d0], qf[d0], a1); }
            if (i == my_last) {
#pragma unroll
                for (int r = 0; r < 16; ++r) { const int kv = 64 * i + 16 * hi + r; if (kv > t) a0[r] = -INFINITY; if (kv + 32 > t) a1[r] = -INFINITY; }
            }
            float mt = fmaxf(a0[0], a1[0]);
#pragma unroll
            for (int r = 1; r < 16; ++r) mt = fmaxf(mt, fmaxf(a0[r], a1[r]));
            mt = fmaxf(mt, __shfl_xor(mt, 32));
            const bool first = (i == 0);
            if (first || __any(mt > 30.f)) {
                const float delta = first ? mt : (mt > 0.f ? mt + 30.f : 0.f);
                mhat += delta;
                const float al = first ? 1.f : __builtin_amdgcn_exp2f(-delta);
                lacc[0] *= al;
#pragma unroll
                for (int r = 0; r < 16; ++r) { a0[r] -= delta; a1[r] -= delta; o0[r] *= al; o1[r] *= al; }
            }
#pragma unroll
            for (int r = 0; r < 16; ++r) { a0[r] = __builtin_amdgcn_exp2f(a0[r]); a1[r] = __builtin_amdgcn_exp2f(a1[r]); }
            u32x4 w0, w1, w2, w3;
            w0.x = pk2(a0[0], a0[1]); w0.y = pk2(a0[2], a0[3]); w0.z = pk2(a0[4], a0[5]); w0.w = pk2(a0[6], a0[7]);
            w1.x = pk2(a0[8], a0[9]); w1.y = pk2(a0[10], a0[11]); w1.z = pk2(a0[12], a0[13]); w1.w = pk2(a0[14], a0[15]);
            w2.x = pk2(a1[0], a1[1]); w2.y = pk2(a1[2], a1[3]); w2.z = pk2(a1[4], a1[5]); w2.w = pk2(a1[6], a1[7]);
            w3.x = pk2(a1[8], a1[9]); w3.y = pk2(a1[10], a1[11]); w3.z = pk2(a1[12], a1[13]); w3.w = pk2(a1[14], a1[15]);
            const bf16x8 pb0 = __builtin_bit_cast(bf16x8, w0), pb1 = __builtin_bit_cast(bf16x8, w1), pb2 = __builtin_bit_cast(bf16x8, w2), pb3 = __builtin_bit_cast(bf16x8, w3);
            const int v00 = ((2 * hi) ^ kx) * 16, v01 = ((2 * hi + 1) ^ kx) * 16, v10 = ((4 + 2 * hi) ^ kx) * 16, v11 = ((5 + 2 * hi) ^ kx) * 16;
            const bf16x8 va0 = *(const LAS bf16x8*)(sl + voff + v00), vb0 = *(const LAS bf16x8*)(sl + voff + 4096 + v00), va1 = *(const LAS bf16x8*)(sl + voff + v01), vb1 = *(const LAS bf16x8*)(sl + voff + 4096 + v01);
            const bf16x8 va2 = *(const LAS bf16x8*)(sl + voff + v10), vb2 = *(const LAS bf16x8*)(sl + voff + 4096 + v10), va3 = *(const LAS bf16x8*)(sl + voff + v11), vb3 = *(const LAS bf16x8*)(sl + voff + 4096 + v11);
            o0 = MFMA32(va0, pb0, o0); o1 = MFMA32(vb0, pb0, o1); lacc = MFMA32(ones, pb0, lacc);
            o0 = MFMA32(va1, pb1, o0); o1 = MFMA32(vb1, pb1, o1); lacc = MFMA32(ones, pb1, lacc);
            o0 = MFMA32(va2, pb2, o0); o1 = MFMA32(vb2, pb2, o1); lacc = MFMA32(ones, pb2, lacc);
            o0 = MFMA32(va3, pb3, o0); o1 = MFMA32(vb3, pb3, o1); lacc = MFMA32(ones, pb3, lacc);
        }
        s_cur = (s_cur == 2 * 16384) ? 0 : s_cur + 16384; s_nxt2 = (s_nxt2 == 2 * 16384) ? 0 : s_nxt2 + 16384;
    }
    float l = (hi == 0) ? lacc[0] : 0.f;
    l += __shfl_xor(l, 32);
    const float inv = 1.f / l;
    bf16_t* op = ybr + (size_t)t * DM + 1536 + h * 64 + 4 * hi;
#pragma unroll
    for (int g = 0; g < 4; ++g) {
        u32x2 w; w.x = pk2(o0[4 * g] * inv, o0[4 * g + 1] * inv); w.y = pk2(o0[4 * g + 2] * inv, o0[4 * g + 3] * inv); *(u32x2*)(op + 8 * g) = w;
        w.x = pk2(o1[4 * g] * inv, o1[4 * g + 1] * inv); w.y = pk2(o1[4 * g + 2] * inv, o1[4 * g + 3] * inv); *(u32x2*)(op + 32 + 8 * g) = w;
    }
    asm volatile("s_waitcnt vmcnt(0) lgkmcnt(0)\n\ts_barrier" ::: "memory");
}

__device__ __forceinline__ void phase_mix1(const Params& p, int l, LAS unsigned char* lds, int wave_, int lane_, int G) {
    const int lane = lane_id(), wave = launder_s(wave_); (void)lane_;
    unsigned char* ws = launder_p(p.ws);
    LAS float* P2L = (LAS float*)(lds + LDS_P2);
    {
        const float* tot = (const float*)(ws + O_TOT2); const int h = wave;
        const float a0 = tot[(4 * lane) * 8 + h], a1 = tot[(4 * lane + 1) * 8 + h], a2 = tot[(4 * lane + 2) * 8 + h], a3 = tot[(4 * lane + 3) * 8 + h];
        const float incl = scan_sum(a0 + a1 + a2 + a3, lane); const float ex = incl - (a0 + a1 + a2 + a3);
        P2L[(4 * lane) * 8 + h] = ex; P2L[(4 * lane + 1) * 8 + h] = ex + a0; P2L[(4 * lane + 2) * 8 + h] = ex + a0 + a1; P2L[(4 * lane + 3) * 8 + h] = ex + a0 + a1 + a2;
    }
    __syncthreads();
    if (DBG_MIX & 1) {
        pg8::SimpleSched Sd{(const char*)(ws + O_POOL), (const char*)(ws + OW_BD), 512, 512, 64, 2, G, (int)blockIdx.x, 8};
        pg8::EpiPool E{(bf16_t*)(ws + O_YBR), p.pool_scale + (size_t)l * 512};
        pg8::gemm_phase(lds, 512, 512, Sd, E, wave);
    }
    const int gw = blockIdx.x * NWAVES + wave, NGW = G * NWAVES;
    const int q = lane & 31, hi = lane >> 5;
    if (DBG_MIX & 2) for (int task = gw; task < 4096; task += NGW) {
        const int vb = task & 3, h = (task >> 2) & 3, c = task >> 4;
        const bf16_t* Ap = (const bf16_t*)(ws + O_VTW) + (size_t)(h * 128 + 32 * vb + q) * S + c * 64 + 8 * hi;
        bf16x8 af[4];
#pragma unroll
        for (int ks = 0; ks < 4; ++ks) af[ks] = *(const bf16x8*)(Ap + 16 * ks);
        float* Uo = (float*)(ws + O_U) + ((size_t)(c * 4 + h) * 128 + 32 * vb) * 128;
#pragma unroll
        for (int kb = 0; kb < 4; ++kb) {
            const bf16_t* Bp = (const bf16_t*)(ws + O_KTM) + (size_t)(h * 128 + 32 * kb + q) * S + c * 64 + 8 * hi;
            f32x16 acc;
#pragma unroll
            for (int r = 0; r < 16; ++r) acc[r] = 0.f;
#pragma unroll
            for (int ks = 0; ks < 4; ++ks) acc = MFMA32(af[ks], *(const bf16x8*)(Bp + 16 * ks), acc);
#pragma unroll
            for (int r = 0; r < 16; ++r) Uo[(size_t)crow(r, hi) * 128 + 32 * kb + q] = acc[r];
        }
    }
    if (DBG_MIX & 4) for (int task = gw; task < 4096; task += NGW) {
        const int h = task & 7, qb = task >> 3;
        attn_unit<false>(h, qb, (const bf16_t*)(ws + O_R1), (const bf16_t*)(ws + O_VTS), nullptr, P2L, p.swa_sinks[l * 8 + h] * LOG2E, (bf16_t*)(ws + O_YBR), lane);
    }
    __syncthreads();
    if (DBG_MIX & 8) {
        const int h = blockIdx.x & 7;
        LAS float* clL = (LAS float*)(lds + 49152);
        { const f32x4* src = (const f32x4*)((const float*)(ws + O_CL2) + (size_t)h * S); const int tid = wave * 64 + lane;
#pragma unroll
          for (int j = 0; j < 8; ++j) *(LAS f32x4*)(clL + 4 * (tid + j * NTHR)) = src[tid + j * NTHR]; }
        __syncthreads();
        for (int pr = (blockIdx.x >> 3); pr < 32; pr += (G >> 3)) {
            fox_unit(h, 63 - pr, (const bf16_t*)(ws + O_R1), (const bf16_t*)(ws + O_VTF), clL, P2L, (bf16_t*)(ws + O_YBR), lds, wave, lane);
            fox_unit(h, pr, (const bf16_t*)(ws + O_R1), (const bf16_t*)(ws + O_VTF), clL, P2L, (bf16_t*)(ws + O_YBR), lds, wave, lane);
        }
    }
}

__device__ __forceinline__ void phase_scan(const Params& p, LAS unsigned char* lds, int wave_, int G) {
    unsigned char* ws = launder_p(p.ws); const int tid = launder_s(wave_) * 64 + lane_id();
    if ((int)blockIdx.x * NTHR >= 4 * 16512) return;
    LAS float* decL = (LAS float*)lds; LAS float* sclL = decL + 1024; LAS float* blL = sclL + 1024; LAS float* dmL = blL + 1024;
    for (int i = tid; i < 1024; i += NTHR) { blL[i] = ((const float*)(ws + O_BLC))[i]; dmL[i] = ((const float*)(ws + O_DMC))[i]; }
    __syncthreads();
    if (tid < 4) {
        const int h = tid; float m = 0.f;
        for (int c = 0; c < 256; ++c) {
            const float bl = blL[c * 4 + h], dm = dmL[c * 4 + h]; const float mn = fmaxf(bl + m, bl + dm);
            decL[c * 4 + h] = __expf(bl + m - mn); sclL[c * 4 + h] = __expf(bl + dm - mn);
            if (blockIdx.x == 0) ((float*)(ws + O_MST))[c * 4 + h] = m;
            m = mn;
        }
    }
    __syncthreads();
    const int e = blockIdx.x * NTHR + tid;
    if (e < 4 * 16512) {
        const int h = e / 16512, idx = e % 16512;
        float st = 0.f;
        if (idx < 16384) {
            const float* src = (const float*)(ws + O_U) + (size_t)h * 16384 + idx; bf16_t* dst = (bf16_t*)(ws + O_CST) + (size_t)h * 16384 + idx;
            for (int c0 = 0; c0 < 256; c0 += 32) {
                float u[32];
#pragma unroll
                for (int j = 0; j < 32; ++j) u[j] = src[(size_t)(c0 + j) * 65536];
#pragma unroll
                for (int j = 0; j < 32; ++j) { dst[(size_t)(c0 + j) * 65536] = f2bf(st); st = decL[(c0 + j) * 4 + h] * st + sclL[(c0 + j) * 4 + h] * u[j]; }
            }
        } else {
            const int k = idx - 16384;
            const float* src = (const float*)(ws + O_UN) + h * 128 + k; float* dst = (float*)(ws + O_NST) + h * 128 + k;
            for (int c0 = 0; c0 < 256; c0 += 8) {
                float u[8];
#pragma unroll
                for (int j = 0; j < 8; ++j) u[j] = src[(size_t)(c0 + j) * 512];
#pragma unroll
                for (int j = 0; j < 8; ++j) { dst[(size_t)(c0 + j) * 512] = st; st = decL[(c0 + j) * 4 + h] * st + sclL[(c0 + j) * 4 + h] * u[j]; }
            }
        }
    }
}

__device__ __forceinline__ void phase_mlout(const Params& p, int wave_, int lane_, int G) {
    const int lane = lane_id(), wave = launder_s(wave_); (void)lane_;
    unsigned char* ws = launder_p(p.ws);
    const int gw = blockIdx.x * NWAVES + wave, NGW = G * NWAVES;
    const int q = lane & 31, hi = lane >> 5;
    const int pim = 16 * ((q >> 2) & 1) + 4 * (q >> 3) + (q & 3);
    const bf16_t* QKC = (const bf16_t*)(ws + O_QKC); const bf16_t* Z = (const bf16_t*)(ws + O_R1);
    for (int task = gw; task < 2048; task += NGW) {
        const int tb = task & 1, h = (task >> 1) & 3, c = task >> 3;
        const int t = c * 64 + 32 * tb + q;
        bf16x8 qf[8];
#pragma unroll
        for (int kk = 0; kk < 8; ++kk) qf[kk] = *(const bf16x8*)(QKC + (size_t)t * 1024 + h * 128 + 16 * kk + 8 * hi);
        const float m_c = ((const float*)(ws + O_MST))[c * 4 + h];
        const float a_t = ((const float*)(ws + O_MLA))[h * S + t], b_t = ((const float*)(ws + O_MLB))[h * S + t];
        const float Mt = fmaxf(m_c, a_t), w_inter = __expf(m_c - Mt);
        f32x16 o[4];
#pragma unroll
        for (int vb = 0; vb < 4; ++vb) {
#pragma unroll
            for (int r = 0; r < 16; ++r) o[vb][r] = 0.f;
            const bf16_t* Cp = (const bf16_t*)(ws + O_CST) + ((size_t)(c * 4 + h) * 128 + 32 * vb + q) * 128 + 8 * hi;
#pragma unroll
            for (int kk = 0; kk < 8; ++kk) o[vb] = MFMA32(*(const bf16x8*)(Cp + 16 * kk), qf[kk], o[vb]);
#pragma unroll
            for (int r = 0; r < 16; ++r) o[vb][r] *= w_inter;
        }
        float nq = 0.f;
        {
            const float* np = (const float*)(ws + O_NST) + (size_t)(c * 4 + h) * 128 + 8 * hi;
#pragma unroll
            for (int kk = 0; kk < 8; ++kk) { const f32x4 n0 = *(const f32x4*)(np + 16 * kk), n1 = *(const f32x4*)(np + 16 * kk + 4);
                const bf16x8 qq = qf[kk];
                nq += n0[0] * bf2f((unsigned short)qq[0]) + n0[1] * bf2f((unsigned short)qq[1]) + n0[2] * bf2f((unsigned short)qq[2]) + n0[3] * bf2f((unsigned short)qq[3])
                    + n1[0] * bf2f((unsigned short)qq[4]) + n1[1] * bf2f((unsigned short)qq[5]) + n1[2] * bf2f((unsigned short)qq[6]) + n1[3] * bf2f((unsigned short)qq[7]); }
            nq += __shfl_xor(nq, 32);
        }
        float den = 0.f;
        for (int sb = 0; sb <= tb; ++sb) {
            const int s0 = c * 64 + 32 * sb;
            f32x16 acc;
#pragma unroll
            for (int r = 0; r < 16; ++r) acc[r] = 0.f;
            const bf16_t* Kp = QKC + (size_t)(s0 + pim) * 1024 + 512 + h * 128 + 8 * hi;
#pragma unroll
            for (int kk = 0; kk < 8; ++kk) acc = MFMA32(*(const bf16x8*)(Kp + 16 * kk), qf[kk], acc);
            const float* dp = (const float*)(ws + O_MLD) + (size_t)h * S + s0 + 16 * hi;
#pragma unroll
            for (int r = 0; r < 16; ++r) { const int s = s0 + 16 * hi + r; const float w = (s <= t) ? __expf(dp[r] - Mt) : 0.f; acc[r] *= w; den += acc[r]; }
            u32x4 w0, w1;
            w0.x = pk2(acc[0], acc[1]); w0.y = pk2(acc[2], acc[3]); w0.z = pk2(acc[4], acc[5]); w0.w = pk2(acc[6], acc[7]);
            w1.x = pk2(acc[8], acc[9]); w1.y = pk2(acc[10], acc[11]); w1.z = pk2(acc[12], acc[13]); w1.w = pk2(acc[14], acc[15]);
            const bf16x8 pb0 = __builtin_bit_cast(bf16x8, w0), pb1 = __builtin_bit_cast(bf16x8, w1);
#pragma unroll
            for (int vb = 0; vb < 4; ++vb) {
                const bf16_t* Vp = (const bf16_t*)(ws + O_VTM) + (size_t)(h * 128 + 32 * vb + q) * S + s0 + 16 * hi;
                o[vb] = MFMA32(*(const bf16x8*)Vp, pb0, o[vb]); o[vb] = MFMA32(*(const bf16x8*)(Vp + 8), pb1, o[vb]);
            }
        }
        den += __shfl_xor(den, 32);
        den += w_inter * nq;
        const float hd = fmaxf(fabsf(den), __expf(-(b_t + Mt))); const float inv = 1.f / hd;
        const bf16_t* opre = Z + (size_t)t * ZLD + ZC_OML + h * 128 + 4 * hi;
        bf16_t* op = (bf16_t*)(ws + O_YBR) + (size_t)t * DM + 1024 + h * 128 + 4 * hi;
#pragma unroll
        for (int vb = 0; vb < 4; ++vb)
#pragma unroll
            for (int g = 0; g < 4; ++g) {
                const u32x2 og = *(const u32x2*)(opre + 32 * vb + 8 * g);
                u32x2 w; w.x = pk2(sigmoidf_(bflo(og.x)) * o[vb][4 * g] * inv, sigmoidf_(bfhi(og.x)) * o[vb][4 * g + 1] * inv);
                w.y = pk2(sigmoidf_(bflo(og.y)) * o[vb][4 * g + 2] * inv, sigmoidf_(bfhi(og.y)) * o[vb][4 * g + 3] * inv);
                *(u32x2*)(op + 32 * vb + 8 * g) = w;
            }
    }
}


__device__ __forceinline__ void dbg_dump(float* out, const void* src, int mode, int wave, int G) {
    const int gt = blockIdx.x * NTHR + wave * 64 + lane_id(), NGT = G * NTHR;
    for (int i = gt; i < S * DM; i += NGT) out[i] = mode ? bf2f(((const bf16_t*)src)[i]) : ((const float*)src)[i];
}
#define DBG_AT(k, off, mode) do { if (DBG_STOP == (k) && l == 0) { GRID_SYNC(15); dbg_dump(p.out, p.ws + (off), (mode), wave, G); return; } } while (0)
#define XB_TMO      128
#define XB_XCNT(j)  (256  + 64 * (j))
#define XB_XSUB(j)  (1280 + 64 * (j))
#define XB_XGEN(j)  (2304 + 64 * (j))
#define XB_TOP      3328
#define XB_TOPGEN   3392
#define XB_SPIN_CAP (1u << 22)
__device__ __forceinline__ unsigned xb_ld(unsigned* p)              { return __hip_atomic_load(p, __ATOMIC_RELAXED, __HIP_MEMORY_SCOPE_AGENT); }
__device__ __forceinline__ unsigned xb_add(unsigned* p, unsigned v) { return __hip_atomic_fetch_add(p, v, __ATOMIC_RELAXED, __HIP_MEMORY_SCOPE_AGENT); }
__device__ __forceinline__ unsigned xb_xcc_id() { return (unsigned)__builtin_amdgcn_s_getreg((3 << 11) | 20) & 0xFu; }
#define XB_SPIN(cond, bar) do { unsigned _sp = 0; while (cond) { __builtin_amdgcn_s_sleep(1); \
    if ((++_sp & 255u) == 0u) { if (xb_ld(&(bar)[XB_TMO])) break; if (_sp > XB_SPIN_CAP) { atomicAdd(&(bar)[XB_TMO], 1u); break; } } } } while (0)
__device__ __forceinline__ void xcd_census(unsigned* bar, unsigned x, unsigned G, unsigned& nloc, unsigned& nx) {
    unsigned sum, cnt, mine, sp = 0u;
    for (;;) {
        sum = 0u; cnt = 0u; mine = 0u;
#pragma unroll
        for (unsigned j = 0; j < 16; ++j) { const unsigned c = xb_ld(&bar[XB_XCNT(j)]); sum += c; cnt += (c > 0u) ? 1u : 0u; mine = (j == x) ? c : mine; }
        if (sum == G) break;
        __builtin_amdgcn_s_sleep(1);
        if ((++sp & 255u) == 0u) { if (xb_ld(&bar[XB_TMO])) break; if (sp > XB_SPIN_CAP) { atomicAdd(&bar[XB_TMO], 1u); break; } }
    }
    nloc = mine > 0u ? mine : 1u; nx = cnt > 0u ? cnt : 1u;
}
__device__ __forceinline__ void grid_barrier(unsigned* bar, volatile LAS unsigned* st, unsigned G, int wave) {
    asm volatile("s_waitcnt vmcnt(0) lgkmcnt(0)" ::: "memory");
    __syncthreads();
    if (wave == 0 && lane_id() == 0) {
        const unsigned x = xb_xcc_id();
        unsigned nloc = st[0], nx = st[1];
        if (nloc == 0u) { xcd_census(bar, x, G, nloc, nx); st[0] = nloc; st[1] = nx; }
        const unsigned old = xb_add(&bar[XB_XSUB(x)], 1u);
        const unsigned gen = old / nloc;
        if (old + 1u == (gen + 1u) * nloc) {
            __builtin_amdgcn_fence(__ATOMIC_RELEASE, "agent");
            asm volatile("s_waitcnt vmcnt(0)" ::: "memory");
            const unsigned og = xb_add(&bar[XB_TOP], 1u);
            const unsigned tg = og / nx;
            if (og + 1u == (tg + 1u) * nx) xb_add(&bar[XB_TOPGEN], 1u);
            else XB_SPIN(xb_ld(&bar[XB_TOPGEN]) == tg, bar);
            __builtin_amdgcn_fence(__ATOMIC_ACQUIRE, "agent");
            xb_add(&bar[XB_XGEN(x)], 1u);
            asm volatile("s_waitcnt vmcnt(0)" ::: "memory");
        } else {
            XB_SPIN(xb_ld(&bar[XB_XGEN(x)]) == gen, bar);
            __builtin_amdgcn_fence(__ATOMIC_ACQUIRE, "agent");
            asm volatile("s_waitcnt vmcnt(0)" ::: "memory");
        }
    }
    __syncthreads();
}
#define GRID_SYNC(k) grid_barrier((unsigned*)(p.ws + O_CTL), (volatile LAS unsigned*)(lds + LDS_MISC + 2048), (unsigned)G, wave)
__global__ void __launch_bounds__(NTHR, 2) fwd_megakernel(Params p) {
    extern __shared__ __attribute__((aligned(16))) unsigned char lds_raw[];
    LAS unsigned char* lds = (LAS unsigned char*)lds_raw;
    cg::grid_group grid = cg::this_grid();
    const int wave = __builtin_amdgcn_readfirstlane((int)threadIdx.x >> 6), lane = 0;
    const int G = gridDim.x, bx = blockIdx.x;
    grid.sync();
    if (wave == 0 && lane_id() == 0) { volatile LAS unsigned* st = (volatile LAS unsigned*)(lds + LDS_MISC + 2048); st[0] = 0u; st[1] = 0u; (void)xb_add((unsigned*)(p.ws + O_CTL) + XB_XCNT(xb_xcc_id()), 1u); }
    __syncthreads();

    for (int l = 0; l < NL; ++l) {
        if (l == 0) { REPS(3) phase_weights(p, 0, lds, wave, lane, G);
            GRID_SYNC(0); }
        REPS(2) { unsigned char* ws = launder_p(p.ws); pg8::SimpleSched Sd{(const char*)(ws + O_HB), (const char*)(ws + OW_F1A), DM, DM, 64, 44, G, bx, 32}; pg8::EpiSwiGLU E{(bf16_t*)(ws + O_R1)}; pg8::gemm_phase(lds, DM, DM, Sd, E, wave); }
        GRID_SYNC(1);
        if (l == 0) { unsigned char* ws = launder_p(p.ws); pg8::SimpleSched Sd{(const char*)(ws + O_R1), (const char*)(ws + OW_F1B), FF, FF, 64, 8, G, bx, 88}; pg8::EpiResid<false> E{p.x, (float*)(ws + O_H), 0.5f, nullptr, nullptr, nullptr}; pg8::gemm_phase(lds, FF, FF, Sd, E, wave); }
        else { unsigned char* ws = launder_p(p.ws); pg8::SimpleSched Sd{(const char*)(ws + O_R1), (const char*)(ws + OW_F1B), FF, FF, 64, 8, G, bx, 88}; pg8::EpiResid<true> E{(const float*)(ws + O_H), (float*)(ws + O_H), 0.5f, (const float*)(ws + O_ST), p.ln_g + (size_t)(l * 3 - 1) * DM, p.ln_b + (size_t)(l * 3 - 1) * DM}; pg8::gemm_phase(lds, FF, FF, Sd, E, wave); }
        GRID_SYNC(2);
        REPS(7) { unsigned char* ws = launder_p(p.ws); const bool dummy = (REP_PHASE == 7) && (rep_ == 0); phase_ln((const float*)(ws + O_H), dummy ? (float*)(ws + O_YBR) : nullptr, (bf16_t*)(ws + (dummy ? O_U : O_HB)), (float*)(ws + O_ST), p.ln_g + (size_t)(l * 3 + 0) * DM, p.ln_b + (size_t)(l * 3 + 0) * DM, wave, lane, G); }
        GRID_SYNC(3);
        DBG_AT(1, O_H, 0);
        { unsigned char* ws = launder_p(p.ws); pg8::SimpleSched Sd{(const char*)(ws + O_HB), (const char*)(ws + OW_IN), DM, DM, 64, 20, G, bx, 32}; pg8::EpiInProj E{(bf16_t*)(ws + O_R1), (float*)(ws + O_ZG)}; pg8::gemm_phase(lds, DM, DM, Sd, E, wave); }
        GRID_SYNC(4);
        DBG_AT(2, O_R1, 1);
        phase_post(p, l, lds, wave, lane, G);
        GRID_SYNC(5);
        DBG_AT(3, O_QKC, 1);
        REPS(1) phase_mix1(p, l, lds, wave, lane, G);
        GRID_SYNC(6);
        DBG_AT(4, O_YBR, 1);
        REPS(6) phase_scan(p, lds, wave, G);
        GRID_SYNC(7);
        REPS(5) phase_mlout(p, wave, lane, G);
        GRID_SYNC(8);
        DBG_AT(5, O_YBR, 1);
        REPS(4) { unsigned char* ws = launder_p(p.ws); pg8::MergeSched Sd{(const char*)(ws + O_HB), (const char*)(ws + O_YBR), (const char*)(ws + OW_G), (const char*)(ws + OW_BC), G, bx};
          pg8::EpiMerge E{(u32x2*)(ws + O_GSC), (u32x4*)(ws + O_MSC), (bf16_t*)(ws + O_MERGED)}; pg8::gemm_phase(lds, DM, DM, Sd, E, wave); }
        GRID_SYNC(9);
        DBG_AT(6, O_MERGED, 1);
        { unsigned char* ws = launder_p(p.ws); pg8::SimpleSched Sd{(const char*)(ws + O_MERGED), (const char*)(ws + OW_O), DM, DM, 64, 8, G, bx, 32}; pg8::EpiResid<true> E{(const float*)(ws + O_H), (float*)(ws + O_H), 1.0f, (const float*)(ws + O_ST), p.ln_g + (size_t)(l * 3 + 0) * DM, p.ln_b + (size_t)(l * 3 + 0) * DM}; pg8::gemm_phase(lds, DM, DM, Sd, E, wave); }
        GRID_SYNC(10);
        { unsigned char* ws = launder_p(p.ws); phase_ln((const float*)(ws + O_H), nullptr, (bf16_t*)(ws + O_HB), (float*)(ws + O_ST), p.ln_g + (size_t)(l * 3 + 1) * DM, p.ln_b + (size_t)(l * 3 + 1) * DM, wave, lane, G); }
        GRID_SYNC(11);
        DBG_AT(7, O_H, 0);
        { unsigned char* ws = launder_p(p.ws); pg8::SimpleSched Sd{(const char*)(ws + O_HB), (const char*)(ws + OW_F2A), DM, DM, 64, 44, G, bx, 32}; pg8::EpiSwiGLU E{(bf16_t*)(ws + O_R1)}; pg8::gemm_phase(lds, DM, DM, Sd, E, wave); }
        GRID_SYNC(12);
        { unsigned char* ws = launder_p(p.ws); pg8::SimpleSched Sd{(const char*)(ws + O_R1), (const char*)(ws + OW_F2B), FF, FF, 64, 8, G, bx, 88}; pg8::EpiResid<true> E{(const float*)(ws + O_H), (float*)(ws + O_H), 0.5f, (const float*)(ws + O_ST), p.ln_g + (size_t)(l * 3 + 1) * DM, p.ln_b + (size_t)(l * 3 + 1) * DM}; pg8::gemm_phase(lds, FF, FF, Sd, E, wave); }
        GRID_SYNC(13);
        { unsigned char* ws = launder_p(p.ws); phase_ln((const float*)(ws + O_H), (l == NL - 1) ? p.out : nullptr, (l == NL - 1) ? nullptr : (bf16_t*)(ws + O_HB), (l == NL - 1) ? nullptr : (float*)(ws + O_ST), p.ln_g + (size_t)(l * 3 + 2) * DM, p.ln_b + (size_t)(l * 3 + 2) * DM, wave, lane, G); }
        if (l + 1 < NL) phase_weights(p, l + 1, lds, wave, lane, G);
        GRID_SYNC(14);
    }
}

extern "C" void kernel_launch(void* const* d_in, const int* in_sizes, int n_in, void* d_out, int out_size, void* d_ws, size_t ws_size, hipStream_t stream) {
    static int grid_blocks = 0;
    if (grid_blocks == 0) {
        if (n_in != 18 || ws_size < O_END) { fprintf(stderr, "kernel_launch: unexpected inputs (n_in %d, ws %zu, need %zu)\n", n_in, ws_size, (size_t)O_END); grid_blocks = -1; return; }
        int dev = 0, cus = 0, per_cu = 0;
        hipGetDevice(&dev);
        hipDeviceGetAttribute(&cus, hipDeviceAttributeMultiprocessorCount, dev);
        hipFuncSetAttribute((const void*)fwd_megakernel, hipFuncAttributeMaxDynamicSharedMemorySize, LDS_BYTES);
        hipOccupancyMaxActiveBlocksPerMultiprocessor(&per_cu, (const void*)fwd_megakernel, NTHR, LDS_BYTES);
        if (per_cu < 1) per_cu = 1;
        grid_blocks = cus * 1;
        (void)hipGetLastError();
    }
    if (grid_blocks < 0) return;
    Params p{};
    p.x = (const float*)d_in[0]; p.ln_g = (const float*)d_in[1]; p.ln_b = (const float*)d_in[2]; p.ffn1_w_in = (const float*)d_in[3]; p.ffn1_w_out = (const float*)d_in[4];
    p.w_in = (const float*)d_in[5]; p.pool_w = (const float*)d_in[6]; p.pool_scale = (const float*)d_in[7]; p.swa_sinks = (const float*)d_in[8]; p.mlstm_conv = (const float*)d_in[9];
    p.mlstm_i_bias = (const float*)d_in[10]; p.mlstm_f_bias = (const float*)d_in[11]; p.fox_f_bias = (const float*)d_in[12]; p.w_branch = (const float*)d_in[13]; p.w_gate = (const float*)d_in[14];
    p.w_out = (const float*)d_in[15]; p.ffn2_w_in = (const float*)d_in[16]; p.ffn2_w_out = (const float*)d_in[17]; p.out = (float*)d_out; p.ws = (unsigned char*)d_ws;
    (void)hipMemsetAsync((unsigned char*)d_ws + O_CTL, 0, 16384, stream);
    void* args[] = {&p};
    hipError_t e = hipLaunchCooperativeKernel((const void*)fwd_megakernel, dim3(grid_blocks), dim3(NTHR), args, LDS_BYTES, stream);
    if (e != hipSuccess) fprintf(stderr, "cooperative launch failed: %s (grid %d)\n", hipGetErrorString(e), grid_blocks);
}
```

```cpp
#include <hip/hip_runtime.h>
#include <hip/hip_cooperative_groups.h>
#include <cstdio>
#include <cstdint>
namespace cg = cooperative_groups;
#define DBG_MIX 15
#define DBG_STOP 0
#define REP_PHASE 0
#define REPS(k) for (int rep_ = 0; rep_ < ((REP_PHASE == (k)) ? 2 : 1); ++rep_)

#define LAS __attribute__((address_space(3)))
typedef unsigned short bf16_t;
typedef short bf16x8 __attribute__((ext_vector_type(8)));
typedef float f32x4 __attribute__((ext_vector_type(4)));
typedef float f32x16 __attribute__((ext_vector_type(16)));
typedef unsigned u32x4 __attribute__((ext_vector_type(4)));
typedef unsigned u32x2 __attribute__((ext_vector_type(2)));
typedef float f32x2_t __attribute__((ext_vector_type(2)));
typedef __bf16 bf16x2_t __attribute__((ext_vector_type(2)));

constexpr int S = 16384, DM = 2048, FF = 5632, ZLD = 4864, NL = 2;
constexpr int NWAVES = 8, NTHR = 512;
constexpr float ALPHA = 1.41421356237309515f;
constexpr float LOG2E = 1.4426950408889634f;
constexpr float C2 = 0.125f * LOG2E;
constexpr float LN_EPS = 1e-5f;
constexpr int ZC_QSWA = 512, ZC_KSWA = 1024, ZC_VSWA = 1152, ZC_QML = 1280, ZC_VML = 2304, ZC_OML = 2816, ZC_QFOX = 3328, ZC_KFOX = 3840, ZC_VFOX = 4352;

constexpr size_t MiB = 1u << 20;
constexpr size_t O_ZG = 0;
constexpr size_t O_MLA = 1 * MiB;
constexpr size_t O_MLB = O_MLA + 256 * 1024;
constexpr size_t O_MLD = O_MLB + 256 * 1024;
constexpr size_t O_CL2 = 2 * MiB;
constexpr size_t O_TOT2 = O_CL2 + 512 * 1024;
constexpr size_t O_BLC = O_TOT2 + 16 * 1024;
constexpr size_t O_DMC = O_BLC + 16 * 1024;
constexpr size_t O_MST = O_DMC + 16 * 1024;
constexpr size_t O_NST = 3 * MiB;
constexpr size_t O_UN = O_NST + 512 * 1024;
constexpr size_t O_ST = 4 * MiB;
constexpr size_t O_W = 8 * MiB;
constexpr size_t OW_F1A = O_W, OW_F1B = OW_F1A + 44 * MiB, OW_IN = OW_F1B + 22 * MiB, OW_G = OW_IN + 20 * MiB, OW_BC = OW_G + 32 * MiB,
                 OW_O = OW_BC + 8 * MiB, OW_F2A = OW_O + 8 * MiB, OW_F2B = OW_F2A + 44 * MiB, OW_BD = OW_F2B + 22 * MiB;
constexpr size_t O_H = 210 * MiB;
constexpr size_t O_HB = 338 * MiB;
constexpr size_t O_R1 = 402 * MiB;
constexpr size_t O_YBR = 578 * MiB;
constexpr size_t O_QKC = 642 * MiB;
constexpr size_t O_VTF = 674 * MiB;
constexpr size_t O_VTS = 690 * MiB;
constexpr size_t O_VTM = 694 * MiB;
constexpr size_t O_VTW = 710 * MiB;
constexpr size_t O_KTM = 726 * MiB;
constexpr size_t O_POOL = 742 * MiB;
constexpr size_t O_U = 758 * MiB;
constexpr size_t O_CST = 822 * MiB;
constexpr size_t O_CTL = 854 * MiB;
constexpr size_t O_END = 855 * MiB;
constexpr size_t O_MERGED = O_QKC;
constexpr size_t O_GSC = O_R1;
constexpr size_t O_MSC = O_R1 + 32 * MiB;

constexpr int RING_BYTES = 131072;
constexpr int LDS_P2 = RING_BYTES;
constexpr int LDS_MISC = RING_BYTES + 8192;
constexpr int LDS_BYTES = 147456;

__device__ __forceinline__ unsigned pk2(float lo, float hi) { f32x2_t v = {lo, hi}; bf16x2_t b = __builtin_convertvector(v, bf16x2_t); return __builtin_bit_cast(unsigned, b); }
__device__ __forceinline__ float bf2f(unsigned short b) { return __uint_as_float((unsigned)b << 16); }
__device__ __forceinline__ float bflo(unsigned w) { return __uint_as_float(w << 16); }
__device__ __forceinline__ float bfhi(unsigned w) { return __uint_as_float(w & 0xffff0000u); }
__device__ __forceinline__ unsigned short f2bf(float f) { return (unsigned short)(pk2(f, 0.f) & 0xffffu); }
__device__ __forceinline__ float sigmoidf_(float x) { return __builtin_amdgcn_rcpf(1.f + __builtin_amdgcn_exp2f(-x * LOG2E)); }
__device__ __forceinline__ float logsigmoidf_(float x) { return fminf(x, 0.f) - log1pf(__expf(-fabsf(x))); }
__device__ __forceinline__ int lane_id() { int l; asm volatile("v_mbcnt_lo_u32_b32 %0, -1, 0\n\tv_mbcnt_hi_u32_b32 %0, -1, %0" : "=v"(l)); return l; }
__device__ __forceinline__ int launder_v(int x) { asm volatile("" : "+v"(x)); return x; }
__device__ __forceinline__ int launder_s(int x) { asm volatile("" : "+s"(x)); return x; }
template <class T> __device__ __forceinline__ T* launder_pv(T* p) { asm volatile("" : "+v"(p)); return p; }
template <class T> __device__ __forceinline__ T* launder_p(T* p) { asm volatile("" : "+s"(p)); return p; }
__device__ __forceinline__ int crow(int r, int hi) { return (r & 3) + 8 * (r >> 2) + 4 * hi; }

namespace pg8 {
constexpr int BM = 256, BK = 64, HALF = 128, HTB = HALF * BK * 2, NXCD = 8, WGM = 8;
__device__ __forceinline__ int lds_byte(int r, int c) { const int st = (r >> 4) * 2 + (c >> 5), rr = r & 15, cc = c & 31, ob = rr * 64 + cc * 2; return st * 1024 + (ob ^ (((ob >> 9) & 1) << 5)); }
__device__ __forceinline__ void stage_rc(int b, int& R, int& C) { const int st = b / 1024, sb = b % 1024, swz = sb ^ (((sb >> 9) & 1) << 5); R = (st >> 1) * 16 + swz / 64; C = (st & 1) * 32 + (swz % 64) / 2; }
__device__ __forceinline__ int perm32(int rho) { const int n = rho >> 4, i = rho & 15; return 8 * (i >> 2) + 4 * n + (i & 3); }

struct Unit { int pm, pn, kind, nt; const char* a; const char* b; };

__device__ __forceinline__ void tile_of(int L, int nM, int nN, int& pm, int& pn) {
    const int nwg = nM * nN; int wgid = L;
    { const int q = nwg / NXCD, r = nwg % NXCD, xcd = wgid % NXCD, off = wgid / NXCD; wgid = (xcd < r ? xcd * (q + 1) : r * (q + 1) + (xcd - r) * q) + off; }
    const int nig = WGM * nN, gid = wgid / nig, fm = gid * WGM, gsz = (nM - fm) < WGM ? (nM - fm) : WGM;
    pm = fm + ((wgid % nig) % gsz); pn = (wgid % nig) / gsz;
}
struct SimpleSched {
    const char* A; const char* Bt; int lda, ldb, nM, nN, G, c, nt;
    __device__ __forceinline__ bool next(int i, Unit& u) const {
        const int L = i * G + c; if (L >= nM * nN) return false;
        tile_of(L, nM, nN, u.pm, u.pn); u.kind = 0; u.nt = nt;
        u.a = A + (size_t)u.pm * 256 * lda * 2; u.b = Bt + (size_t)u.pn * 256 * ldb * 2; return true;
    }
};
struct MergeSched {
    const char* HB; const char* YBR; const char* WG; const char* WBC; int G, c;
    __device__ __forceinline__ bool next(int i, Unit& u) const {
        const int L = (i >> 3) * G + c; if (L >= 64 * 8) return false;
        tile_of(L, 64, 8, u.pm, u.pn); const int sub = i & 7, b = sub >> 1; u.kind = sub;
        if ((sub & 1) == 0) { u.nt = 32; u.a = HB + (size_t)u.pm * 256 * 2048 * 2; u.b = WG + ((size_t)b * 2048 + (size_t)u.pn * 256) * 2048 * 2; }
        else { u.nt = 8; u.a = YBR + ((size_t)u.pm * 256 * 2048 + b * 512) * 2; u.b = WBC + ((size_t)u.pn * 256 * 2048 + b * 512) * 2; }
        return true;
    }
};

template <class Epi, class Sched>
__device__ __forceinline__ void gemm_phase(LAS unsigned char* lds, const int lda, const int ldb, const Sched& S, const Epi& E, const int wave_) {
    const int wid = launder_s(wave_), lane = lane_id(), tid = wid * 64 + lane, wr = wid >> 2, wc = wid & 3, fr = lane & 15, fq = lane >> 4;
    unsigned voffA[2], voffB[2];
#pragma unroll
    for (int i = 0; i < 2; ++i) { int R, C; stage_rc(tid * 16 + i * 8192, R, C); const int Rb = Epi::PERM ? ((R & ~31) + perm32(R & 31)) : R;
        voffA[i] = (unsigned)(R * lda + C) * 2u; voffB[i] = (unsigned)(Rb * ldb + C) * 2u; }
    const size_t kstep = (size_t)(BK * 2);
    const size_t hstepA = (size_t)HALF * lda * 2, hstepB = (size_t)HALF * ldb * 2;
    const unsigned ldsw = (unsigned)wid * 1024u;
    const int aoff = lds_byte(wr * 64 + fr, fq * 8), boff = lds_byte(wc * 32 + fr, fq * 8);
#define PG8_SA(b, h) (((b) * 2 + (h)) * HTB)
#define PG8_SB(b, h) ((4 + (b) * 2 + (h)) * HTB)
#define PG8_STAGE(bufoff, gbase, voff) do { _Pragma("unroll") for (int _i = 0; _i < 2; ++_i) \
        __builtin_amdgcn_global_load_lds((const unsigned*)((const char*)(gbase) + (voff)[_i]), (LAS unsigned*)(lds + (bufoff) + ldsw + _i * 8192), 16, 0, 0); } while (0)
#define PG8_LDA(dst, b, h) do { _Pragma("unroll") for (int m = 0; m < 4; ++m) _Pragma("unroll") for (int k = 0; k < 2; ++k) dst[m][k] = *(const LAS bf16x8*)(lds + PG8_SA(b, h) + aoff + m * 2048 + k * 1024); } while (0)
#define PG8_LDB(dst, b, h) do { _Pragma("unroll") for (int n = 0; n < 2; ++n) _Pragma("unroll") for (int k = 0; k < 2; ++k) dst[n][k] = *(const LAS bf16x8*)(lds + PG8_SB(b, h) + boff + n * 2048 + k * 1024); } while (0)
#define PG8_MMA(ai, bj, At, Bt) do { __builtin_amdgcn_s_setprio(1); _Pragma("unroll") for (int m = 0; m < 4; ++m) _Pragma("unroll") for (int n = 0; n < 2; ++n) _Pragma("unroll") for (int k = 0; k < 2; ++k) \
        acc[ai][bj][m][n] = __builtin_amdgcn_mfma_f32_16x16x32_bf16(Bt[n][k], At[m][k], acc[ai][bj][m][n], 0, 0, 0); __builtin_amdgcn_s_setprio(0); } while (0)
#define PG8_WAIT_V(n) asm volatile("s_waitcnt vmcnt(" #n ")" ::: "memory")
#define PG8_WAIT_L(n) asm volatile("s_waitcnt lgkmcnt(" #n ")" ::: "memory")
#define PG8_BAR __builtin_amdgcn_s_barrier()
#define PG8_SCHED __builtin_amdgcn_sched_barrier(0)
    Unit cur, nxt; int ui = 0;
    if (!S.next(0, cur)) return;
    f32x4 acc[2][2][4][2];
#pragma unroll
    for (int a = 0; a < 2; ++a)
#pragma unroll
        for (int b = 0; b < 2; ++b)
#pragma unroll
            for (int m = 0; m < 4; ++m)
#pragma unroll
                for (int n = 0; n < 2; ++n) acc[a][b][m][n] = (f32x4){0.f, 0.f, 0.f, 0.f};
    bf16x8 At[4][2], B0[2][2], B1[2][2];
    const char* cA = cur.a; const char* cB = cur.b;
    PG8_STAGE(PG8_SB(0, 0), cB, voffB); PG8_STAGE(PG8_SB(0, 1), cB + hstepB, voffB); PG8_STAGE(PG8_SA(0, 0), cA, voffA); PG8_STAGE(PG8_SA(0, 1), cA + hstepA, voffA);
    if (wr == 1) PG8_BAR;
    PG8_WAIT_V(2); PG8_BAR;
    PG8_STAGE(PG8_SB(1, 0), cB + kstep, voffB); PG8_STAGE(PG8_SA(1, 0), cA + kstep, voffA); PG8_STAGE(PG8_SB(1, 1), cB + hstepB + kstep, voffB);
    PG8_WAIT_V(6); PG8_BAR;
    for (;;) {
        const bool has_next = S.next(ui + 1, nxt);
        const char* nA = has_next ? nxt.a : cA; const char* nB = has_next ? nxt.b : cB;
        const int nt = cur.nt;
        for (int t = 0; t < nt; t += 2) {
            const bool last = (t == nt - 2);
            const char* a1 = cA + (size_t)(t + 1) * kstep;
            const char* a2 = last ? nA : cA + (size_t)(t + 2) * kstep; const char* b2 = last ? nB : cB + (size_t)(t + 2) * kstep;
            const char* a3 = a2 + kstep; const char* b3 = b2 + kstep;
            PG8_LDB(B0, 0, 0); PG8_LDB(B1, 0, 1); PG8_SCHED; PG8_LDA(At, 0, 0); PG8_STAGE(PG8_SA(1, 1), a1 + hstepA, voffA);
            PG8_WAIT_V(8); PG8_WAIT_L(0); PG8_BAR; PG8_MMA(0, 0, At, B0); PG8_MMA(0, 1, At, B1); PG8_BAR; PG8_SCHED;
            PG8_LDA(At, 0, 1); PG8_STAGE(PG8_SB(0, 0), b2, voffB); PG8_STAGE(PG8_SB(0, 1), b2 + hstepB, voffB); PG8_STAGE(PG8_SA(0, 0), a2, voffA);
            PG8_WAIT_V(8); PG8_WAIT_L(0); PG8_BAR; PG8_MMA(1, 0, At, B0); PG8_MMA(1, 1, At, B1); PG8_BAR; PG8_SCHED;
            PG8_LDB(B0, 1, 0); PG8_LDB(B1, 1, 1); PG8_SCHED; PG8_LDA(At, 1, 0); PG8_STAGE(PG8_SA(0, 1), a2 + hstepA, voffA);
            PG8_WAIT_V(8); PG8_WAIT_L(0); PG8_BAR; PG8_MMA(0, 0, At, B0); PG8_MMA(0, 1, At, B1); PG8_BAR; PG8_SCHED;
            PG8_LDA(At, 1, 1); PG8_STAGE(PG8_SB(1, 0), b3, voffB); PG8_STAGE(PG8_SB(1, 1), b3 + hstepB, voffB); PG8_STAGE(PG8_SA(1, 0), a3, voffA);
            PG8_WAIT_V(8); PG8_WAIT_L(0); PG8_BAR; PG8_MMA(1, 0, At, B0); PG8_MMA(1, 1, At, B1); PG8_BAR; PG8_SCHED;
        }
        if (wr == 0) PG8_BAR;
        E(acc, cur, wr, wc, fr, fq);
        if (!has_next) break;
#pragma unroll
        for (int a = 0; a < 2; ++a)
#pragma unroll
            for (int b = 0; b < 2; ++b)
#pragma unroll
                for (int m = 0; m < 4; ++m)
#pragma unroll
                    for (int n = 0; n < 2; ++n) acc[a][b][m][n] = (f32x4){0.f, 0.f, 0.f, 0.f};
        cur = nxt; cA = nA; cB = nB; ++ui;
        if (wr == 1) PG8_BAR;
    }
    PG8_WAIT_V(0);
    PG8_BAR;
#undef PG8_SA
#undef PG8_SB
#undef PG8_STAGE
#undef PG8_LDA
#undef PG8_LDB
#undef PG8_MMA
#undef PG8_WAIT_V
#undef PG8_WAIT_L
#undef PG8_BAR
#undef PG8_SCHED
}

typedef f32x4 Acc[2][2][4][2];

struct EpiSwiGLU {
    static constexpr bool PERM = true;
    bf16_t* O;
    __device__ __forceinline__ void operator()(const Acc& acc, const Unit& u, int wr, int wc, int fr, int fq) const {
        const int row0 = u.pm * BM + wr * 64 + fr, col0 = u.pn * 128 + wc * 32 + 8 * fq;
#pragma unroll
        for (int ai = 0; ai < 2; ++ai)
#pragma unroll
            for (int m = 0; m < 4; ++m) {
                bf16_t* p = O + (size_t)(row0 + ai * HALF + m * 16) * FF + col0;
                float h[8];
#pragma unroll
                for (int n = 0; n < 2; ++n)
#pragma unroll
                    for (int j = 0; j < 4; ++j) { const float g = acc[ai][0][m][n][j], up = acc[ai][1][m][n][j]; h[n * 4 + j] = g * sigmoidf_(g) * up; }
                u32x4 w; w.x = pk2(h[0], h[1]); w.y = pk2(h[2], h[3]); w.z = pk2(h[4], h[5]); w.w = pk2(h[6], h[7]);
                *(u32x4*)p = w;
            }
    }
};
template <bool LNRES> struct EpiResid {
    static constexpr bool PERM = false;
    const float* res; float* out; float s; const float* st; const float* g; const float* b;
    __device__ __forceinline__ void operator()(const Acc& acc, const Unit& u, int wr, int wc, int fr, int fq) const {
        const int col0 = u.pn * BM + wc * 32 + 4 * fq;
#pragma unroll
        for (int ai = 0; ai < 2; ++ai)
#pragma unroll
            for (int bj = 0; bj < 2; ++bj) {
                f32x4 rv[4][2], gv[2], bv[2]; f32x2_t sv[4];
                const int c = col0 + bj * HALF;
                if (LNRES) {
#pragma unroll
                    for (int n = 0; n < 2; ++n) { gv[n] = *(const f32x4*)(g + c + n * 16); bv[n] = *(const f32x4*)(b + c + n * 16); }
                }
#pragma unroll
                for (int m = 0; m < 4; ++m) { const int row = u.pm * BM + ai * HALF + wr * 64 + m * 16 + fr; const size_t off = (size_t)row * DM + c;
                    if (LNRES) sv[m] = *(const f32x2_t*)(st + 2 * (size_t)row);
#pragma unroll
                    for (int n = 0; n < 2; ++n) rv[m][n] = *(const f32x4*)(res + off + n * 16); }
                asm volatile("" ::: "memory");
#pragma unroll
                for (int m = 0; m < 4; ++m) { const size_t off = (size_t)(u.pm * BM + ai * HALF + wr * 64 + m * 16 + fr) * DM + c;
#pragma unroll
                    for (int n = 0; n < 2; ++n) { f32x4 r = rv[m][n]; if (LNRES) r = (r - sv[m].x) * sv[m].y * gv[n] + bv[n];
                        *(f32x4*)(out + off + n * 16) = r * ALPHA + acc[ai][bj][m][n] * s; } }
                asm volatile("" ::: "memory");
            }
    }
};
struct EpiInProj {
    static constexpr bool PERM = true;
    bf16_t* Z; float* ZG;
    __device__ __forceinline__ void operator()(const Acc& acc, const Unit& u, int wr, int wc, int fr, int fq) const {
        const int row0 = u.pm * BM + wr * 64 + fr;
        if (u.pn < 19) {
            const float sc = (u.pn == 2 || u.pn == 3 || u.pn == 13 || u.pn == 14) ? C2 : 1.f;
            const int col0 = u.pn * BM + wc * 32 + 8 * fq;
#pragma unroll
            for (int ai = 0; ai < 2; ++ai)
#pragma unroll
                for (int m = 0; m < 4; ++m) { bf16_t* p = Z + (size_t)(row0 + ai * HALF + m * 16) * ZLD + col0;
#pragma unroll
                    for (int bj = 0; bj < 2; ++bj) { const f32x4 v0 = acc[ai][bj][m][0] * sc, v1 = acc[ai][bj][m][1] * sc;
                        u32x4 w; w.x = pk2(v0[0], v0[1]); w.y = pk2(v0[2], v0[3]); w.z = pk2(v1[0], v1[1]); w.w = pk2(v1[2], v1[3]);
                        *(u32x4*)(p + bj * HALF) = w; } }
        } else if (wc == 0 && fq < 2) {
#pragma unroll
            for (int ai = 0; ai < 2; ++ai)
#pragma unroll
                for (int m = 0; m < 4; ++m) { float* p = ZG + (size_t)(row0 + ai * HALF + m * 16) * 16 + 8 * fq;
                    *(f32x4*)p = acc[ai][0][m][0]; *(f32x4*)(p + 4) = acc[ai][0][m][1]; }
        }
    }
};
struct EpiPool {
    static constexpr bool PERM = true;
    bf16_t* Y; const float* scale;
    __device__ __forceinline__ void operator()(const Acc& acc, const Unit& u, int wr, int wc, int fr, int fq) const {
        const int row0 = u.pm * BM + wr * 64 + fr, col0 = u.pn * BM + wc * 32 + 8 * fq;
#pragma unroll
        for (int bj = 0; bj < 2; ++bj) {
            const f32x4 s0 = *(const f32x4*)(scale + col0 + bj * HALF), s1 = *(const f32x4*)(scale + col0 + bj * HALF + 4);
#pragma unroll
            for (int ai = 0; ai < 2; ++ai)
#pragma unroll
                for (int m = 0; m < 4; ++m) { bf16_t* p = Y + (size_t)(row0 + ai * HALF + m * 16) * DM + col0 + bj * HALF;
                    const f32x4 v0 = acc[ai][bj][m][0] * s0, v1 = acc[ai][bj][m][1] * s1;
                    u32x4 w; w.x = pk2(v0[0], v0[1]); w.y = pk2(v0[2], v0[3]); w.z = pk2(v1[0], v1[1]); w.w = pk2(v1[2], v1[3]);
                    *(u32x4*)p = w; }
        }
    }
};
struct EpiMerge {
    static constexpr bool PERM = true;
    u32x2* gsc; u32x4* msc; bf16_t* MG;
    __device__ __forceinline__ void operator()(const Acc& acc, const Unit& u, int wr, int wc, int fr, int fq) const {
        const int tid = (wr * 4 + wc) * 64 + fq * 16 + fr;
        u32x2* g = gsc + ((size_t)blockIdx.x * NTHR + tid) * 16;
        u32x4* ms = msc + ((size_t)blockIdx.x * NTHR + tid) * 16;
        const int b = u.kind >> 1;
        if ((u.kind & 1) == 0) {
#pragma unroll
            for (int ai = 0; ai < 2; ++ai)
#pragma unroll
                for (int bj = 0; bj < 2; ++bj)
#pragma unroll
                    for (int m = 0; m < 4; ++m) { const f32x4 a0 = acc[ai][bj][m][0], a1 = acc[ai][bj][m][1];
                        u32x2 w;
                        w.x = (unsigned)(sigmoidf_(a0[0]) * 255.f + 0.5f) | ((unsigned)(sigmoidf_(a0[1]) * 255.f + 0.5f) << 8) | ((unsigned)(sigmoidf_(a0[2]) * 255.f + 0.5f) << 16) | ((unsigned)(sigmoidf_(a0[3]) * 255.f + 0.5f) << 24);
                        w.y = (unsigned)(sigmoidf_(a1[0]) * 255.f + 0.5f) | ((unsigned)(sigmoidf_(a1[1]) * 255.f + 0.5f) << 8) | ((unsigned)(sigmoidf_(a1[2]) * 255.f + 0.5f) << 16) | ((unsigned)(sigmoidf_(a1[3]) * 255.f + 0.5f) << 24);
                        g[(ai * 2 + bj) * 4 + m] = w; }
            asm volatile("" ::: "memory");
        } else {
            const int row0 = u.pm * BM + wr * 64 + fr, col0 = u.pn * BM + wc * 32 + 8 * fq;
            const float k255 = 1.f / 255.f;
#pragma unroll
            for (int ai = 0; ai < 2; ++ai) {
                u32x2 gw[8]; u32x4 pv[8];
#pragma unroll
                for (int sl = 0; sl < 8; ++sl) gw[sl] = g[ai * 8 + sl];
                if (b > 0) {
#pragma unroll
                    for (int sl = 0; sl < 8; ++sl) pv[sl] = ms[ai * 8 + sl];
                }
#pragma unroll
                for (int bj = 0; bj < 2; ++bj)
#pragma unroll
                    for (int m = 0; m < 4; ++m) { const int hs = bj * 4 + m, slot = ai * 8 + hs; const u32x2 w = gw[hs];
                        f32x4 p0 = acc[ai][bj][m][0], p1 = acc[ai][bj][m][1];
                        p0[0] *= (float)(w.x & 255u) * k255; p0[1] *= (float)((w.x >> 8) & 255u) * k255; p0[2] *= (float)((w.x >> 16) & 255u) * k255; p0[3] *= (float)(w.x >> 24) * k255;
                        p1[0] *= (float)(w.y & 255u) * k255; p1[1] *= (float)((w.y >> 8) & 255u) * k255; p1[2] *= (float)((w.y >> 16) & 255u) * k255; p1[3] *= (float)(w.y >> 24) * k255;
                        if (b > 0) { const u32x4 q = pv[hs];
                            p0[0] += bflo(q.x); p0[1] += bfhi(q.x); p0[2] += bflo(q.y); p0[3] += bfhi(q.y); p1[0] += bflo(q.z); p1[1] += bfhi(q.z); p1[2] += bflo(q.w); p1[3] += bfhi(q.w); }
                        u32x4 o; o.x = pk2(p0[0], p0[1]); o.y = pk2(p0[2], p0[3]); o.z = pk2(p1[0], p1[1]); o.w = pk2(p1[2], p1[3]);
                        if (b < 3) ms[slot] = o;
                        else *(u32x4*)(MG + (size_t)(row0 + ai * HALF + m * 16) * DM + col0 + bj * HALF) = o; }
                asm volatile("" ::: "memory");
            }
        }
    }
};
}

struct Params {
    const float* x; const float* ln_g; const float* ln_b; const float* ffn1_w_in; const float* ffn1_w_out; const float* w_in; const float* pool_w; const float* pool_scale;
    const float* swa_sinks; const float* mlstm_conv; const float* mlstm_i_bias; const float* mlstm_f_bias; const float* fox_f_bias; const float* w_branch; const float* w_gate;
    const float* w_out; const float* ffn2_w_in; const float* ffn2_w_out; float* out; unsigned char* ws;
};

__device__ __forceinline__ int maprow(int kind, int n) {
    if (kind == 1) { const int type = n >= FF ? 1 : 0; const int j = n - type * FF; return (j >> 7) * 256 + type * 128 + (j & 127); }
    if (kind == 2) { if (n < 3328) return n; if (n < 3336) return 4864 + (n - 3328); if (n < 4872) return n - 8; return n; }
    return n;
}
__device__ __forceinline__ void tr_item(const float* W, int ldw, int ncols, int nblk, int item, bf16_t* dst, int dpitch, int dcol0, int mapkind, LAS float* scr, int lane) {
    const int kb = item / nblk, nb = item % nblk, k0 = 64 * kb, n0 = 32 * nb;
    const int nsrc = n0 + (lane & 31);
    float wv[32];
#pragma unroll
    for (int i = 0; i < 32; ++i) { const int kk = 2 * i + (lane >> 5); wv[i] = (nsrc < ncols) ? W[(size_t)(k0 + kk) * ldw + nsrc] : 0.f; }
#pragma unroll
    for (int i = 0; i < 32; ++i) { const int kk = 2 * i + (lane >> 5); scr[kk * 33 + (lane & 31)] = wv[i]; }
    asm volatile("s_waitcnt lgkmcnt(0)" ::: "memory");
    const int c = lane & 7;
#pragma unroll
    for (int j = 0; j < 4; ++j) { const int nn = (lane >> 3) + 8 * j; const int n = n0 + nn; const LAS float* s = scr + (8 * c) * 33 + nn;
        u32x4 o; o.x = pk2(s[0 * 33], s[1 * 33]); o.y = pk2(s[2 * 33], s[3 * 33]); o.z = pk2(s[4 * 33], s[5 * 33]); o.w = pk2(s[6 * 33], s[7 * 33]);
        if (n < ncols) *(u32x4*)(dst + (size_t)maprow(mapkind, n) * dpitch + dcol0 + k0 + 8 * c) = o; }
    asm volatile("s_waitcnt lgkmcnt(0)" ::: "memory");
}

__device__ __forceinline__ void phase_weights(const Params& p, int l, LAS unsigned char* lds, int wave_, int lane_, int G) {
    const int lane = lane_id(), wave = launder_s(wave_); (void)lane_;
    unsigned char* ws = launder_p(p.ws);
    LAS float* scr = (LAS float*)(lds + wave * 8448);
    const int gw = blockIdx.x * NWAVES + wave, NGW = G * NWAVES;
    const float* f1a = p.ffn1_w_in + (size_t)l * DM * 2 * FF; const float* f1b = p.ffn1_w_out + (size_t)l * FF * DM;
    const float* f2a = p.ffn2_w_in + (size_t)l * DM * 2 * FF; const float* f2b = p.ffn2_w_out + (size_t)l * FF * DM;
    const float* win = p.w_in + (size_t)l * DM * 4880; const float* wg = p.w_gate + (size_t)l * 4 * DM * DM; const float* wb = p.w_branch + (size_t)l * 4 * 512 * DM;
    const float* wo = p.w_out + (size_t)l * DM * DM; const float* pw = p.pool_w + (size_t)l * 4 * 128 * 128;
    constexpr int I_FA = 32 * 352, I_FB = 88 * 64, I_IN = 32 * 153, I_G = 4 * 32 * 64, I_B = 4 * 8 * 64, I_O = 32 * 64, I_P = 4 * 2 * 4;
    constexpr int NITEMS = 2 * I_FA + 2 * I_FB + I_IN + I_G + I_B + I_O + I_P;
    for (int it = gw; it < NITEMS; it += NGW) {
        int r = it;
        if (r < I_FA) { tr_item(f1a, 2 * FF, 2 * FF, 352, r, (bf16_t*)(ws + OW_F1A), DM, 0, 1, scr, lane); continue; } r -= I_FA;
        if (r < I_FA) { tr_item(f2a, 2 * FF, 2 * FF, 352, r, (bf16_t*)(ws + OW_F2A), DM, 0, 1, scr, lane); continue; } r -= I_FA;
        if (r < I_FB) { tr_item(f1b, DM, DM, 64, r, (bf16_t*)(ws + OW_F1B), FF, 0, 0, scr, lane); continue; } r -= I_FB;
        if (r < I_FB) { tr_item(f2b, DM, DM, 64, r, (bf16_t*)(ws + OW_F2B), FF, 0, 0, scr, lane); continue; } r -= I_FB;
        if (r < I_IN) { tr_item(win, 4880, 4880, 153, r, (bf16_t*)(ws + OW_IN), DM, 0, 2, scr, lane); continue; } r -= I_IN;
        if (r < I_G) { const int b = r / 2048, rr = r % 2048; tr_item(wg + (size_t)b * DM * DM, DM, DM, 64, rr, (bf16_t*)(ws + OW_G) + (size_t)b * DM * DM, DM, 0, 0, scr, lane); continue; } r -= I_G;
        if (r < I_B) { const int b = r / 512, rr = r % 512; tr_item(wb + (size_t)b * 512 * DM, DM, DM, 64, rr, (bf16_t*)(ws + OW_BC), DM, b * 512, 0, scr, lane); continue; } r -= I_B;
        if (r < I_O) { tr_item(wo, DM, DM, 64, r, (bf16_t*)(ws + OW_O), DM, 0, 0, scr, lane); continue; } r -= I_O;
        { const int g = r / 8, rr = r % 8; tr_item(pw + (size_t)g * 128 * 128, 128, 128, 4, rr, (bf16_t*)(ws + OW_BD) + (size_t)g * 128 * 512, 512, g * 128, 0, scr, lane); }
    }
    const int gt = blockIdx.x * NTHR + wave * 64 + lane, NGT = G * NTHR;
    const unsigned z0 = (unsigned)launder_v(0); const u32x4 zz = {z0, z0, z0, z0};
    { u32x4* zr = (u32x4*)((bf16_t*)(ws + OW_IN) + (size_t)4880 * DM); for (int i = gt; i < 240 * DM / 8; i += NGT) zr[i] = zz; }
    { u32x4* bd = (u32x4*)(ws + OW_BD); for (int i = gt; i < 512 * 512 / 8; i += NGT) { const int n = i / 64, k = (i % 64) * 8; if ((n >> 7) != (k >> 7)) bd[i] = zz; } }
    if (l == 0) {
        const f32x4* xs = (const f32x4*)p.x; u32x2* hb = (u32x2*)(ws + O_HB);
        for (int i = gt; i < S * DM / 4; i += NGT) { const f32x4 v = xs[i]; u32x2 w; w.x = pk2(v[0], v[1]); w.y = pk2(v[2], v[3]); hb[i] = w; }
    }
}

__device__ __forceinline__ float wave_sum(float v) {
#pragma unroll
    for (int o = 1; o < 64; o <<= 1) v += __shfl_xor(v, o);
    return v;
}
__device__ __forceinline__ void phase_ln(const float* Yin, float* Hout, bf16_t* hb, float* stats, const float* g, const float* b, int wave_, int lane_, int G) {
    const int lane = lane_id(), wave = launder_s(wave_); (void)lane_;
    const int gw = blockIdx.x * NWAVES + wave, NGW = G * NWAVES;
    for (int row = gw; row < S; row += 2 * NGW) {
        const int rowb = row + NGW;
        const f32x4* xa = (const f32x4*)(Yin + (size_t)row * DM) + lane; const f32x4* xb = (const f32x4*)(Yin + (size_t)rowb * DM) + lane;
        f32x4 va[8], vb[8]; float sa = 0.f, sb = 0.f;
#pragma unroll
        for (int j = 0; j < 8; ++j) { va[j] = xa[64 * j]; vb[j] = xb[64 * j]; }
#pragma unroll
        for (int j = 0; j < 8; ++j) { sa += (va[j][0] + va[j][1]) + (va[j][2] + va[j][3]); sb += (vb[j][0] + vb[j][1]) + (vb[j][2] + vb[j][3]); }
        const float ma = wave_sum(sa) * (1.f / DM), mb = wave_sum(sb) * (1.f / DM); float qa = 0.f, qb = 0.f;
#pragma unroll
        for (int j = 0; j < 8; ++j) { va[j] = va[j] - ma; vb[j] = vb[j] - mb;
            qa += (va[j][0] * va[j][0] + va[j][1] * va[j][1]) + (va[j][2] * va[j][2] + va[j][3] * va[j][3]);
            qb += (vb[j][0] * vb[j][0] + vb[j][1] * vb[j][1]) + (vb[j][2] * vb[j][2] + vb[j][3] * vb[j][3]); }
        const float ra = 1.f / sqrtf(wave_sum(qa) * (1.f / DM) + LN_EPS), rb = 1.f / sqrtf(wave_sum(qb) * (1.f / DM) + LN_EPS);
        if (stats && lane == 0) { stats[2 * (size_t)row] = ma; stats[2 * (size_t)row + 1] = ra; stats[2 * (size_t)rowb] = mb; stats[2 * (size_t)rowb + 1] = rb; }
        f32x4* ha = (f32x4*)(Hout + (size_t)row * DM) + lane; f32x4* hbp = (f32x4*)(Hout + (size_t)rowb * DM) + lane;
        u32x2* ba = (u32x2*)(hb + (size_t)row * DM) + lane; u32x2* bb = (u32x2*)(hb + (size_t)rowb * DM) + lane;
#pragma unroll
        for (int j = 0; j < 8; ++j) { const f32x4 gg = ((const f32x4*)g)[64 * j + lane], bbv = ((const f32x4*)b)[64 * j + lane];
            const f32x4 oa = va[j] * ra * gg + bbv, ob = vb[j] * rb * gg + bbv;
            if (Hout) { ha[64 * j] = oa; hbp[64 * j] = ob; }
            if (hb) { u32x2 w; w.x = pk2(oa[0], oa[1]); w.y = pk2(oa[2], oa[3]); ba[64 * j] = w; w.x = pk2(ob[0], ob[1]); w.y = pk2(ob[2], ob[3]); bb[64 * j] = w; } }
    }
}

__device__ __forceinline__ float scan_sum(float x, int lane) {
#pragma unroll
    for (int o = 1; o < 64; o <<= 1) { const float y = __shfl_up(x, o); if (lane >= o) x += y; }
    return x;
}
__device__ __forceinline__ float scan_max(float x, int lane) {
#pragma unroll
    for (int o = 1; o < 64; o <<= 1) { const float y = __shfl_up(x, o); if (lane >= o) x = fmaxf(x, y); }
    return x;
}
__device__ __forceinline__ void phase_post(const Params& p, int l, LAS unsigned char* lds, int wave_, int lane_, int G) {
    const int lane = lane_id(), wave = launder_s(wave_); (void)lane_;
    unsigned char* ws = launder_p(p.ws);
    bf16_t* Z = (bf16_t*)(ws + O_R1); const float* ZG = (const float*)(ws + O_ZG);
    LAS float* eL = (LAS float*)(lds + LDS_MISC);
    const int tid = wave * 64 + lane;
    LAS float* invL = (LAS float*)(lds + LDS_MISC + 1024);
    if (tid < 32) invL[tid] = exp2f(-(float)tid * 0.41524101186092029f);
    for (int c = blockIdx.x; c < S / 64; c += G) {
        const int t0 = c * 64;
        {
            const int t = t0 + lane;
            if (wave < 4) {
                const int h = wave;
                const float ip = ZG[(size_t)t * 16 + h] + p.mlstm_i_bias[l * 4 + h];
                const float lf = logsigmoidf_(ZG[(size_t)t * 16 + 4 + h] + p.mlstm_f_bias[l * 4 + h]);
                const float b = scan_sum(lf, lane);
                const float d = ip - b;
                const float a = scan_max(d, lane);
                const float dmax = __shfl(a, 63), bl = __shfl(b, 63);
                ((float*)(ws + O_MLA))[h * S + t] = a; ((float*)(ws + O_MLB))[h * S + t] = b; ((float*)(ws + O_MLD))[h * S + t] = d;
                eL[h * 64 + lane] = __expf(d - dmax);
                if (lane == 63) { ((float*)(ws + O_BLC))[c * 4 + h] = bl; ((float*)(ws + O_DMC))[c * 4 + h] = dmax; }
            }
            {
                const int h = wave;
                const float lf = logsigmoidf_(ZG[(size_t)t * 16 + 8 + h] + p.fox_f_bias[l * 8 + h]);
                const float cl = scan_sum(lf, lane) * LOG2E;
                ((float*)(ws + O_CL2))[h * S + t] = cl;
                if (lane == 63) ((float*)(ws + O_TOT2))[c * 8 + h] = cl;
            }
        }
        __syncthreads();
        for (int idx = tid; idx < 64 * 40; idx += NTHR) {
            const int tl = idx / 40, rem = idx % 40, hh = rem >> 2, i0 = (rem & 3) * 8, t = t0 + tl;
            bf16_t* px = Z + (size_t)t * ZLD + (hh < 8 ? ZC_QSWA + hh * 64 : ZC_KSWA + (hh - 8) * 64) + i0;
            const u32x4 a = *(const u32x4*)px, b = *(const u32x4*)(px + 32);
            float x1[8] = {bflo(a.x), bfhi(a.x), bflo(a.y), bfhi(a.y), bflo(a.z), bfhi(a.z), bflo(a.w), bfhi(a.w)};
            float x2[8] = {bflo(b.x), bfhi(b.x), bflo(b.y), bfhi(b.y), bflo(b.z), bfhi(b.z), bflo(b.w), bfhi(b.w)};
            float y1[8], y2[8];
#pragma unroll
            for (int j = 0; j < 8; ++j) {
                const float ang = (float)t * invL[i0 + j];
                double rev = (double)ang * 0.15915494309189535; rev -= rint(rev);
                const float rr = (float)(rev * 6.283185307179586);
                const float cs = __cosf(rr), sn = __sinf(rr);
                y1[j] = x1[j] * cs - x2[j] * sn; y2[j] = x2[j] * cs + x1[j] * sn;
            }
            u32x4 o1, o2;
            o1.x = pk2(y1[0], y1[1]); o1.y = pk2(y1[2], y1[3]); o1.z = pk2(y1[4], y1[5]); o1.w = pk2(y1[6], y1[7]);
            o2.x = pk2(y2[0], y2[1]); o2.y = pk2(y2[2], y2[3]); o2.z = pk2(y2[4], y2[5]); o2.w = pk2(y2[6], y2[7]);
            *(u32x4*)px = o1; *(u32x4*)(px + 32) = o2;
        }
        for (int idx = tid; idx < 128 + 512 + 512; idx += NTHR) {
            int col, h = 0; bf16_t* dst; bf16_t* dst2 = nullptr;
            if (idx < 128) { col = ZC_VSWA + idx; dst = (bf16_t*)(ws + O_VTS) + (size_t)idx * S; }
            else if (idx < 640) { const int cc = idx - 128; col = ZC_VFOX + cc; dst = (bf16_t*)(ws + O_VTF) + (size_t)cc * S; }
            else { const int cc = idx - 640; col = ZC_VML + cc; dst = (bf16_t*)(ws + O_VTM) + (size_t)cc * S; dst2 = (bf16_t*)(ws + O_VTW) + (size_t)cc * S; h = cc >> 7; }
            const bf16_t* __restrict__ src = launder_pv(Z + (size_t)t0 * ZLD + col);
            unsigned short v[64];
#pragma unroll
            for (int j = 0; j < 64; ++j) { v[j] = *src; src += ZLD; }
#pragma unroll
            for (int g8 = 0; g8 < 8; ++g8) { u32x4 w;
                w.x = (unsigned)v[8 * g8] | ((unsigned)v[8 * g8 + 1] << 16); w.y = (unsigned)v[8 * g8 + 2] | ((unsigned)v[8 * g8 + 3] << 16);
                w.z = (unsigned)v[8 * g8 + 4] | ((unsigned)v[8 * g8 + 5] << 16); w.w = (unsigned)v[8 * g8 + 6] | ((unsigned)v[8 * g8 + 7] << 16);
                *(u32x4*)(dst + t0 + 8 * g8) = w; }
            if (dst2) {
                const LAS float* e = eL + h * 64;
#pragma unroll
                for (int g8 = 0; g8 < 8; ++g8) { u32x4 w;
                    w.x = pk2(bf2f(v[8 * g8]) * e[8 * g8], bf2f(v[8 * g8 + 1]) * e[8 * g8 + 1]); w.y = pk2(bf2f(v[8 * g8 + 2]) * e[8 * g8 + 2], bf2f(v[8 * g8 + 3]) * e[8 * g8 + 3]);
                    w.z = pk2(bf2f(v[8 * g8 + 4]) * e[8 * g8 + 4], bf2f(v[8 * g8 + 5]) * e[8 * g8 + 5]); w.w = pk2(bf2f(v[8 * g8 + 6]) * e[8 * g8 + 6], bf2f(v[8 * g8 + 7]) * e[8 * g8 + 7]);
                    *(u32x4*)(dst2 + t0 + 8 * g8) = w; }
            }
        }
        for (int cc = tid; cc < 1024; cc += NTHR) {
            const float* cw = p.mlstm_conv + (size_t)l * 4 * 1024 + cc;
            const float w0 = cw[0], w1 = cw[1024], w2 = cw[2048], w3 = cw[3072];
            const bf16_t* __restrict__ src = launder_pv(Z + (size_t)(t0 >= 3 ? t0 - 3 : 0) * ZLD + ZC_QML + cc);
            unsigned short xv[67];
#pragma unroll
            for (int j = 0; j < 67; ++j) { const int tt = t0 - 3 + j; if (tt >= 0) { xv[j] = *src; src += ZLD; } else xv[j] = (unsigned short)0; }
            const float qs = cc < 512 ? 0.08838834764831845f : 1.f;
            bf16_t* dq = (bf16_t*)(ws + O_QKC) + (size_t)t0 * 1024 + cc;
            const int kc = cc - 512, h = (kc >= 0) ? (kc >> 7) : 0; const LAS float* e = eL + h * 64; float su = 0.f;
#pragma unroll
            for (int g8 = 0; g8 < 8; ++g8) {
                unsigned short ob[8];
#pragma unroll
                for (int j = 0; j < 8; ++j) { const int t = 8 * g8 + j;
                    const float y = w0 * bf2f(xv[t]) + w1 * bf2f(xv[t + 1]) + w2 * bf2f(xv[t + 2]) + w3 * bf2f(xv[t + 3]);
                    ob[j] = f2bf(y * sigmoidf_(y) * qs); dq[(size_t)t * 1024] = ob[j]; }
                if (cc >= 512) {
                    u32x4 w; w.x = (unsigned)ob[0] | ((unsigned)ob[1] << 16); w.y = (unsigned)ob[2] | ((unsigned)ob[3] << 16); w.z = (unsigned)ob[4] | ((unsigned)ob[5] << 16); w.w = (unsigned)ob[6] | ((unsigned)ob[7] << 16);
                    *(u32x4*)((bf16_t*)(ws + O_KTM) + (size_t)kc * S + t0 + 8 * g8) = w;
#pragma unroll
                    for (int j = 0; j < 8; ++j) su += e[8 * g8 + j] * bf2f(ob[j]);
                }
            }
            if (cc >= 512) ((float*)(ws + O_UN))[(size_t)c * 512 + kc] = su;
        }
        for (int cc = tid; cc < 512; cc += NTHR) {
            const int g = cc >> 7, win = 2 << g;
            const bf16_t* __restrict__ src = launder_pv(Z + (size_t)(t0 >= 15 ? t0 - 15 : 0) * ZLD + cc);
            unsigned short xv[79];
#pragma unroll
            for (int j = 0; j < 79; ++j) { const int tt = t0 - 15 + j; if (tt >= 0) { xv[j] = (j >= 16 - win) ? *src : (unsigned short)0; src += ZLD; } else xv[j] = (unsigned short)0; }
            float sacc = 0.f;
#pragma unroll
            for (int j = 0; j < 15; ++j) sacc += bf2f(xv[j]);
            bf16_t* dp = (bf16_t*)(ws + O_POOL) + (size_t)t0 * 512 + cc;
#pragma unroll
            for (int j = 0; j < 64; ++j) { const int t = t0 + j; const float x0 = bf2f(xv[15 + j]); sacc += x0;
                const int cnt = (t + 1) < win ? (t + 1) : win; dp[(size_t)j * 512] = f2bf(sacc / (float)cnt - x0);
                const float lv = (g == 0) ? bf2f(xv[15 + j - 1]) : (g == 1) ? bf2f(xv[15 + j - 3]) : (g == 2) ? bf2f(xv[15 + j - 7]) : bf2f(xv[15 + j - 15]);
                sacc -= lv; }
        }
        __syncthreads();
    }
}

#define MFMA32(a, b, c) __builtin_amdgcn_mfma_f32_32x32x16_bf16((a), (b), (c), 0, 0, 0)
template <bool FOX>
__device__ __forceinline__ void attn_unit(int h, int qb, const bf16_t* Z, const bf16_t* Vt, const float* cl2, const LAS float* P2L, float sink2, bf16_t* ybr, int lane) {
    const int q = lane & 31, hi = lane >> 5, t0 = qb * 32, t = t0 + q;
    const int qcol = FOX ? (ZC_QFOX + h * 64) : (ZC_QSWA + h * 64);
    const int kcol = FOX ? (ZC_KFOX + h * 64) : (ZC_KSWA + (h >> 2) * 64);
    const int ocol = FOX ? (1536 + h * 64) : (512 + h * 64);
    const bf16_t* Vth = Vt + (size_t)((FOX ? h : (h >> 2)) * 64 + q) * S + 16 * hi;
    const int pim = 16 * ((q >> 2) & 1) + 4 * (q >> 3) + (q & 3);
    const bf16_t* Kp = Z + (size_t)pim * ZLD + kcol + 8 * hi;
    const float* clh = cl2 + (size_t)h * S + 16 * hi;
    bf16x8 qf[4];
#pragma unroll
    for (int d0 = 0; d0 < 4; ++d0) qf[d0] = *(const bf16x8*)(Z + (size_t)t * ZLD + qcol + 16 * d0 + 8 * hi);
    const int kv_lo = FOX ? 0 : (t0 >= 128 ? t0 - 128 : 0);
    const int ntiles = (t0 - kv_lo) / 32 + 1;
    float mhat = FOX ? 0.f : sink2, l = FOX ? 0.f : (hi == 0 ? 1.f : 0.f);
    float cq = 0.f; if (FOX) cq = cl2[(size_t)h * S + t] + P2L[(t >> 6) * 8 + h];
    f32x16 o0, o1;
#pragma unroll
    for (int r = 0; r < 16; ++r) { o0[r] = 0.f; o1[r] = 0.f; }
    bf16x8 kf[4], vf[4]; f32x4 ck[4];
    {
        const int kv0 = kv_lo;
#pragma unroll
        for (int d0 = 0; d0 < 4; ++d0) kf[d0] = *(const bf16x8*)(Kp + (size_t)kv0 * ZLD + 16 * d0);
#pragma unroll
        for (int i = 0; i < 4; ++i) vf[i] = *(const bf16x8*)(Vth + (size_t)(i >> 1) * 32 * S + kv0 + 8 * (i & 1));
        if (FOX) {
#pragma unroll
            for (int i = 0; i < 4; ++i) ck[i] = *(const f32x4*)(clh + kv0 + 4 * i);
        }
    }
    for (int it = 0; it < ntiles; ++it) {
        const int kv0 = kv_lo + 32 * it;
        const int itn = (it + 1 < ntiles) ? it + 1 : it; const int kvn = kv_lo + 32 * itn;
        bf16x8 kfn[4], vfn[4]; f32x4 ckn[4];
#pragma unroll
        for (int d0 = 0; d0 < 4; ++d0) kfn[d0] = *(const bf16x8*)(Kp + (size_t)kvn * ZLD + 16 * d0);
#pragma unroll
        for (int i = 0; i < 4; ++i) vfn[i] = *(const bf16x8*)(Vth + (size_t)(i >> 1) * 32 * S + kvn + 8 * (i & 1));
        if (FOX) {
#pragma unroll
            for (int i = 0; i < 4; ++i) ckn[i] = *(const f32x4*)(clh + kvn + 4 * i);
        }
        f32x16 acc;
        if (FOX) {
            const float base = (cq - P2L[(kv0 >> 6) * 8 + h]) - mhat;
#pragma unroll
            for (int r = 0; r < 16; ++r) acc[r] = base - ck[r >> 2][r & 3];
        } else {
#pragma unroll
            for (int r = 0; r < 16; ++r) acc[r] = -mhat;
        }
#pragma unroll
        for (int d0 = 0; d0 < 4; ++d0) acc = MFMA32(kf[d0], qf[d0], acc);
        if (FOX) {
            if (it == ntiles - 1) {
#pragma unroll
                for (int r = 0; r < 16; ++r) if (16 * hi + r > q) acc[r] = -INFINITY;
            }
        } else {
#pragma unroll
            for (int r = 0; r < 16; ++r) { const int kv = kv0 + 16 * hi + r; if (kv > t || kv + 127 < t) acc[r] = -INFINITY; }
        }
        float mt = acc[0];
#pragma unroll
        for (int r = 1; r < 16; ++r) mt = fmaxf(mt, acc[r]);
        mt = fmaxf(mt, __shfl_xor(mt, 32));
        const bool first = FOX && (it == 0);
        if (first || __any(mt > 8.f)) {
            const float delta = first ? mt : fmaxf(mt, 0.f);
            mhat += delta;
            const float al = first ? 1.f : __builtin_amdgcn_exp2f(-delta);
            l *= al;
#pragma unroll
            for (int r = 0; r < 16; ++r) { acc[r] -= delta; o0[r] *= al; o1[r] *= al; }
        }
        float ps = 0.f;
#pragma unroll
        for (int r = 0; r < 16; ++r) { acc[r] = __builtin_amdgcn_exp2f(acc[r]); ps += acc[r]; }
        l += ps;
        u32x4 w0, w1;
        w0.x = pk2(acc[0], acc[1]); w0.y = pk2(acc[2], acc[3]); w0.z = pk2(acc[4], acc[5]); w0.w = pk2(acc[6], acc[7]);
        w1.x = pk2(acc[8], acc[9]); w1.y = pk2(acc[10], acc[11]); w1.z = pk2(acc[12], acc[13]); w1.w = pk2(acc[14], acc[15]);
        const bf16x8 pb0 = __builtin_bit_cast(bf16x8, w0), pb1 = __builtin_bit_cast(bf16x8, w1);
        o0 = MFMA32(vf[0], pb0, o0); o0 = MFMA32(vf[1], pb1, o0);
        o1 = MFMA32(vf[2], pb0, o1); o1 = MFMA32(vf[3], pb1, o1);
#pragma unroll
        for (int i = 0; i < 4; ++i) { kf[i] = kfn[i]; vf[i] = vfn[i]; if (FOX) ck[i] = ckn[i]; }
    }
    l += __shfl_xor(l, 32);
    const float inv = 1.f / l;
    bf16_t* op = ybr + (size_t)t * DM + ocol + 4 * hi;
#pragma unroll
    for (int g = 0; g < 4; ++g) {
        u32x2 w; w.x = pk2(o0[4 * g] * inv, o0[4 * g + 1] * inv); w.y = pk2(o0[4 * g + 2] * inv, o0[4 * g + 3] * inv); *(u32x2*)(op + 8 * g) = w;
        w.x = pk2(o1[4 * g] * inv, o1[4 * g + 1] * inv); w.y = pk2(o1[4 * g + 2] * inv, o1[4 * g + 3] * inv); *(u32x2*)(op + 32 + 8 * g) = w;
    }
}


__device__ __forceinline__ void fox_unit(int h, int Q, const bf16_t* Z, const bf16_t* Vt, const LAS float* clL, const LAS float* P2L, bf16_t* ybr, LAS unsigned char* lds, int wave, int lane) {
    const int q = lane & 31, hi = lane >> 5, t = Q * 256 + wave * 32 + q;
    const int kx = (q >> 1) & 7;
    const int my_last = 4 * Q + (wave >> 1), ntile = 4 * Q + 4;
    const int P = wave * 64 + lane, lrow = P >> 3, piece = (P & 7) ^ ((lrow >> 1) & 7);
    const int lr = lrow & 31, grow = 32 * (lrow >> 5) + 16 * ((lr >> 2) & 1) + 4 * (lr >> 3) + (lr & 3);
    const bf16_t* ksrc = Z + (size_t)grow * ZLD + ZC_KFOX + h * 64 + piece * 8;
    const bf16_t* vsrc = Vt + (size_t)(h * 64 + lrow) * S + piece * 8;
    const LAS float* clh = clL + 16 * hi;
    bf16x8 qf[4];
#pragma unroll
    for (int d0 = 0; d0 < 4; ++d0) qf[d0] = *(const bf16x8*)(Z + (size_t)t * ZLD + ZC_QFOX + h * 64 + 16 * d0 + 8 * hi);
    const float cq = clL[t] + P2L[(t >> 6) * 8 + h];
    float mhat = 0.f;
    f32x16 o0, o1, lacc;
#pragma unroll
    for (int r = 0; r < 16; ++r) { o0[r] = 0.f; o1[r] = 0.f; lacc[r] = 0.f; }
    const short one_ = (q == 0) ? (short)0x3F80 : (short)0;
    const bf16x8 ones = {one_, one_, one_, one_, one_, one_, one_, one_};
    asm volatile("s_waitcnt vmcnt(0)" ::: "memory");
    asm volatile("" : "+v"(qf[0]), "+v"(qf[1]), "+v"(qf[2]), "+v"(qf[3]));
    __builtin_amdgcn_global_load_lds((const unsigned*)ksrc, (LAS unsigned*)(lds + wave * 1024), 16, 0, 0);
    __builtin_amdgcn_global_load_lds((const unsigned*)vsrc, (LAS unsigned*)(lds + 8192 + wave * 1024), 16, 0, 0);
    __builtin_amdgcn_global_load_lds((const unsigned*)(ksrc + (size_t)64 * ZLD), (LAS unsigned*)(lds + 16384 + wave * 1024), 16, 0, 0);
    __builtin_amdgcn_global_load_lds((const unsigned*)(vsrc + 64), (LAS unsigned*)(lds + 16384 + 8192 + wave * 1024), 16, 0, 0);
    const int koff = q * 128, voff = 8192 + q * 128;
    int s_cur = 0, s_nxt2 = 2 * 16384;
    for (int i = 0; i < ntile; ++i) {
        if (i + 1 < ntile) asm volatile("s_waitcnt vmcnt(2) lgkmcnt(0)\n\ts_barrier" ::: "memory");
        else asm volatile("s_waitcnt vmcnt(0) lgkmcnt(0)\n\ts_barrier" ::: "memory");
        if (i + 2 < ntile) {
            const int kvn = 64 * (i + 2);
            LAS unsigned char* dst = lds + s_nxt2 + wave * 1024;
            __builtin_amdgcn_global_load_lds((const unsigned*)(ksrc + (size_t)kvn * ZLD), (LAS unsigned*)dst, 16, 0, 0);
            __builtin_amdgcn_global_load_lds((const unsigned*)(vsrc + kvn), (LAS unsigned*)(dst + 8192), 16, 0, 0);
        }
        const bool active = (i <= my_last);
        f32x16 a0, a1;
        if (active) {
            const float base = (cq - P2L[i * 8 + h]) - mhat;
            const LAS float* cp = clh + 64 * i;
#pragma unroll
            for (int j = 0; j < 4; ++j) { const f32x4 c0 = *(const LAS f32x4*)(cp + 4 * j), c1 = *(const LAS f32x4*)(cp + 32 + 4 * j);
#pragma unroll
                for (int e = 0; e < 4; ++e) { a0[4 * j + e] = base - c0[e]; a1[4 * j + e] = base - c1[e]; } }
        }
        if (active) {
            const LAS unsigned char* sl = lds + s_cur;
            bf16x8 kfa[4], kfb[4];
#pragma unroll
            for (int d0 = 0; d0 < 4; ++d0) { const int so = ((2 * d0 + hi) ^ kx) * 16; kfa[d0] = *(const LAS bf16x8*)(sl + koff + so); kfb[d0] = *(const LAS bf16x8*)(sl + 4096 + koff + so); }
#pragma unroll
            for (int d0 = 0; d0 < 4; ++d0) { a0 = MFMA32(kfa[d0], qf[d0], a0); a1 = MFMA32(kfb[d0], qf[d0], a1); }
            if (i == my_last) {
#pragma unroll
                for (int r = 0; r < 16; ++r) { const int kv = 64 * i + 16 * hi + r; if (kv > t) a0[r] = -INFINITY; if (kv + 32 > t) a1[r] = -INFINITY; }
            }
            float mt = fmaxf(a0[0], a1[0]);
#pragma unroll
            for (int r = 1; r < 16; ++r) mt = fmaxf(mt, fmaxf(a0[r], a1[r]));
            mt = fmaxf(mt, __shfl_xor(mt, 32));
            const bool first = (i == 0);
            if (first || __any(mt > 30.f)) {
                const float delta = first ? mt : (mt > 0.f ? mt + 30.f : 0.f);
                mhat += delta;
                const float al = first ? 1.f : __builtin_amdgcn_exp2f(-delta);
                lacc[0] *= al;
#pragma unroll
                for (int r = 0; r < 16; ++r) { a0[r] -= delta; a1[r] -= delta; o0[r] *= al; o1[r] *= al; }
            }
#pragma unroll
            for (int r = 0; r < 16; ++r) { a0[r] = __builtin_amdgcn_exp2f(a0[r]); a1[r] = __builtin_amdgcn_exp2f(a1[r]); }
            u32x4 w0, w1, w2, w3;
            w0.x = pk2(a0[0], a0[1]); w0.y = pk2(a0[2], a0[3]); w0.z = pk2(a0[4], a0[5]); w0.w = pk2(a0[6], a0[7]);
            w1.x = pk2(a0[8], a0[9]); w1.y = pk2(a0[10], a0[11]); w1.z = pk2(a0[12], a0[13]); w1.w = pk2(a0[14], a0[15]);
            w2.x = pk2(a1[0], a1[1]); w2.y = pk2(a1[2], a1[3]); w2.z = pk2(a1[4], a1[5]); w2.w = pk2(a1[6], a1[7]);
            w3.x = pk2(a1[8], a1[9]); w3.y = pk2(a1[10], a1[11]); w3.z = pk2(a1[12], a1[13]); w3.w = pk2(a1[14], a1[15]);
            const bf16x8 pb0 = __builtin_bit_cast(bf16x8, w0), pb1 = __builtin_bit_cast(bf16x8, w1), pb2 = __builtin_bit_cast(bf16x8, w2), pb3 = __builtin_bit_cast(bf16x8, w3);
            const int v00 = ((2 * hi) ^ kx) * 16, v01 = ((2 * hi + 1) ^ kx) * 16, v10 = ((4 + 2 * hi) ^ kx) * 16, v11 = ((5 + 2 * hi) ^ kx) * 16;
            const bf16x8 va0 = *(const LAS bf16x8*)(sl + voff + v00), vb0 = *(const LAS bf16x8*)(sl + voff + 4096 + v00), va1 = *(const LAS bf16x8*)(sl + voff + v01), vb1 = *(const LAS bf16x8*)(sl + voff + 4096 + v01);
            const bf16x8 va2 = *(const LAS bf16x8*)(sl + voff + v10), vb2 = *(const LAS bf16x8*)(sl + voff + 4096 + v10), va3 = *(const LAS bf16x8*)(sl + voff + v11), vb3 = *(const LAS bf16x8*)(sl + voff + 4096 + v11);
            o0 = MFMA32(va0, pb0, o0); o1 = MFMA32(vb0, pb0, o1); lacc = MFMA32(ones, pb0, lacc);
            o0 = MFMA32(va1, pb1, o0); o1 = MFMA32(vb1, pb1, o1); lacc = MFMA32(ones, pb1, lacc);
            o0 = MFMA32(va2, pb2, o0); o1 = MFMA32(vb2, pb2, o1); lacc = MFMA32(ones, pb2, lacc);
            o0 = MFMA32(va3, pb3, o0); o1 = MFMA32(vb3, pb3, o1); lacc = MFMA32(ones, pb3, lacc);
        }
        s_cur = (s_cur == 2 * 16384) ? 0 : s_cur + 16384; s_nxt2 = (s_nxt2 == 2 * 16384) ? 0 : s_nxt2 + 16384;
    }
    float l = (hi == 0) ? lacc[0] : 0.f;
    l += __shfl_xor(l, 32);
    const float inv = 1.f / l;
    bf16_t* op = ybr + (size_t)t * DM + 1536 + h * 64 + 4 * hi;
#pragma unroll
    for (int g = 0; g < 4; ++g) {
        u32x2 w; w.x = pk2(o0[4 * g] * inv, o0[4 * g + 1] * inv); w.y = pk2(o0[4 * g + 2] * inv, o0[4 * g + 3] * inv); *(u32x2*)(op + 8 * g) = w;
        w.x = pk2(o1[4 * g] * inv, o1[4 * g + 1] * inv); w.y = pk2(o1[4 * g + 2] * inv, o1[4 * g + 3] * inv); *(u32x2*)(op + 32 + 8 * g) = w;
    }
    asm volatile("s_waitcnt vmcnt(0) lgkmcnt(0)\n\ts_barrier" ::: "memory");
}

__device__ __forceinline__ void phase_mix1(const Params& p, int l, LAS unsigned char* lds, int wave_, int lane_, int G) {
    const int lane = lane_id(), wave = launder_s(wave_); (void)lane_;
    unsigned char* ws = launder_p(p.ws);
    LAS float* P2L = (LAS float*)(lds + LDS_P2);
    {
        const float* tot = (const float*)(ws + O_TOT2); const int h = wave;
        const float a0 = tot[(4 * lane) * 8 + h], a1 = tot[(4 * lane + 1) * 8 + h], a2 = tot[(4 * lane + 2) * 8 + h], a3 = tot[(4 * lane + 3) * 8 + h];
        const float incl = scan_sum(a0 + a1 + a2 + a3, lane); const float ex = incl - (a0 + a1 + a2 + a3);
        P2L[(4 * lane) * 8 + h] = ex; P2L[(4 * lane + 1) * 8 + h] = ex + a0; P2L[(4 * lane + 2) * 8 + h] = ex + a0 + a1; P2L[(4 * lane + 3) * 8 + h] = ex + a0 + a1 + a2;
    }
    __syncthreads();
    if (DBG_MIX & 1) {
        pg8::SimpleSched Sd{(const char*)(ws + O_POOL), (const char*)(ws + OW_BD), 512, 512, 64, 2, G, (int)blockIdx.x, 8};
        pg8::EpiPool E{(bf16_t*)(ws + O_YBR), p.pool_scale + (size_t)l * 512};
        pg8::gemm_phase(lds, 512, 512, Sd, E, wave);
    }
    const int gw = blockIdx.x * NWAVES + wave, NGW = G * NWAVES;
    const int q = lane & 31, hi = lane >> 5;
    if (DBG_MIX & 2) for (int task = gw; task < 4096; task += NGW) {
        const int vb = task & 3, h = (task >> 2) & 3, c = task >> 4;
        const bf16_t* Ap = (const bf16_t*)(ws + O_VTW) + (size_t)(h * 128 + 32 * vb + q) * S + c * 64 + 8 * hi;
        bf16x8 af[4];
#pragma unroll
        for (int ks = 0; ks < 4; ++ks) af[ks] = *(const bf16x8*)(Ap + 16 * ks);
        float* Uo = (float*)(ws + O_U) + ((size_t)(c * 4 + h) * 128 + 32 * vb) * 128;
#pragma unroll
        for (int kb = 0; kb < 4; ++kb) {
            const bf16_t* Bp = (const bf16_t*)(ws + O_KTM) + (size_t)(h * 128 + 32 * kb + q) * S + c * 64 + 8 * hi;
            f32x16 acc;
#pragma unroll
            for (int r = 0; r < 16; ++r) acc[r] = 0.f;
#pragma unroll
            for (int ks = 0; ks < 4; ++ks) acc = MFMA32(af[ks], *(const bf16x8*)(Bp + 16 * ks), acc);
#pragma unroll
            for (int r = 0; r < 16; ++r) Uo[(size_t)crow(r, hi) * 128 + 32 * kb + q] = acc[r];
        }
    }
    if (DBG_MIX & 4) for (int task = gw; task < 4096; task += NGW) {
        const int h = task & 7, qb = task >> 3;
        attn_unit<false>(h, qb, (const bf16_t*)(ws + O_R1), (const bf16_t*)(ws + O_VTS), nullptr, P2L, p.swa_sinks[l * 8 + h] * LOG2E, (bf16_t*)(ws + O_YBR), lane);
    }
    __syncthreads();
    if (DBG_MIX & 8) {
        const int h = blockIdx.x & 7;
        LAS float* clL = (LAS float*)(lds + 49152);
        { const f32x4* src = (const f32x4*)((const float*)(ws + O_CL2) + (size_t)h * S); const int tid = wave * 64 + lane;
#pragma unroll
          for (int j = 0; j < 8; ++j) *(LAS f32x4*)(clL + 4 * (tid + j * NTHR)) = src[tid + j * NTHR]; }
        __syncthreads();
        for (int pr = (blockIdx.x >> 3); pr < 32; pr += (G >> 3)) {
            fox_unit(h, 63 - pr, (const bf16_t*)(ws + O_R1), (const bf16_t*)(ws + O_VTF), clL, P2L, (bf16_t*)(ws + O_YBR), lds, wave, lane);
            fox_unit(h, pr, (const bf16_t*)(ws + O_R1), (const bf16_t*)(ws + O_VTF), clL, P2L, (bf16_t*)(ws + O_YBR), lds, wave, lane);
        }
    }
}

__device__ __forceinline__ void phase_scan(const Params& p, LAS unsigned char* lds, int wave_, int G) {
    unsigned char* ws = launder_p(p.ws); const int tid = launder_s(wave_) * 64 + lane_id();
    if ((int)blockIdx.x * NTHR >= 4 * 16512) return;
    LAS float* decL = (LAS float*)lds; LAS float* sclL = decL + 1024;
    {
        const int wv = tid >> 6, ln = tid & 63;
        if (wv < 4) {
            const int h = wv; const float* BL = (const float*)(ws + O_BLC); const float* DMX = (const float*)(ws + O_DMC);
            float bl[4], dm[4], B[5], M[5];
#pragma unroll
            for (int j = 0; j < 4; ++j) { bl[j] = BL[(4 * ln + j) * 4 + h]; dm[j] = DMX[(4 * ln + j) * 4 + h]; }
            const float s4 = (bl[0] + bl[1]) + (bl[2] + bl[3]);
            const float incl = scan_sum(s4, ln);
            B[0] = incl - s4; B[1] = B[0] + bl[0]; B[2] = B[1] + bl[1]; B[3] = B[2] + bl[2]; B[4] = B[3] + bl[3];
            float E[4];
#pragma unroll
            for (int j = 0; j < 4; ++j) E[j] = dm[j] - B[j];
            const float mx4 = fmaxf(fmaxf(E[0], E[1]), fmaxf(E[2], E[3]));
            const float inclm = scan_max(mx4, ln);
            const float up = __shfl_up(inclm, 1);
            M[0] = fmaxf(0.f, ln == 0 ? -INFINITY : up); M[1] = fmaxf(M[0], E[0]); M[2] = fmaxf(M[1], E[1]); M[3] = fmaxf(M[2], E[2]); M[4] = fmaxf(M[3], E[3]);
#pragma unroll
            for (int j = 0; j < 4; ++j) { const float mc = M[j] + B[j], mn = M[j + 1] + B[j + 1]; const int c = 4 * ln + j;
                decL[c * 4 + h] = __expf(bl[j] + mc - mn); sclL[c * 4 + h] = __expf(bl[j] + dm[j] - mn);
                if (blockIdx.x == 0) ((float*)(ws + O_MST))[c * 4 + h] = mc; }
        }
    }
    __syncthreads();
    const int e = blockIdx.x * NTHR + tid;
    if (e < 4 * 16512) {
        const int h = e / 16512, idx = e % 16512;
        float st = 0.f;
        if (idx < 16384) {
            const float* src = (const float*)(ws + O_U) + (size_t)h * 16384 + idx; bf16_t* dst = (bf16_t*)(ws + O_CST) + (size_t)h * 16384 + idx;
            for (int c0 = 0; c0 < 256; c0 += 32) {
                float u[32];
#pragma unroll
                for (int j = 0; j < 32; ++j) u[j] = src[(size_t)(c0 + j) * 65536];
#pragma unroll
                for (int j = 0; j < 32; ++j) { dst[(size_t)(c0 + j) * 65536] = f2bf(st); st = decL[(c0 + j) * 4 + h] * st + sclL[(c0 + j) * 4 + h] * u[j]; }
            }
        } else {
            const int k = idx - 16384;
            const float* src = (const float*)(ws + O_UN) + h * 128 + k; float* dst = (float*)(ws + O_NST) + h * 128 + k;
            for (int c0 = 0; c0 < 256; c0 += 8) {
                float u[8];
#pragma unroll
                for (int j = 0; j < 8; ++j) u[j] = src[(size_t)(c0 + j) * 512];
#pragma unroll
                for (int j = 0; j < 8; ++j) { dst[(size_t)(c0 + j) * 512] = st; st = decL[(c0 + j) * 4 + h] * st + sclL[(c0 + j) * 4 + h] * u[j]; }
            }
        }
    }
}

__device__ __forceinline__ void phase_mlout(const Params& p, int wave_, int lane_, int G) {
    const int lane = lane_id(), wave = launder_s(wave_); (void)lane_;
    unsigned char* ws = launder_p(p.ws);
    const int gw = blockIdx.x * NWAVES + wave, NGW = G * NWAVES;
    const int q = lane & 31, hi = lane >> 5;
    const int pim = 16 * ((q >> 2) & 1) + 4 * (q >> 3) + (q & 3);
    const bf16_t* QKC = (const bf16_t*)(ws + O_QKC); const bf16_t* Z = (const bf16_t*)(ws + O_R1);
    for (int task = gw; task < 2048; task += NGW) {
        const int tb = task & 1, h = (task >> 1) & 3, c = task >> 3;
        const int t = c * 64 + 32 * tb + q;
        bf16x8 qf[8];
#pragma unroll
        for (int kk = 0; kk < 8; ++kk) qf[kk] = *(const bf16x8*)(QKC + (size_t)t * 1024 + h * 128 + 16 * kk + 8 * hi);
        const float m_c = ((const float*)(ws + O_MST))[c * 4 + h];
        const float a_t = ((const float*)(ws + O_MLA))[h * S + t], b_t = ((const float*)(ws + O_MLB))[h * S + t];
        const float Mt = fmaxf(m_c, a_t), w_inter = __expf(m_c - Mt);
        f32x16 o[4];
#pragma unroll
        for (int vb = 0; vb < 4; ++vb) {
#pragma unroll
            for (int r = 0; r < 16; ++r) o[vb][r] = 0.f;
            const bf16_t* Cp = (const bf16_t*)(ws + O_CST) + ((size_t)(c * 4 + h) * 128 + 32 * vb + q) * 128 + 8 * hi;
#pragma unroll
            for (int kk = 0; kk < 8; ++kk) o[vb] = MFMA32(*(const bf16x8*)(Cp + 16 * kk), qf[kk], o[vb]);
#pragma unroll
            for (int r = 0; r < 16; ++r) o[vb][r] *= w_inter;
        }
        float nq = 0.f;
        {
            const float* np = (const float*)(ws + O_NST) + (size_t)(c * 4 + h) * 128 + 8 * hi;
#pragma unroll
            for (int kk = 0; kk < 8; ++kk) { const f32x4 n0 = *(const f32x4*)(np + 16 * kk), n1 = *(const f32x4*)(np + 16 * kk + 4);
                const bf16x8 qq = qf[kk];
                nq += n0[0] * bf2f((unsigned short)qq[0]) + n0[1] * bf2f((unsigned short)qq[1]) + n0[2] * bf2f((unsigned short)qq[2]) + n0[3] * bf2f((unsigned short)qq[3])
                    + n1[0] * bf2f((unsigned short)qq[4]) + n1[1] * bf2f((unsigned short)qq[5]) + n1[2] * bf2f((unsigned short)qq[6]) + n1[3] * bf2f((unsigned short)qq[7]); }
            nq += __shfl_xor(nq, 32);
        }
        float den = 0.f;
        for (int sb = 0; sb <= tb; ++sb) {
            const int s0 = c * 64 + 32 * sb;
            f32x16 acc;
#pragma unroll
            for (int r = 0; r < 16; ++r) acc[r] = 0.f;
            const bf16_t* Kp = QKC + (size_t)(s0 + pim) * 1024 + 512 + h * 128 + 8 * hi;
#pragma unroll
            for (int kk = 0; kk < 8; ++kk) acc = MFMA32(*(const bf16x8*)(Kp + 16 * kk), qf[kk], acc);
            const float* dp = (const float*)(ws + O_MLD) + (size_t)h * S + s0 + 16 * hi;
#pragma unroll
            for (int r = 0; r < 16; ++r) { const int s = s0 + 16 * hi + r; const float w = (s <= t) ? __expf(dp[r] - Mt) : 0.f; acc[r] *= w; den += acc[r]; }
            u32x4 w0, w1;
            w0.x = pk2(acc[0], acc[1]); w0.y = pk2(acc[2], acc[3]); w0.z = pk2(acc[4], acc[5]); w0.w = pk2(acc[6], acc[7]);
            w1.x = pk2(acc[8], acc[9]); w1.y = pk2(acc[10], acc[11]); w1.z = pk2(acc[12], acc[13]); w1.w = pk2(acc[14], acc[15]);
            const bf16x8 pb0 = __builtin_bit_cast(bf16x8, w0), pb1 = __builtin_bit_cast(bf16x8, w1);
#pragma unroll
            for (int vb = 0; vb < 4; ++vb) {
                const bf16_t* Vp = (const bf16_t*)(ws + O_VTM) + (size_t)(h * 128 + 32 * vb + q) * S + s0 + 16 * hi;
                o[vb] = MFMA32(*(const bf16x8*)Vp, pb0, o[vb]); o[vb] = MFMA32(*(const bf16x8*)(Vp + 8), pb1, o[vb]);
            }
        }
        den += __shfl_xor(den, 32);
        den += w_inter * nq;
        const float hd = fmaxf(fabsf(den), __expf(-(b_t + Mt))); const float inv = 1.f / hd;
        const bf16_t* opre = Z + (size_t)t * ZLD + ZC_OML + h * 128 + 4 * hi;
        bf16_t* op = (bf16_t*)(ws + O_YBR) + (size_t)t * DM + 1024 + h * 128 + 4 * hi;
#pragma unroll
        for (int vb = 0; vb < 4; ++vb)
#pragma unroll
            for (int g = 0; g < 4; ++g) {
                const u32x2 og = *(const u32x2*)(opre + 32 * vb + 8 * g);
                u32x2 w; w.x = pk2(sigmoidf_(bflo(og.x)) * o[vb][4 * g] * inv, sigmoidf_(bfhi(og.x)) * o[vb][4 * g + 1] * inv);
                w.y = pk2(sigmoidf_(bflo(og.y)) * o[vb][4 * g + 2] * inv, sigmoidf_(bfhi(og.y)) * o[vb][4 * g + 3] * inv);
                *(u32x2*)(op + 32 * vb + 8 * g) = w;
            }
    }
}


__device__ __forceinline__ void dbg_dump(float* out, const void* src, int mode, int wave, int G) {
    const int gt = blockIdx.x * NTHR + wave * 64 + lane_id(), NGT = G * NTHR;
    for (int i = gt; i < S * DM; i += NGT) out[i] = mode ? bf2f(((const bf16_t*)src)[i]) : ((const float*)src)[i];
}
#define DBG_AT(k, off, mode) do { if (DBG_STOP == (k) && l == 0) { GRID_SYNC(15); dbg_dump(p.out, p.ws + (off), (mode), wave, G); return; } } while (0)
#define XB_TMO      128
#define XB_XCNT(j)  (256  + 64 * (j))
#define XB_XSUB(j)  (1280 + 64 * (j))
#define XB_XGEN(j)  (2304 + 64 * (j))
#define XB_TOP      3328
#define XB_TOPGEN   3392
#define XB_SPIN_CAP (1u << 22)
__device__ __forceinline__ unsigned xb_ld(unsigned* p)              { return __hip_atomic_load(p, __ATOMIC_RELAXED, __HIP_MEMORY_SCOPE_AGENT); }
__device__ __forceinline__ unsigned xb_add(unsigned* p, unsigned v) { return __hip_atomic_fetch_add(p, v, __ATOMIC_RELAXED, __HIP_MEMORY_SCOPE_AGENT); }
__device__ __forceinline__ unsigned xb_xcc_id() { return (unsigned)__builtin_amdgcn_s_getreg((3 << 11) | 20) & 0xFu; }
#define XB_SPIN(cond, bar) do { unsigned _sp = 0; while (cond) { __builtin_amdgcn_s_sleep(1); \
    if ((++_sp & 255u) == 0u) { if (xb_ld(&(bar)[XB_TMO])) break; if (_sp > XB_SPIN_CAP) { atomicAdd(&(bar)[XB_TMO], 1u); break; } } } } while (0)
__device__ __forceinline__ void xcd_census(unsigned* bar, unsigned x, unsigned G, unsigned& nloc, unsigned& nx) {
    unsigned sum, cnt, mine, sp = 0u;
    for (;;) {
        sum = 0u; cnt = 0u; mine = 0u;
#pragma unroll
        for (unsigned j = 0; j < 16; ++j) { const unsigned c = xb_ld(&bar[XB_XCNT(j)]); sum += c; cnt += (c > 0u) ? 1u : 0u; mine = (j == x) ? c : mine; }
        if (sum == G) break;
        __builtin_amdgcn_s_sleep(1);
        if ((++sp & 255u) == 0u) { if (xb_ld(&bar[XB_TMO])) break; if (sp > XB_SPIN_CAP) { atomicAdd(&bar[XB_TMO], 1u); break; } }
    }
    nloc = mine > 0u ? mine : 1u; nx = cnt > 0u ? cnt : 1u;
}
__device__ __forceinline__ void grid_barrier(unsigned* bar, volatile LAS unsigned* st, unsigned G, int wave) {
    asm volatile("s_waitcnt vmcnt(0) lgkmcnt(0)" ::: "memory");
    __syncthreads();
    if (wave == 0 && lane_id() == 0) {
        const unsigned x = xb_xcc_id();
        unsigned nloc = st[0], nx = st[1];
        if (nloc == 0u) { xcd_census(bar, x, G, nloc, nx); st[0] = nloc; st[1] = nx; }
        const unsigned old = xb_add(&bar[XB_XSUB(x)], 1u);
        const unsigned gen = old / nloc;
        if (old + 1u == (gen + 1u) * nloc) {
            __builtin_amdgcn_fence(__ATOMIC_RELEASE, "agent");
            asm volatile("s_waitcnt vmcnt(0)" ::: "memory");
            const unsigned og = xb_add(&bar[XB_TOP], 1u);
            const unsigned tg = og / nx;
            if (og + 1u == (tg + 1u) * nx) xb_add(&bar[XB_TOPGEN], 1u);
            else XB_SPIN(xb_ld(&bar[XB_TOPGEN]) == tg, bar);
            __builtin_amdgcn_fence(__ATOMIC_ACQUIRE, "agent");
            xb_add(&bar[XB_XGEN(x)], 1u);
            asm volatile("s_waitcnt vmcnt(0)" ::: "memory");
        } else {
            XB_SPIN(xb_ld(&bar[XB_XGEN(x)]) == gen, bar);
            __builtin_amdgcn_fence(__ATOMIC_ACQUIRE, "agent");
            asm volatile("s_waitcnt vmcnt(0)" ::: "memory");
        }
    }
    __syncthreads();
}
#define GRID_SYNC(k) grid_barrier((unsigned*)(p.ws + O_CTL), (volatile LAS unsigned*)(lds + LDS_MISC + 2048), (unsigned)G, wave)
__global__ void __launch_bounds__(NTHR, 2) fwd_megakernel(Params p) {
    extern __shared__ __attribute__((aligned(16))) unsigned char lds_raw[];
    LAS unsigned char* lds = (LAS unsigned char*)lds_raw;
    cg::grid_group grid = cg::this_grid();
    const int wave = __builtin_amdgcn_readfirstlane((int)threadIdx.x >> 6), lane = 0;
    const int G = gridDim.x, bx = blockIdx.x;
    grid.sync();
    if (wave == 0 && lane_id() == 0) { volatile LAS unsigned* st = (volatile LAS unsigned*)(lds + LDS_MISC + 2048); st[0] = 0u; st[1] = 0u; (void)xb_add((unsigned*)(p.ws + O_CTL) + XB_XCNT(xb_xcc_id()), 1u); }
    __syncthreads();

    for (int l = 0; l < NL; ++l) {
        if (l == 0) { REPS(3) phase_weights(p, 0, lds, wave, lane, G);
            GRID_SYNC(0); }
        REPS(2) { unsigned char* ws = launder_p(p.ws); pg8::SimpleSched Sd{(const char*)(ws + O_HB), (const char*)(ws + OW_F1A), DM, DM, 64, 44, G, bx, 32}; pg8::EpiSwiGLU E{(bf16_t*)(ws + O_R1)}; pg8::gemm_phase(lds, DM, DM, Sd, E, wave); }
        GRID_SYNC(1);
        if (l == 0) { unsigned char* ws = launder_p(p.ws); pg8::SimpleSched Sd{(const char*)(ws + O_R1), (const char*)(ws + OW_F1B), FF, FF, 64, 8, G, bx, 88}; pg8::EpiResid<false> E{p.x, (float*)(ws + O_H), 0.5f, nullptr, nullptr, nullptr}; pg8::gemm_phase(lds, FF, FF, Sd, E, wave); }
        else { unsigned char* ws = launder_p(p.ws); pg8::SimpleSched Sd{(const char*)(ws + O_R1), (const char*)(ws + OW_F1B), FF, FF, 64, 8, G, bx, 88}; pg8::EpiResid<true> E{(const float*)(ws + O_H), (float*)(ws + O_H), 0.5f, (const float*)(ws + O_ST), p.ln_g + (size_t)(l * 3 - 1) * DM, p.ln_b + (size_t)(l * 3 - 1) * DM}; pg8::gemm_phase(lds, FF, FF, Sd, E, wave); }
        GRID_SYNC(2);
        REPS(7) { unsigned char* ws = launder_p(p.ws); const bool dummy = (REP_PHASE == 7) && (rep_ == 0); phase_ln((const float*)(ws + O_H), dummy ? (float*)(ws + O_YBR) : nullptr, (bf16_t*)(ws + (dummy ? O_U : O_HB)), (float*)(ws + O_ST), p.ln_g + (size_t)(l * 3 + 0) * DM, p.ln_b + (size_t)(l * 3 + 0) * DM, wave, lane, G); }
        GRID_SYNC(3);
        DBG_AT(1, O_H, 0);
        { unsigned char* ws = launder_p(p.ws); pg8::SimpleSched Sd{(const char*)(ws + O_HB), (const char*)(ws + OW_IN), DM, DM, 64, 20, G, bx, 32}; pg8::EpiInProj E{(bf16_t*)(ws + O_R1), (float*)(ws + O_ZG)}; pg8::gemm_phase(lds, DM, DM, Sd, E, wave); }
        GRID_SYNC(4);
        DBG_AT(2, O_R1, 1);
        phase_post(p, l, lds, wave, lane, G);
        GRID_SYNC(5);
        DBG_AT(3, O_QKC, 1);
        REPS(1) phase_mix1(p, l, lds, wave, lane, G);
        GRID_SYNC(6);
        DBG_AT(4, O_YBR, 1);
        REPS(6) phase_scan(p, lds, wave, G);
        GRID_SYNC(7);
        REPS(5) phase_mlout(p, wave, lane, G);
        GRID_SYNC(8);
        DBG_AT(5, O_YBR, 1);
        REPS(4) { unsigned char* ws = launder_p(p.ws); pg8::MergeSched Sd{(const char*)(ws + O_HB), (const char*)(ws + O_YBR), (const char*)(ws + OW_G), (const char*)(ws + OW_BC), G, bx};
          pg8::EpiMerge E{(u32x2*)(ws + O_GSC), (u32x4*)(ws + O_MSC), (bf16_t*)(ws + O_MERGED)}; pg8::gemm_phase(lds, DM, DM, Sd, E, wave); }
        GRID_SYNC(9);
        DBG_AT(6, O_MERGED, 1);
        { unsigned char* ws = launder_p(p.ws); pg8::SimpleSched Sd{(const char*)(ws + O_MERGED), (const char*)(ws + OW_O), DM, DM, 64, 8, G, bx, 32}; pg8::EpiResid<true> E{(const float*)(ws + O_H), (float*)(ws + O_H), 1.0f, (const float*)(ws + O_ST), p.ln_g + (size_t)(l * 3 + 0) * DM, p.ln_b + (size_t)(l * 3 + 0) * DM}; pg8::gemm_phase(lds, DM, DM, Sd, E, wave); }
        GRID_SYNC(10);
        { unsigned char* ws = launder_p(p.ws); phase_ln((const float*)(ws + O_H), nullptr, (bf16_t*)(ws + O_HB), (float*)(ws + O_ST), p.ln_g + (size_t)(l * 3 + 1) * DM, p.ln_b + (size_t)(l * 3 + 1) * DM, wave, lane, G); }
        GRID_SYNC(11);
        DBG_AT(7, O_H, 0);
        { unsigned char* ws = launder_p(p.ws); pg8::SimpleSched Sd{(const char*)(ws + O_HB), (const char*)(ws + OW_F2A), DM, DM, 64, 44, G, bx, 32}; pg8::EpiSwiGLU E{(bf16_t*)(ws + O_R1)}; pg8::gemm_phase(lds, DM, DM, Sd, E, wave); }
        GRID_SYNC(12);
        { unsigned char* ws = launder_p(p.ws); pg8::SimpleSched Sd{(const char*)(ws + O_R1), (const char*)(ws + OW_F2B), FF, FF, 64, 8, G, bx, 88}; pg8::EpiResid<true> E{(const float*)(ws + O_H), (float*)(ws + O_H), 0.5f, (const float*)(ws + O_ST), p.ln_g + (size_t)(l * 3 + 1) * DM, p.ln_b + (size_t)(l * 3 + 1) * DM}; pg8::gemm_phase(lds, FF, FF, Sd, E, wave); }
        GRID_SYNC(13);
        { unsigned char* ws = launder_p(p.ws); phase_ln((const float*)(ws + O_H), (l == NL - 1) ? p.out : nullptr, (l == NL - 1) ? nullptr : (bf16_t*)(ws + O_HB), (l == NL - 1) ? nullptr : (float*)(ws + O_ST), p.ln_g + (size_t)(l * 3 + 2) * DM, p.ln_b + (size_t)(l * 3 + 2) * DM, wave, lane, G); }
        if (l + 1 < NL) phase_weights(p, l + 1, lds, wave, lane, G);
        GRID_SYNC(14);
    }
}

extern "C" void kernel_launch(void* const* d_in, const int* in_sizes, int n_in, void* d_out, int out_size, void* d_ws, size_t ws_size, hipStream_t stream) {
    static int grid_blocks = 0;
    if (grid_blocks == 0) {
        if (n_in != 18 || ws_size < O_END) { fprintf(stderr, "kernel_launch: unexpected inputs (n_in %d, ws %zu, need %zu)\n", n_in, ws_size, (size_t)O_END); grid_blocks = -1; return; }
        int dev = 0, cus = 0, per_cu = 0;
        hipGetDevice(&dev);
        hipDeviceGetAttribute(&cus, hipDeviceAttributeMultiprocessorCount, dev);
        hipFuncSetAttribute((const void*)fwd_megakernel, hipFuncAttributeMaxDynamicSharedMemorySize, LDS_BYTES);
        hipOccupancyMaxActiveBlocksPerMultiprocessor(&per_cu, (const void*)fwd_megakernel, NTHR, LDS_BYTES);
        if (per_cu < 1) per_cu = 1;
        grid_blocks = cus * 1;
        (void)hipGetLastError();
    }
    if (grid_blocks < 0) return;
    Params p{};
    p.x = (const float*)d_in[0]; p.ln_g = (const float*)d_in[1]; p.ln_b = (const float*)d_in[2]; p.ffn1_w_in = (const float*)d_in[3]; p.ffn1_w_out = (const float*)d_in[4];
    p.w_in = (const float*)d_in[5]; p.pool_w = (const float*)d_in[6]; p.pool_scale = (const float*)d_in[7]; p.swa_sinks = (const float*)d_in[8]; p.mlstm_conv = (const float*)d_in[9];
    p.mlstm_i_bias = (const float*)d_in[10]; p.mlstm_f_bias = (const float*)d_in[11]; p.fox_f_bias = (const float*)d_in[12]; p.w_branch = (const float*)d_in[13]; p.w_gate = (const float*)d_in[14];
    p.w_out = (const float*)d_in[15]; p.ffn2_w_in = (const float*)d_in[16]; p.ffn2_w_out = (const float*)d_in[17]; p.out = (float*)d_out; p.ws = (unsigned char*)d_ws;
    (void)hipMemsetAsync((unsigned char*)d_ws + O_CTL, 0, 16384, stream);
    void* args[] = {&p};
    hipError_t e = hipLaunchCooperativeKernel((const void*)fwd_megakernel, dim3(grid_blocks), dim3(NTHR), args, LDS_BYTES, stream);
    if (e != hipSuccess) fprintf(stderr, "cooperative launch failed: %s (grid %d)\n", hipGetErrorString(e), grid_blocks);
}
```

```cpp
#include <hip/hip_runtime.h>
#include <hip/hip_cooperative_groups.h>
#include <cstdio>
#include <cstdint>
namespace cg = cooperative_groups;
#define DBG_MIX 15
#define DBG_STOP 0
#define REP_PHASE 0
#define REPS(k) for (int rep_ = 0; rep_ < ((REP_PHASE == (k)) ? 2 : 1); ++rep_)

#define LAS __attribute__((address_space(3)))
typedef unsigned short bf16_t;
typedef short bf16x8 __attribute__((ext_vector_type(8)));
typedef float f32x4 __attribute__((ext_vector_type(4)));
typedef float f32x16 __attribute__((ext_vector_type(16)));
typedef unsigned u32x4 __attribute__((ext_vector_type(4)));
typedef unsigned u32x2 __attribute__((ext_vector_type(2)));
typedef float f32x2_t __attribute__((ext_vector_type(2)));
typedef __bf16 bf16x2_t __attribute__((ext_vector_type(2)));

constexpr int S = 16384, DM = 2048, FF = 5632, ZLD = 4864, NL = 2;
constexpr int NWAVES = 8, NTHR = 512;
constexpr float ALPHA = 1.41421356237309515f;
constexpr float LOG2E = 1.4426950408889634f;
constexpr float C2 = 0.125f * LOG2E;
constexpr float LN_EPS = 1e-5f;
constexpr int ZC_QSWA = 512, ZC_KSWA = 1024, ZC_VSWA = 1152, ZC_QML = 1280, ZC_VML = 2304, ZC_OML = 2816, ZC_QFOX = 3328, ZC_KFOX = 3840, ZC_VFOX = 4352;

constexpr size_t MiB = 1u << 20;
constexpr size_t O_ZG = 0;
constexpr size_t O_MLA = 1 * MiB;
constexpr size_t O_MLB = O_MLA + 256 * 1024;
constexpr size_t O_MLD = O_MLB + 256 * 1024;
constexpr size_t O_CL2 = 2 * MiB;
constexpr size_t O_TOT2 = O_CL2 + 512 * 1024;
constexpr size_t O_BLC = O_TOT2 + 16 * 1024;
constexpr size_t O_DMC = O_BLC + 16 * 1024;
constexpr size_t O_MST = O_DMC + 16 * 1024;
constexpr size_t O_NST = 3 * MiB;
constexpr size_t O_UN = O_NST + 512 * 1024;
constexpr size_t O_ST = 4 * MiB;
constexpr size_t O_W = 8 * MiB;
constexpr size_t OW_F1A = O_W, OW_F1B = OW_F1A + 44 * MiB, OW_IN = OW_F1B + 22 * MiB, OW_G = OW_IN + 20 * MiB, OW_BC = OW_G + 32 * MiB,
                 OW_O = OW_BC + 8 * MiB, OW_F2A = OW_O + 8 * MiB, OW_F2B = OW_F2A + 44 * MiB, OW_BD = OW_F2B + 22 * MiB;
constexpr size_t O_H = 210 * MiB;
constexpr size_t O_HB = 338 * MiB;
constexpr size_t O_R1 = 402 * MiB;
constexpr size_t O_YBR = 578 * MiB;
constexpr size_t O_QKC = 642 * MiB;
constexpr size_t O_VTF = 674 * MiB;
constexpr size_t O_VTS = 690 * MiB;
constexpr size_t O_VTM = 694 * MiB;
constexpr size_t O_VTW = 710 * MiB;
constexpr size_t O_KTM = 726 * MiB;
constexpr size_t O_POOL = 742 * MiB;
constexpr size_t O_U = 758 * MiB;
constexpr size_t O_CST = 822 * MiB;
constexpr size_t O_CTL = 854 * MiB;
constexpr size_t O_END = 855 * MiB;
constexpr size_t O_MERGED = O_QKC;
constexpr size_t O_GSC = O_R1;
constexpr size_t O_MSC = O_R1 + 32 * MiB;

constexpr int RING_BYTES = 131072;
constexpr int LDS_P2 = RING_BYTES;
constexpr int LDS_MISC = RING_BYTES + 8192;
constexpr int LDS_BYTES = 147456;

__device__ __forceinline__ unsigned pk2(float lo, float hi) { f32x2_t v = {lo, hi}; bf16x2_t b = __builtin_convertvector(v, bf16x2_t); return __builtin_bit_cast(unsigned, b); }
__device__ __forceinline__ float bf2f(unsigned short b) { return __uint_as_float((unsigned)b << 16); }
__device__ __forceinline__ float bflo(unsigned w) { return __uint_as_float(w << 16); }
__device__ __forceinline__ float bfhi(unsigned w) { return __uint_as_float(w & 0xffff0000u); }
__device__ __forceinline__ unsigned short f2bf(float f) { return (unsigned short)(pk2(f, 0.f) & 0xffffu); }
__device__ __forceinline__ float sigmoidf_(float x) { return __builtin_amdgcn_rcpf(1.f + __builtin_amdgcn_exp2f(-x * LOG2E)); }
__device__ __forceinline__ float logsigmoidf_(float x) { return fminf(x, 0.f) - log1pf(__expf(-fabsf(x))); }
__device__ __forceinline__ int lane_id() { int l; asm volatile("v_mbcnt_lo_u32_b32 %0, -1, 0\n\tv_mbcnt_hi_u32_b32 %0, -1, %0" : "=v"(l)); return l; }
__device__ __forceinline__ int launder_v(int x) { asm volatile("" : "+v"(x)); return x; }
__device__ __forceinline__ int launder_s(int x) { asm volatile("" : "+s"(x)); return x; }
template <class T> __device__ __forceinline__ T* launder_pv(T* p) { asm volatile("" : "+v"(p)); return p; }
template <class T> __device__ __forceinline__ T* launder_p(T* p) { asm volatile("" : "+s"(p)); return p; }
__device__ __forceinline__ int crow(int r, int hi) { return (r & 3) + 8 * (r >> 2) + 4 * hi; }

namespace pg8 {
constexpr int BM = 256, BK = 64, HALF = 128, HTB = HALF * BK * 2, NXCD = 8, WGM = 8;
__device__ __forceinline__ int lds_byte(int r, int c) { const int st = (r >> 4) * 2 + (c >> 5), rr = r & 15, cc = c & 31, ob = rr * 64 + cc * 2; return st * 1024 + (ob ^ (((ob >> 9) & 1) << 5)); }
__device__ __forceinline__ void stage_rc(int b, int& R, int& C) { const int st = b / 1024, sb = b % 1024, swz = sb ^ (((sb >> 9) & 1) << 5); R = (st >> 1) * 16 + swz / 64; C = (st & 1) * 32 + (swz % 64) / 2; }
__device__ __forceinline__ int perm32(int rho) { const int n = rho >> 4, i = rho & 15; return 8 * (i >> 2) + 4 * n + (i & 3); }

struct Unit { int pm, pn, kind, nt; const char* a; const char* b; };

__device__ __forceinline__ void tile_of(int L, int nM, int nN, int& pm, int& pn) {
    const int nwg = nM * nN; int wgid = L;
    { const int q = nwg / NXCD, r = nwg % NXCD, xcd = wgid % NXCD, off = wgid / NXCD; wgid = (xcd < r ? xcd * (q + 1) : r * (q + 1) + (xcd - r) * q) + off; }
    const int nig = WGM * nN, gid = wgid / nig, fm = gid * WGM, gsz = (nM - fm) < WGM ? (nM - fm) : WGM;
    pm = fm + ((wgid % nig) % gsz); pn = (wgid % nig) / gsz;
}
struct SimpleSched {
    const char* A; const char* Bt; int lda, ldb, nM, nN, G, c, nt;
    __device__ __forceinline__ bool next(int i, Unit& u) const {
        const int L = i * G + c; if (L >= nM * nN) return false;
        tile_of(L, nM, nN, u.pm, u.pn); u.kind = 0; u.nt = nt;
        u.a = A + (size_t)u.pm * 256 * lda * 2; u.b = Bt + (size_t)u.pn * 256 * ldb * 2; return true;
    }
};
struct MergeSched {
    const char* HB; const char* YBR; const char* WG; const char* WBC; int G, c;
    __device__ __forceinline__ bool next(int i, Unit& u) const {
        const int L = (i >> 3) * G + c; if (L >= 64 * 8) return false;
        tile_of(L, 64, 8, u.pm, u.pn); const int sub = i & 7, b = sub >> 1; u.kind = sub;
        if ((sub & 1) == 0) { u.nt = 32; u.a = HB + (size_t)u.pm * 256 * 2048 * 2; u.b = WG + ((size_t)b * 2048 + (size_t)u.pn * 256) * 2048 * 2; }
        else { u.nt = 8; u.a = YBR + ((size_t)u.pm * 256 * 2048 + b * 512) * 2; u.b = WBC + ((size_t)u.pn * 256 * 2048 + b * 512) * 2; }
        return true;
    }
};

template <class Epi, class Sched>
__device__ __forceinline__ void gemm_phase(LAS unsigned char* lds, const int lda, const int ldb, const Sched& S, const Epi& E, const int wave_) {
    const int wid = launder_s(wave_), lane = lane_id(), tid = wid * 64 + lane, wr = wid >> 2, wc = wid & 3, fr = lane & 15, fq = lane >> 4;
    unsigned voffA[2], voffB[2];
#pragma unroll
    for (int i = 0; i < 2; ++i) { int R, C; stage_rc(tid * 16 + i * 8192, R, C); const int Rb = Epi::PERM ? ((R & ~31) + perm32(R & 31)) : R;
        voffA[i] = (unsigned)(R * lda + C) * 2u; voffB[i] = (unsigned)(Rb * ldb + C) * 2u; }
    const size_t kstep = (size_t)(BK * 2);
    const size_t hstepA = (size_t)HALF * lda * 2, hstepB = (size_t)HALF * ldb * 2;
    const unsigned ldsw = (unsigned)wid * 1024u;
    const int aoff = lds_byte(wr * 64 + fr, fq * 8), boff = lds_byte(wc * 32 + fr, fq * 8);
#define PG8_SA(b, h) (((b) * 2 + (h)) * HTB)
#define PG8_SB(b, h) ((4 + (b) * 2 + (h)) * HTB)
#define PG8_STAGE(bufoff, gbase, voff) do { _Pragma("unroll") for (int _i = 0; _i < 2; ++_i) \
        __builtin_amdgcn_global_load_lds((const unsigned*)((const char*)(gbase) + (voff)[_i]), (LAS unsigned*)(lds + (bufoff) + ldsw + _i * 8192), 16, 0, 0); } while (0)
#define PG8_LDA(dst, b, h) do { _Pragma("unroll") for (int m = 0; m < 4; ++m) _Pragma("unroll") for (int k = 0; k < 2; ++k) dst[m][k] = *(const LAS bf16x8*)(lds + PG8_SA(b, h) + aoff + m * 2048 + k * 1024); } while (0)
#define PG8_LDB(dst, b, h) do { _Pragma("unroll") for (int n = 0; n < 2; ++n) _Pragma("unroll") for (int k = 0; k < 2; ++k) dst[n][k] = *(const LAS bf16x8*)(lds + PG8_SB(b, h) + boff + n * 2048 + k * 1024); } while (0)
#define PG8_MMA(ai, bj, At, Bt) do { __builtin_amdgcn_s_setprio(1); _Pragma("unroll") for (int m = 0; m < 4; ++m) _Pragma("unroll") for (int n = 0; n < 2; ++n) _Pragma("unroll") for (int k = 0; k < 2; ++k) \
        acc[ai][bj][m][n] = __builtin_amdgcn_mfma_f32_16x16x32_bf16(Bt[n][k], At[m][k], acc[ai][bj][m][n], 0, 0, 0); __builtin_amdgcn_s_setprio(0); } while (0)
#define PG8_WAIT_V(n) asm volatile("s_waitcnt vmcnt(" #n ")" ::: "memory")
#define PG8_WAIT_L(n) asm volatile("s_waitcnt lgkmcnt(" #n ")" ::: "memory")
#define PG8_BAR __builtin_amdgcn_s_barrier()
#define PG8_SCHED __builtin_amdgcn_sched_barrier(0)
    Unit cur, nxt; int ui = 0;
    if (!S.next(0, cur)) return;
    f32x4 acc[2][2][4][2];
#pragma unroll
    for (int a = 0; a < 2; ++a)
#pragma unroll
        for (int b = 0; b < 2; ++b)
#pragma unroll
            for (int m = 0; m < 4; ++m)
#pragma unroll
                for (int n = 0; n < 2; ++n) acc[a][b][m][n] = (f32x4){0.f, 0.f, 0.f, 0.f};
    bf16x8 At[4][2], B0[2][2], B1[2][2];
    const char* cA = cur.a; const char* cB = cur.b;
    PG8_STAGE(PG8_SB(0, 0), cB, voffB); PG8_STAGE(PG8_SB(0, 1), cB + hstepB, voffB); PG8_STAGE(PG8_SA(0, 0), cA, voffA); PG8_STAGE(PG8_SA(0, 1), cA + hstepA, voffA);
    if (wr == 1) PG8_BAR;
    PG8_WAIT_V(2); PG8_BAR;
    PG8_STAGE(PG8_SB(1, 0), cB + kstep, voffB); PG8_STAGE(PG8_SA(1, 0), cA + kstep, voffA); PG8_STAGE(PG8_SB(1, 1), cB + hstepB + kstep, voffB);
    PG8_WAIT_V(6); PG8_BAR;
    for (;;) {
        const bool has_next = S.next(ui + 1, nxt);
        const char* nA = has_next ? nxt.a : cA; const char* nB = has_next ? nxt.b : cB;
        const int nt = cur.nt;
        for (int t = 0; t < nt; t += 2) {
            const bool last = (t == nt - 2);
            const char* a1 = cA + (size_t)(t + 1) * kstep;
            const char* a2 = last ? nA : cA + (size_t)(t + 2) * kstep; const char* b2 = last ? nB : cB + (size_t)(t + 2) * kstep;
            const char* a3 = a2 + kstep; const char* b3 = b2 + kstep;
            PG8_LDB(B0, 0, 0); PG8_LDB(B1, 0, 1); PG8_SCHED; PG8_LDA(At, 0, 0); PG8_STAGE(PG8_SA(1, 1), a1 + hstepA, voffA);
            PG8_WAIT_V(8); PG8_WAIT_L(0); PG8_BAR; PG8_MMA(0, 0, At, B0); PG8_MMA(0, 1, At, B1); PG8_BAR; PG8_SCHED;
            PG8_LDA(At, 0, 1); PG8_STAGE(PG8_SB(0, 0), b2, voffB); PG8_STAGE(PG8_SB(0, 1), b2 + hstepB, voffB); PG8_STAGE(PG8_SA(0, 0), a2, voffA);
            PG8_WAIT_V(8); PG8_WAIT_L(0); PG8_BAR; PG8_MMA(1, 0, At, B0); PG8_MMA(1, 1, At, B1); PG8_BAR; PG8_SCHED;
            PG8_LDB(B0, 1, 0); PG8_LDB(B1, 1, 1); PG8_SCHED; PG8_LDA(At, 1, 0); PG8_STAGE(PG8_SA(0, 1), a2 + hstepA, voffA);
            PG8_WAIT_V(8); PG8_WAIT_L(0); PG8_BAR; PG8_MMA(0, 0, At, B0); PG8_MMA(0, 1, At, B1); PG8_BAR; PG8_SCHED;
            PG8_LDA(At, 1, 1); PG8_STAGE(PG8_SB(1, 0), b3, voffB); PG8_STAGE(PG8_SB(1, 1), b3 + hstepB, voffB); PG8_STAGE(PG8_SA(1, 0), a3, voffA);
            PG8_WAIT_V(8); PG8_WAIT_L(0); PG8_BAR; PG8_MMA(1, 0, At, B0); PG8_MMA(1, 1, At, B1); PG8_BAR; PG8_SCHED;
        }
        if (wr == 0) PG8_BAR;
        E(acc, cur, wr, wc, fr, fq);
        if (!has_next) break;
#pragma unroll
        for (int a = 0; a < 2; ++a)
#pragma unroll
            for (int b = 0; b < 2; ++b)
#pragma unroll
                for (int m = 0; m < 4; ++m)
#pragma unroll
                    for (int n = 0; n < 2; ++n) acc[a][b][m][n] = (f32x4){0.f, 0.f, 0.f, 0.f};
        cur = nxt; cA = nA; cB = nB; ++ui;
        if (wr == 1) PG8_BAR;
    }
    PG8_WAIT_V(0);
    PG8_BAR;
#undef PG8_SA
#undef PG8_SB
#undef PG8_STAGE
#undef PG8_LDA
#undef PG8_LDB
#undef PG8_MMA
#undef PG8_WAIT_V
#undef PG8_WAIT_L
#undef PG8_BAR
#undef PG8_SCHED
}

typedef f32x4 Acc[2][2][4][2];

struct EpiSwiGLU {
    static constexpr bool PERM = true;
    bf16_t* O;
    __device__ __forceinline__ void operator()(const Acc& acc, const Unit& u, int wr, int wc, int fr, int fq) const {
        const int row0 = u.pm * BM + wr * 64 + fr, col0 = u.pn * 128 + wc * 32 + 8 * fq;
#pragma unroll
        for (int ai = 0; ai < 2; ++ai)
#pragma unroll
            for (int m = 0; m < 4; ++m) {
                bf16_t* p = O + (size_t)(row0 + ai * HALF + m * 16) * FF + col0;
                float h[8];
#pragma unroll
                for (int n = 0; n < 2; ++n)
#pragma unroll
                    for (int j = 0; j < 4; ++j) { const float g = acc[ai][0][m][n][j], up = acc[ai][1][m][n][j]; h[n * 4 + j] = g * sigmoidf_(g) * up; }
                u32x4 w; w.x = pk2(h[0], h[1]); w.y = pk2(h[2], h[3]); w.z = pk2(h[4], h[5]); w.w = pk2(h[6], h[7]);
                *(u32x4*)p = w;
            }
    }
};
template <bool LNRES> struct EpiResid {
    static constexpr bool PERM = false;
    const float* res; float* out; float s; const float* st; const float* g; const float* b;
    __device__ __forceinline__ void operator()(const Acc& acc, const Unit& u, int wr, int wc, int fr, int fq) const {
        const int col0 = u.pn * BM + wc * 32 + 4 * fq;
#pragma unroll
        for (int ai = 0; ai < 2; ++ai)
#pragma unroll
            for (int bj = 0; bj < 2; ++bj) {
                f32x4 rv[4][2], gv[2], bv[2]; f32x2_t sv[4];
                const int c = col0 + bj * HALF;
                if (LNRES) {
#pragma unroll
                    for (int n = 0; n < 2; ++n) { gv[n] = *(const f32x4*)(g + c + n * 16); bv[n] = *(const f32x4*)(b + c + n * 16); }
                }
#pragma unroll
                for (int m = 0; m < 4; ++m) { const int row = u.pm * BM + ai * HALF + wr * 64 + m * 16 + fr; const size_t off = (size_t)row * DM + c;
                    if (LNRES) sv[m] = *(const f32x2_t*)(st + 2 * (size_t)row);
#pragma unroll
                    for (int n = 0; n < 2; ++n) rv[m][n] = *(const f32x4*)(res + off + n * 16); }
                asm volatile("" ::: "memory");
#pragma unroll
                for (int m = 0; m < 4; ++m) { const size_t off = (size_t)(u.pm * BM + ai * HALF + wr * 64 + m * 16 + fr) * DM + c;
#pragma unroll
                    for (int n = 0; n < 2; ++n) { f32x4 r = rv[m][n]; if (LNRES) r = (r - sv[m].x) * sv[m].y * gv[n] + bv[n];
                        *(f32x4*)(out + off + n * 16) = r * ALPHA + acc[ai][bj][m][n] * s; } }
                asm volatile("" ::: "memory");
            }
    }
};
struct EpiInProj {
    static constexpr bool PERM = true;
    bf16_t* Z; float* ZG;
    __device__ __forceinline__ void operator()(const Acc& acc, const Unit& u, int wr, int wc, int fr, int fq) const {
        const int row0 = u.pm * BM + wr * 64 + fr;
        if (u.pn < 19) {
            const float sc = (u.pn == 2 || u.pn == 3 || u.pn == 13 || u.pn == 14) ? C2 : 1.f;
            const int col0 = u.pn * BM + wc * 32 + 8 * fq;
#pragma unroll
            for (int ai = 0; ai < 2; ++ai)
#pragma unroll
                for (int m = 0; m < 4; ++m) { bf16_t* p = Z + (size_t)(row0 + ai * HALF + m * 16) * ZLD + col0;
#pragma unroll
                    for (int bj = 0; bj < 2; ++bj) { const f32x4 v0 = acc[ai][bj][m][0] * sc, v1 = acc[ai][bj][m][1] * sc;
                        u32x4 w; w.x = pk2(v0[0], v0[1]); w.y = pk2(v0[2], v0[3]); w.z = pk2(v1[0], v1[1]); w.w = pk2(v1[2], v1[3]);
                        *(u32x4*)(p + bj * HALF) = w; } }
        } else if (wc == 0 && fq < 2) {
#pragma unroll
            for (int ai = 0; ai < 2; ++ai)
#pragma unroll
                for (int m = 0; m < 4; ++m) { float* p = ZG + (size_t)(row0 + ai * HALF + m * 16) * 16 + 8 * fq;
                    *(f32x4*)p = acc[ai][0][m][0]; *(f32x4*)(p + 4) = acc[ai][0][m][1]; }
        }
    }
};
struct EpiPool {
    static constexpr bool PERM = true;
    bf16_t* Y; const float* scale;
    __device__ __forceinline__ void operator()(const Acc& acc, const Unit& u, int wr, int wc, int fr, int fq) const {
        const int row0 = u.pm * BM + wr * 64 + fr, col0 = u.pn * BM + wc * 32 + 8 * fq;
#pragma unroll
        for (int bj = 0; bj < 2; ++bj) {
            const f32x4 s0 = *(const f32x4*)(scale + col0 + bj * HALF), s1 = *(const f32x4*)(scale + col0 + bj * HALF + 4);
#pragma unroll
            for (int ai = 0; ai < 2; ++ai)
#pragma unroll
                for (int m = 0; m < 4; ++m) { bf16_t* p = Y + (size_t)(row0 + ai * HALF + m * 16) * DM + col0 + bj * HALF;
                    const f32x4 v0 = acc[ai][bj][m][0] * s0, v1 = acc[ai][bj][m][1] * s1;
                    u32x4 w; w.x = pk2(v0[0], v0[1]); w.y = pk2(v0[2], v0[3]); w.z = pk2(v1[0], v1[1]); w.w = pk2(v1[2], v1[3]);
                    *(u32x4*)p = w; }
        }
    }
};
struct EpiMerge {
    static constexpr bool PERM = true;
    u32x2* gsc; u32x4* msc; bf16_t* MG;
    __device__ __forceinline__ void operator()(const Acc& acc, const Unit& u, int wr, int wc, int fr, int fq) const {
        const int tid = (wr * 4 + wc) * 64 + fq * 16 + fr;
        u32x2* g = gsc + ((size_t)blockIdx.x * NTHR + tid) * 16;
        u32x4* ms = msc + ((size_t)blockIdx.x * NTHR + tid) * 16;
        const int b = u.kind >> 1;
        if ((u.kind & 1) == 0) {
#pragma unroll
            for (int ai = 0; ai < 2; ++ai)
#pragma unroll
                for (int bj = 0; bj < 2; ++bj)
#pragma unroll
                    for (int m = 0; m < 4; ++m) { const f32x4 a0 = acc[ai][bj][m][0], a1 = acc[ai][bj][m][1];
                        u32x2 w;
                        w.x = (unsigned)(sigmoidf_(a0[0]) * 255.f + 0.5f) | ((unsigned)(sigmoidf_(a0[1]) * 255.f + 0.5f) << 8) | ((unsigned)(sigmoidf_(a0[2]) * 255.f + 0.5f) << 16) | ((unsigned)(sigmoidf_(a0[3]) * 255.f + 0.5f) << 24);
                        w.y = (unsigned)(sigmoidf_(a1[0]) * 255.f + 0.5f) | ((unsigned)(sigmoidf_(a1[1]) * 255.f + 0.5f) << 8) | ((unsigned)(sigmoidf_(a1[2]) * 255.f + 0.5f) << 16) | ((unsigned)(sigmoidf_(a1[3]) * 255.f + 0.5f) << 24);
                        g[(ai * 2 + bj) * 4 + m] = w; }
            asm volatile("" ::: "memory");
        } else {
            const int row0 = u.pm * BM + wr * 64 + fr, col0 = u.pn * BM + wc * 32 + 8 * fq;
            const float k255 = 1.f / 255.f;
#pragma unroll
            for (int ai = 0; ai < 2; ++ai) {
                u32x2 gw[8]; u32x4 pv[8];
#pragma unroll
                for (int sl = 0; sl < 8; ++sl) gw[sl] = g[ai * 8 + sl];
                if (b > 0) {
#pragma unroll
                    for (int sl = 0; sl < 8; ++sl) pv[sl] = ms[ai * 8 + sl];
                }
#pragma unroll
                for (int bj = 0; bj < 2; ++bj)
#pragma unroll
                    for (int m = 0; m < 4; ++m) { const int hs = bj * 4 + m, slot = ai * 8 + hs; const u32x2 w = gw[hs];
                        f32x4 p0 = acc[ai][bj][m][0], p1 = acc[ai][bj][m][1];
                        p0[0] *= (float)(w.x & 255u) * k255; p0[1] *= (float)((w.x >> 8) & 255u) * k255; p0[2] *= (float)((w.x >> 16) & 255u) * k255; p0[3] *= (float)(w.x >> 24) * k255;
                        p1[0] *= (float)(w.y & 255u) * k255; p1[1] *= (float)((w.y >> 8) & 255u) * k255; p1[2] *= (float)((w.y >> 16) & 255u) * k255; p1[3] *= (float)(w.y >> 24) * k255;
                        if (b > 0) { const u32x4 q = pv[hs];
                            p0[0] += bflo(q.x); p0[1] += bfhi(q.x); p0[2] += bflo(q.y); p0[3] += bfhi(q.y); p1[0] += bflo(q.z); p1[1] += bfhi(q.z); p1[2] += bflo(q.w); p1[3] += bfhi(q.w); }
                        u32x4 o; o.x = pk2(p0[0], p0[1]); o.y = pk2(p0[2], p0[3]); o.z = pk2(p1[0], p1[1]); o.w = pk2(p1[2], p1[3]);
                        if (b < 3) ms[slot] = o;
                        else *(u32x4*)(MG + (size_t)(row0 + ai * HALF + m * 16) * DM + col0 + bj * HALF) = o; }
                asm volatile("" ::: "memory");
            }
        }
    }
};
}

struct Params {
    const float* x; const float* ln_g; const float* ln_b; const float* ffn1_w_in; const float* ffn1_w_out; const float* w_in; const float* pool_w; const float* pool_scale;
    const float* swa_sinks; const float* mlstm_conv; const float* mlstm_i_bias; const float* mlstm_f_bias; const float* fox_f_bias; const float* w_branch; const float* w_gate;
    const float* w_out; const float* ffn2_w_in; const float* ffn2_w_out; float* out; unsigned char* ws;
};

__device__ __forceinline__ int maprow(int kind, int n) {
    if (kind == 1) { const int type = n >= FF ? 1 : 0; const int j = n - type * FF; return (j >> 7) * 256 + type * 128 + (j & 127); }
    if (kind == 2) { if (n < 3328) return n; if (n < 3336) return 4864 + (n - 3328); if (n < 4872) return n - 8; return n; }
    return n;
}
__device__ __forceinline__ void tr_item(const float* W, int ldw, int ncols, int nblk, int item, bf16_t* dst, int dpitch, int dcol0, int mapkind, LAS float* scr, int lane) {
    const int kb = item / nblk, nb = item % nblk, k0 = 64 * kb, n0 = 32 * nb;
    const int nsrc = n0 + (lane & 31);
    float wv[32];
#pragma unroll
    for (int i = 0; i < 32; ++i) { const int kk = 2 * i + (lane >> 5); wv[i] = (nsrc < ncols) ? W[(size_t)(k0 + kk) * ldw + nsrc] : 0.f; }
#pragma unroll
    for (int i = 0; i < 32; ++i) { const int kk = 2 * i + (lane >> 5); scr[kk * 33 + (lane & 31)] = wv[i]; }
    asm volatile("s_waitcnt lgkmcnt(0)" ::: "memory");
    const int c = lane & 7;
#pragma unroll
    for (int j = 0; j < 4; ++j) { const int nn = (lane >> 3) + 8 * j; const int n = n0 + nn; const LAS float* s = scr + (8 * c) * 33 + nn;
        u32x4 o; o.x = pk2(s[0 * 33], s[1 * 33]); o.y = pk2(s[2 * 33], s[3 * 33]); o.z = pk2(s[4 * 33], s[5 * 33]); o.w = pk2(s[6 * 33], s[7 * 33]);
        if (n < ncols) *(u32x4*)(dst + (size_t)maprow(mapkind, n) * dpitch + dcol0 + k0 + 8 * c) = o; }
    asm volatile("s_waitcnt lgkmcnt(0)" ::: "memory");
}

__device__ __forceinline__ void phase_weights(const Params& p, int l, LAS unsigned char* lds, int wave_, int lane_, int G) {
    const int lane = lane_id(), wave = launder_s(wave_); (void)lane_;
    unsigned char* ws = launder_p(p.ws);
    LAS float* scr = (LAS float*)(lds + wave * 8448);
    const int gw = blockIdx.x * NWAVES + wave, NGW = G * NWAVES;
    const float* f1a = p.ffn1_w_in + (size_t)l * DM * 2 * FF; const float* f1b = p.ffn1_w_out + (size_t)l * FF * DM;
    const float* f2a = p.ffn2_w_in + (size_t)l * DM * 2 * FF; const float* f2b = p.ffn2_w_out + (size_t)l * FF * DM;
    const float* win = p.w_in + (size_t)l * DM * 4880; const float* wg = p.w_gate + (size_t)l * 4 * DM * DM; const float* wb = p.w_branch + (size_t)l * 4 * 512 * DM;
    const float* wo = p.w_out + (size_t)l * DM * DM; const float* pw = p.pool_w + (size_t)l * 4 * 128 * 128;
    constexpr int I_FA = 32 * 352, I_FB = 88 * 64, I_IN = 32 * 153, I_G = 4 * 32 * 64, I_B = 4 * 8 * 64, I_O = 32 * 64, I_P = 4 * 2 * 4;
    constexpr int NITEMS = 2 * I_FA + 2 * I_FB + I_IN + I_G + I_B + I_O + I_P;
    for (int it = gw; it < NITEMS; it += NGW) {
        int r = it;
        if (r < I_FA) { tr_item(f1a, 2 * FF, 2 * FF, 352, r, (bf16_t*)(ws + OW_F1A), DM, 0, 1, scr, lane); continue; } r -= I_FA;
        if (r < I_FA) { tr_item(f2a, 2 * FF, 2 * FF, 352, r, (bf16_t*)(ws + OW_F2A), DM, 0, 1, scr, lane); continue; } r -= I_FA;
        if (r < I_FB) { tr_item(f1b, DM, DM, 64, r, (bf16_t*)(ws + OW_F1B), FF, 0, 0, scr, lane); continue; } r -= I_FB;
        if (r < I_FB) { tr_item(f2b, DM, DM, 64, r, (bf16_t*)(ws + OW_F2B), FF, 0, 0, scr, lane); continue; } r -= I_FB;
        if (r < I_IN) { tr_item(win, 4880, 4880, 153, r, (bf16_t*)(ws + OW_IN), DM, 0, 2, scr, lane); continue; } r -= I_IN;
        if (r < I_G) { const int b = r / 2048, rr = r % 2048; tr_item(wg + (size_t)b * DM * DM, DM, DM, 64, rr, (bf16_t*)(ws + OW_G) + (size_t)b * DM * DM, DM, 0, 0, scr, lane); continue; } r -= I_G;
        if (r < I_B) { const int b = r / 512, rr = r % 512; tr_item(wb + (size_t)b * 512 * DM, DM, DM, 64, rr, (bf16_t*)(ws + OW_BC), DM, b * 512, 0, scr, lane); continue; } r -= I_B;
        if (r < I_O) { tr_item(wo, DM, DM, 64, r, (bf16_t*)(ws + OW_O), DM, 0, 0, scr, lane); continue; } r -= I_O;
        { const int g = r / 8, rr = r % 8; tr_item(pw + (size_t)g * 128 * 128, 128, 128, 4, rr, (bf16_t*)(ws + OW_BD) + (size_t)g * 128 * 512, 512, g * 128, 0, scr, lane); }
    }
    const int gt = blockIdx.x * NTHR + wave * 64 + lane, NGT = G * NTHR;
    const unsigned z0 = (unsigned)launder_v(0); const u32x4 zz = {z0, z0, z0, z0};
    { u32x4* zr = (u32x4*)((bf16_t*)(ws + OW_IN) + (size_t)4880 * DM); for (int i = gt; i < 240 * DM / 8; i += NGT) zr[i] = zz; }
    { u32x4* bd = (u32x4*)(ws + OW_BD); for (int i = gt; i < 512 * 512 / 8; i += NGT) { const int n = i / 64, k = (i % 64) * 8; if ((n >> 7) != (k >> 7)) bd[i] = zz; } }
    if (l == 0) {
        const f32x4* xs = (const f32x4*)p.x; u32x2* hb = (u32x2*)(ws + O_HB);
        for (int i = gt; i < S * DM / 4; i += NGT) { const f32x4 v = xs[i]; u32x2 w; w.x = pk2(v[0], v[1]); w.y = pk2(v[2], v[3]); hb[i] = w; }
    }
}

__device__ __forceinline__ float wave_sum(float v) {
#pragma unroll
    for (int o = 1; o < 64; o <<= 1) v += __shfl_xor(v, o);
    return v;
}
__device__ __forceinline__ void phase_ln(const float* Yin, float* Hout, bf16_t* hb, float* stats, const float* g, const float* b, int wave_, int lane_, int G) {
    const int lane = lane_id(), wave = launder_s(wave_); (void)lane_;
    const int gw = blockIdx.x * NWAVES + wave, NGW = G * NWAVES;
    for (int row = gw; row < S; row += 2 * NGW) {
        const int rowb = row + NGW;
        const f32x4* xa = (const f32x4*)(Yin + (size_t)row * DM) + lane; const f32x4* xb = (const f32x4*)(Yin + (size_t)rowb * DM) + lane;
        f32x4 va[8], vb[8]; float sa = 0.f, sb = 0.f;
#pragma unroll
        for (int j = 0; j < 8; ++j) { va[j] = xa[64 * j]; vb[j] = xb[64 * j]; }
#pragma unroll
        for (int j = 0; j < 8; ++j) { sa += (va[j][0] + va[j][1]) + (va[j][2] + va[j][3]); sb += (vb[j][0] + vb[j][1]) + (vb[j][2] + vb[j][3]); }
        const float ma = wave_sum(sa) * (1.f / DM), mb = wave_sum(sb) * (1.f / DM); float qa = 0.f, qb = 0.f;
#pragma unroll
        for (int j = 0; j < 8; ++j) { va[j] = va[j] - ma; vb[j] = vb[j] - mb;
            qa += (va[j][0] * va[j][0] + va[j][1] * va[j][1]) + (va[j][2] * va[j][2] + va[j][3] * va[j][3]);
            qb += (vb[j][0] * vb[j][0] + vb[j][1] * vb[j][1]) + (vb[j][2] * vb[j][2] + vb[j][3] * vb[j][3]); }
        const float ra = 1.f / sqrtf(wave_sum(qa) * (1.f / DM) + LN_EPS), rb = 1.f / sqrtf(wave_sum(qb) * (1.f / DM) + LN_EPS);
        if (stats && lane == 0) { stats[2 * (size_t)row] = ma; stats[2 * (size_t)row + 1] = ra; stats[2 * (size_t)rowb] = mb; stats[2 * (size_t)rowb + 1] = rb; }
        f32x4* ha = (f32x4*)(Hout + (size_t)row * DM) + lane; f32x4* hbp = (f32x4*)(Hout + (size_t)rowb * DM) + lane;
        u32x2* ba = (u32x2*)(hb + (size_t)row * DM) + lane; u32x2* bb = (u32x2*)(hb + (size_t)rowb * DM) + lane;
#pragma unroll
        for (int j = 0; j < 8; ++j) { const f32x4 gg = ((const f32x4*)g)[64 * j + lane], bbv = ((const f32x4*)b)[64 * j + lane];
            const f32x4 oa = va[j] * ra * gg + bbv, ob = vb[j] * rb * gg + bbv;
            if (Hout) { ha[64 * j] = oa; hbp[64 * j] = ob; }
            if (hb) { u32x2 w; w.x = pk2(oa[0], oa[1]); w.y = pk2(oa[2], oa[3]); ba[64 * j] = w; w.x = pk2(ob[0], ob[1]); w.y = pk2(ob[2], ob[3]); bb[64 * j] = w; } }
    }
}

__device__ __forceinline__ float scan_sum(float x, int lane) {
#pragma unroll
    for (int o = 1; o < 64; o <<= 1) { const float y = __shfl_up(x, o); if (lane >= o) x += y; }
    return x;
}
__device__ __forceinline__ float scan_max(float x, int lane) {
#pragma unroll
    for (int o = 1; o < 64; o <<= 1) { const float y = __shfl_up(x, o); if (lane >= o) x = fmaxf(x, y); }
    return x;
}
__device__ __forceinline__ void phase_post(const Params& p, int l, LAS unsigned char* lds, int wave_, int lane_, int G) {
    const int lane = lane_id(), wave = launder_s(wave_); (void)lane_;
    unsigned char* ws = launder_p(p.ws);
    bf16_t* Z = (bf16_t*)(ws + O_R1); const float* ZG = (const float*)(ws + O_ZG);
    LAS float* eL = (LAS float*)(lds + LDS_MISC);
    const int tid = wave * 64 + lane;
    LAS float* invL = (LAS float*)(lds + LDS_MISC + 1024);
    if (tid < 32) invL[tid] = exp2f(-(float)tid * 0.41524101186092029f);
    for (int c = blockIdx.x; c < S / 64; c += G) {
        const int t0 = c * 64;
        {
            const int t = t0 + lane;
            if (wave < 4) {
                const int h = wave;
                const float ip = ZG[(size_t)t * 16 + h] + p.mlstm_i_bias[l * 4 + h];
                const float lf = logsigmoidf_(ZG[(size_t)t * 16 + 4 + h] + p.mlstm_f_bias[l * 4 + h]);
                const float b = scan_sum(lf, lane);
                const float d = ip - b;
                const float a = scan_max(d, lane);
                const float dmax = __shfl(a, 63), bl = __shfl(b, 63);
                ((float*)(ws + O_MLA))[h * S + t] = a; ((float*)(ws + O_MLB))[h * S + t] = b; ((float*)(ws + O_MLD))[h * S + t] = d;
                eL[h * 64 + lane] = __expf(d - dmax);
                if (lane == 63) { ((float*)(ws + O_BLC))[c * 4 + h] = bl; ((float*)(ws + O_DMC))[c * 4 + h] = dmax; }
            }
            {
                const int h = wave;
                const float lf = logsigmoidf_(ZG[(size_t)t * 16 + 8 + h] + p.fox_f_bias[l * 8 + h]);
                const float cl = scan_sum(lf, lane) * LOG2E;
                ((float*)(ws + O_CL2))[h * S + t] = cl;
                if (lane == 63) ((float*)(ws + O_TOT2))[c * 8 + h] = cl;
            }
        }
        __syncthreads();
        for (int idx = tid; idx < 64 * 40; idx += NTHR) {
            const int tl = idx / 40, rem = idx % 40, hh = rem >> 2, i0 = (rem & 3) * 8, t = t0 + tl;
            bf16_t* px = Z + (size_t)t * ZLD + (hh < 8 ? ZC_QSWA + hh * 64 : ZC_KSWA + (hh - 8) * 64) + i0;
            const u32x4 a = *(const u32x4*)px, b = *(const u32x4*)(px + 32);
            float x1[8] = {bflo(a.x), bfhi(a.x), bflo(a.y), bfhi(a.y), bflo(a.z), bfhi(a.z), bflo(a.w), bfhi(a.w)};
            float x2[8] = {bflo(b.x), bfhi(b.x), bflo(b.y), bfhi(b.y), bflo(b.z), bfhi(b.z), bflo(b.w), bfhi(b.w)};
            float y1[8], y2[8];
#pragma unroll
            for (int j = 0; j < 8; ++j) {
                const float ang = (float)t * invL[i0 + j];
                double rev = (double)ang * 0.15915494309189535; rev -= rint(rev);
                const float rr = (float)(rev * 6.283185307179586);
                const float cs = __cosf(rr), sn = __sinf(rr);
                y1[j] = x1[j] * cs - x2[j] * sn; y2[j] = x2[j] * cs + x1[j] * sn;
            }
            u32x4 o1, o2;
            o1.x = pk2(y1[0], y1[1]); o1.y = pk2(y1[2], y1[3]); o1.z = pk2(y1[4], y1[5]); o1.w = pk2(y1[6], y1[7]);
            o2.x = pk2(y2[0], y2[1]); o2.y = pk2(y2[2], y2[3]); o2.z = pk2(y2[4], y2[5]); o2.w = pk2(y2[6], y2[7]);
            *(u32x4*)px = o1; *(u32x4*)(px + 32) = o2;
        }
        for (int idx = tid; idx < 128 + 512 + 512; idx += NTHR) {
            int col, h = 0; bf16_t* dst; bf16_t* dst2 = nullptr;
            if (idx < 128) { col = ZC_VSWA + idx; dst = (bf16_t*)(ws + O_VTS) + (size_t)idx * S; }
            else if (idx < 640) { const int cc = idx - 128; col = ZC_VFOX + cc; dst = (bf16_t*)(ws + O_VTF) + (size_t)cc * S; }
            else { const int cc = idx - 640; col = ZC_VML + cc; dst = (bf16_t*)(ws + O_VTM) + (size_t)cc * S; dst2 = (bf16_t*)(ws + O_VTW) + (size_t)cc * S; h = cc >> 7; }
            const bf16_t* __restrict__ src = launder_pv(Z + (size_t)t0 * ZLD + col);
            unsigned short v[64];
#pragma unroll
            for (int j = 0; j < 64; ++j) { v[j] = *src; src += ZLD; }
#pragma unroll
            for (int g8 = 0; g8 < 8; ++g8) { u32x4 w;
                w.x = (unsigned)v[8 * g8] | ((unsigned)v[8 * g8 + 1] << 16); w.y = (unsigned)v[8 * g8 + 2] | ((unsigned)v[8 * g8 + 3] << 16);
                w.z = (unsigned)v[8 * g8 + 4] | ((unsigned)v[8 * g8 + 5] << 16); w.w = (unsigned)v[8 * g8 + 6] | ((unsigned)v[8 * g8 + 7] << 16);
                *(u32x4*)(dst + t0 + 8 * g8) = w; }
            if (dst2) {
                const LAS float* e = eL + h * 64;
#pragma unroll
                for (int g8 = 0; g8 < 8; ++g8) { u32x4 w;
                    w.x = pk2(bf2f(v[8 * g8]) * e[8 * g8], bf2f(v[8 * g8 + 1]) * e[8 * g8 + 1]); w.y = pk2(bf2f(v[8 * g8 + 2]) * e[8 * g8 + 2], bf2f(v[8 * g8 + 3]) * e[8 * g8 + 3]);
                    w.z = pk2(bf2f(v[8 * g8 + 4]) * e[8 * g8 + 4], bf2f(v[8 * g8 + 5]) * e[8 * g8 + 5]); w.w = pk2(bf2f(v[8 * g8 + 6]) * e[8 * g8 + 6], bf2f(v[8 * g8 + 7]) * e[8 * g8 + 7]);
                    *(u32x4*)(dst2 + t0 + 8 * g8) = w; }
            }
        }
        for (int cc = tid; cc < 1024; cc += NTHR) {
            const float* cw = p.mlstm_conv + (size_t)l * 4 * 1024 + cc;
            const float w0 = cw[0], w1 = cw[1024], w2 = cw[2048], w3 = cw[3072];
            const bf16_t* __restrict__ src = launder_pv(Z + (size_t)(t0 >= 3 ? t0 - 3 : 0) * ZLD + ZC_QML + cc);
            unsigned short xv[67];
#pragma unroll
            for (int j = 0; j < 67; ++j) { const int tt = t0 - 3 + j; if (tt >= 0) { xv[j] = *src; src += ZLD; } else xv[j] = (unsigned short)0; }
            const float qs = cc < 512 ? 0.08838834764831845f : 1.f;
            bf16_t* dq = (bf16_t*)(ws + O_QKC) + (size_t)t0 * 1024 + cc;
            const int kc = cc - 512, h = (kc >= 0) ? (kc >> 7) : 0; const LAS float* e = eL + h * 64; float su = 0.f;
#pragma unroll
            for (int g8 = 0; g8 < 8; ++g8) {
                unsigned short ob[8];
#pragma unroll
                for (int j = 0; j < 8; ++j) { const int t = 8 * g8 + j;
                    const float y = w0 * bf2f(xv[t]) + w1 * bf2f(xv[t + 1]) + w2 * bf2f(xv[t + 2]) + w3 * bf2f(xv[t + 3]);
                    ob[j] = f2bf(y * sigmoidf_(y) * qs); dq[(size_t)t * 1024] = ob[j]; }
                if (cc >= 512) {
                    u32x4 w; w.x = (unsigned)ob[0] | ((unsigned)ob[1] << 16); w.y = (unsigned)ob[2] | ((unsigned)ob[3] << 16); w.z = (unsigned)ob[4] | ((unsigned)ob[5] << 16); w.w = (unsigned)ob[6] | ((unsigned)ob[7] << 16);
                    *(u32x4*)((bf16_t*)(ws + O_KTM) + (size_t)kc * S + t0 + 8 * g8) = w;
#pragma unroll
                    for (int j = 0; j < 8; ++j) su += e[8 * g8 + j] * bf2f(ob[j]);
                }
            }
            if (cc >= 512) ((float*)(ws + O_UN))[(size_t)c * 512 + kc] = su;
        }
        for (int cc = tid; cc < 512; cc += NTHR) {
            const int g = cc >> 7, win = 2 << g;
            const bf16_t* __restrict__ src = launder_pv(Z + (size_t)(t0 >= 15 ? t0 - 15 : 0) * ZLD + cc);
            unsigned short xv[79];
#pragma unroll
            for (int j = 0; j < 79; ++j) { const int tt = t0 - 15 + j; if (tt >= 0) { xv[j] = (j >= 16 - win) ? *src : (unsigned short)0; src += ZLD; } else xv[j] = (unsigned short)0; }
            float sacc = 0.f;
#pragma unroll
            for (int j = 0; j < 15; ++j) sacc += bf2f(xv[j]);
            bf16_t* dp = (bf16_t*)(ws + O_POOL) + (size_t)t0 * 512 + cc;
#pragma unroll
            for (int j = 0; j < 64; ++j) { const int t = t0 + j; const float x0 = bf2f(xv[15 + j]); sacc += x0;
                const int cnt = (t + 1) < win ? (t + 1) : win; dp[(size_t)j * 512] = f2bf(sacc / (float)cnt - x0);
                const float lv = (g == 0) ? bf2f(xv[15 + j - 1]) : (g == 1) ? bf2f(xv[15 + j - 3]) : (g == 2) ? bf2f(xv[15 + j - 7]) : bf2f(xv[15 + j - 15]);
                sacc -= lv; }
        }
        __syncthreads();
    }
}

#define MFMA32(a, b, c) __builtin_amdgcn_mfma_f32_32x32x16_bf16((a), (b), (c), 0, 0, 0)
template <bool FOX>
__device__ __forceinline__ void attn_unit(int h, int qb, const bf16_t* Z, const bf16_t* Vt, const float* cl2, const LAS float* P2L, float sink2, bf16_t* ybr, int lane) {
    const int q = lane & 31, hi = lane >> 5, t0 = qb * 32, t = t0 + q;
    const int qcol = FOX ? (ZC_QFOX + h * 64) : (ZC_QSWA + h * 64);
    const int kcol = FOX ? (ZC_KFOX + h * 64) : (ZC_KSWA + (h >> 2) * 64);
    const int ocol = FOX ? (1536 + h * 64) : (512 + h * 64);
    const bf16_t* Vth = Vt + (size_t)((FOX ? h : (h >> 2)) * 64 + q) * S + 16 * hi;
    const int pim = 16 * ((q >> 2) & 1) + 4 * (q >> 3) + (q & 3);
    const bf16_t* Kp = Z + (size_t)pim * ZLD + kcol + 8 * hi;
    const float* clh = cl2 + (size_t)h * S + 16 * hi;
    bf16x8 qf[4];
#pragma unroll
    for (int d0 = 0; d0 < 4; ++d0) qf[d0] = *(const bf16x8*)(Z + (size_t)t * ZLD + qcol + 16 * d0 + 8 * hi);
    const int kv_lo = FOX ? 0 : (t0 >= 128 ? t0 - 128 : 0);
    const int ntiles = (t0 - kv_lo) / 32 + 1;
    float mhat = FOX ? 0.f : sink2, l = FOX ? 0.f : (hi == 0 ? 1.f : 0.f);
    float cq = 0.f; if (FOX) cq = cl2[(size_t)h * S + t] + P2L[(t >> 6) * 8 + h];
    f32x16 o0, o1;
#pragma unroll
    for (int r = 0; r < 16; ++r) { o0[r] = 0.f; o1[r] = 0.f; }
    bf16x8 kf[4], vf[4]; f32x4 ck[4];
    {
        const int kv0 = kv_lo;
#pragma unroll
        for (int d0 = 0; d0 < 4; ++d0) kf[d0] = *(const bf16x8*)(Kp + (size_t)kv0 * ZLD + 16 * d0);
#pragma unroll
        for (int i = 0; i < 4; ++i) vf[i] = *(const bf16x8*)(Vth + (size_t)(i >> 1) * 32 * S + kv0 + 8 * (i & 1));
        if (FOX) {
#pragma unroll
            for (int i = 0; i < 4; ++i) ck[i] = *(const f32x4*)(clh + kv0 + 4 * i);
        }
    }
    for (int it = 0; it < ntiles; ++it) {
        const int kv0 = kv_lo + 32 * it;
        const int itn = (it + 1 < ntiles) ? it + 1 : it; const int kvn = kv_lo + 32 * itn;
        bf16x8 kfn[4], vfn[4]; f32x4 ckn[4];
#pragma unroll
        for (int d0 = 0; d0 < 4; ++d0) kfn[d0] = *(const bf16x8*)(Kp + (size_t)kvn * ZLD + 16 * d0);
#pragma unroll
        for (int i = 0; i < 4; ++i) vfn[i] = *(const bf16x8*)(Vth + (size_t)(i >> 1) * 32 * S + kvn + 8 * (i & 1));
        if (FOX) {
#pragma unroll
            for (int i = 0; i < 4; ++i) ckn[i] = *(const f32x4*)(clh + kvn + 4 * i);
        }
        f32x16 acc;
        if (FOX) {
            const float base = (cq - P2L[(kv0 >> 6) * 8 + h]) - mhat;
#pragma unroll
            for (int r = 0; r < 16; ++r) acc[r] = base - ck[r >> 2][r & 3];
        } else {
#pragma unroll
            for (int r = 0; r < 16; ++r) acc[r] = -mhat;
        }
#pragma unroll
        for (int d0 = 0; d0 < 4; ++d0) acc = MFMA32(kf[d0], qf[d0], acc);
        if (FOX) {
            if (it == ntiles - 1) {
#pragma unroll
                for (int r = 0; r < 16; ++r) if (16 * hi + r > q) acc[r] = -INFINITY;
            }
        } else {
#pragma unroll
            for (int r = 0; r < 16; ++r) { const int kv = kv0 + 16 * hi + r; if (kv > t || kv + 127 < t) acc[r] = -INFINITY; }
        }
        float mt = acc[0];
#pragma unroll
        for (int r = 1; r < 16; ++r) mt = fmaxf(mt, acc[r]);
        mt = fmaxf(mt, __shfl_xor(mt, 32));
        const bool first = FOX && (it == 0);
        if (first || __any(mt > 8.f)) {
            const float delta = first ? mt : fmaxf(mt, 0.f);
            mhat += delta;
            const float al = first ? 1.f : __builtin_amdgcn_exp2f(-delta);
            l *= al;
#pragma unroll
            for (int r = 0; r < 16; ++r) { acc[r] -= delta; o0[r] *= al; o1[r] *= al; }
        }
        float ps = 0.f;
#pragma unroll
        for (int r = 0; r < 16; ++r) { acc[r] = __builtin_amdgcn_exp2f(acc[r]); ps += acc[r]; }
        l += ps;
        u32x4 w0, w1;
        w0.x = pk2(acc[0], acc[1]); w0.y = pk2(acc[2], acc[3]); w0.z = pk2(acc[4], acc[5]); w0.w = pk2(acc[6], acc[7]);
        w1.x = pk2(acc[8], acc[9]); w1.y = pk2(acc[10], acc[11]); w1.z = pk2(acc[12], acc[13]); w1.w = pk2(acc[14], acc[15]);
        const bf16x8 pb0 = __builtin_bit_cast(bf16x8, w0), pb1 = __builtin_bit_cast(bf16x8, w1);
        o0 = MFMA32(vf[0], pb0, o0); o0 = MFMA32(vf[1], pb1, o0);
        o1 = MFMA32(vf[2], pb0, o1); o1 = MFMA32(vf[3], pb1, o1);
#pragma unroll
        for (int i = 0; i < 4; ++i) { kf[i] = kfn[i]; vf[i] = vfn[i]; if (FOX) ck[i] = ckn[i]; }
    }
    l += __shfl_xor(l, 32);
    const float inv = 1.f / l;
    bf16_t* op = ybr + (size_t)t * DM + ocol + 4 * hi;
#pragma unroll
    for (int g = 0; g < 4; ++g) {
        u32x2 w; w.x = pk2(o0[4 * g] * inv, o0[4 * g + 1] * inv); w.y = pk2(o0[4 * g + 2] * inv, o0[4 * g + 3] * inv); *(u32x2*)(op + 8 * g) = w;
        w.x = pk2(o1[4 * g] * inv, o1[4 * g + 1] * inv); w.y = pk2(o1[4 * g + 2] * inv, o1[4 * g + 3] * inv); *(u32x2*)(op + 32 + 8 * g) = w;
    }
}


__device__ __forceinline__ void fox_unit(int h, int Q, const bf16_t* Z, const bf16_t* Vt, const LAS float* clL, const LAS float* P2L, bf16_t* ybr, LAS unsigned char* lds, int wave, int lane) {
    const int q = lane & 31, hi = lane >> 5, t = Q * 256 + wave * 32 + q;
    const int kx = (q >> 1) & 7;
    const int my_last = 4 * Q + (wave >> 1), ntile = 4 * Q + 4;
    const int P = wave * 64 + lane, lrow = P >> 3, piece = (P & 7) ^ ((lrow >> 1) & 7);
    const int lr = lrow & 31, grow = 32 * (lrow >> 5) + 16 * ((lr >> 2) & 1) + 4 * (lr >> 3) + (lr & 3);
    const bf16_t* ksrc = Z + (size_t)grow * ZLD + ZC_KFOX + h * 64 + piece * 8;
    const bf16_t* vsrc = Vt + (size_t)(h * 64 + lrow) * S + piece * 8;
    const LAS float* clh = clL + 16 * hi;
    bf16x8 qf[4];
#pragma unroll
    for (int d0 = 0; d0 < 4; ++d0) qf[d0] = *(const bf16x8*)(Z + (size_t)t * ZLD + ZC_QFOX + h * 64 + 16 * d0 + 8 * hi);
    const float cq = clL[t] + P2L[(t >> 6) * 8 + h];
    float mhat = 0.f;
    f32x16 o0, o1, lacc;
#pragma unroll
    for (int r = 0; r < 16; ++r) { o0[r] = 0.f; o1[r] = 0.f; lacc[r] = 0.f; }
    const short one_ = (q == 0) ? (short)0x3F80 : (short)0;
    const bf16x8 ones = {one_, one_, one_, one_, one_, one_, one_, one_};
    asm volatile("s_waitcnt vmcnt(0)" ::: "memory");
    asm volatile("" : "+v"(qf[0]), "+v"(qf[1]), "+v"(qf[2]), "+v"(qf[3]));
#define FOX_DMA(T, SLOT) do { LAS unsigned char* d_ = lds + (SLOT) * 16384 + wave * 1024; \
        __builtin_amdgcn_global_load_lds((const unsigned*)(ksrc + (size_t)(64 * (T)) * ZLD), (LAS unsigned*)d_, 16, 0, 0); \
        __builtin_amdgcn_global_load_lds((const unsigned*)(vsrc + 64 * (T)), (LAS unsigned*)(d_ + 8192), 16, 0, 0); } while (0)
    FOX_DMA(0, 0); FOX_DMA(1, 1); FOX_DMA(2, 2);
    const int koff = q * 128, voff = 8192 + q * 128;
    const int v00 = ((2 * hi) ^ kx) * 16, v01 = ((2 * hi + 1) ^ kx) * 16, v10 = ((4 + 2 * hi) ^ kx) * 16, v11 = ((5 + 2 * hi) ^ kx) * 16;
#define FOX_QK(X0, X1, T) do { const float base_ = (cq - P2L[(T) * 8 + h]) - mhat; const LAS float* cp_ = clh + 64 * (T); \
        _Pragma("unroll") for (int j = 0; j < 4; ++j) { const f32x4 c0 = *(const LAS f32x4*)(cp_ + 4 * j), c1 = *(const LAS f32x4*)(cp_ + 32 + 4 * j); \
            _Pragma("unroll") for (int e = 0; e < 4; ++e) { X0[4 * j + e] = base_ - c0[e]; X1[4 * j + e] = base_ - c1[e]; } } \
        const LAS unsigned char* sk_ = lds + ((T) & 3) * 16384; bf16x8 kfa[4], kfb[4]; \
        _Pragma("unroll") for (int d0 = 0; d0 < 4; ++d0) { const int so = ((2 * d0 + hi) ^ kx) * 16; kfa[d0] = *(const LAS bf16x8*)(sk_ + koff + so); kfb[d0] = *(const LAS bf16x8*)(sk_ + 4096 + koff + so); } \
        _Pragma("unroll") for (int d0 = 0; d0 < 4; ++d0) { X0 = MFMA32(kfa[d0], qf[d0], X0); X1 = MFMA32(kfb[d0], qf[d0], X1); } } while (0)
#define FOX_STEP(C0, C1, N0, N1, I) do { const int i_ = (I); \
        if (i_ + 2 < ntile) asm volatile("s_waitcnt vmcnt(2) lgkmcnt(0)\n\ts_barrier" ::: "memory"); \
        else asm volatile("s_waitcnt vmcnt(0) lgkmcnt(0)\n\ts_barrier" ::: "memory"); \
        if (i_ + 3 < ntile) FOX_DMA(i_ + 3, (i_ + 3) & 3); \
        const bool actn_ = (i_ + 1 <= my_last); \
        if (actn_) FOX_QK(N0, N1, i_ + 1); \
        if (i_ <= my_last) { \
            if (pflag) { _Pragma("unroll") for (int r = 0; r < 16; ++r) { C0[r] -= pd; C1[r] -= pd; } } \
            if (i_ == my_last) { _Pragma("unroll") for (int r = 0; r < 16; ++r) { const int kv = 64 * i_ + 16 * hi + r; if (kv > t) C0[r] = -INFINITY; if (kv + 32 > t) C1[r] = -INFINITY; } } \
            float mt = fmaxf(C0[0], C1[0]); \
            _Pragma("unroll") for (int r = 1; r < 16; ++r) mt = fmaxf(mt, fmaxf(C0[r], C1[r])); \
            mt = fmaxf(mt, __shfl_xor(mt, 32)); \
            const bool first = (i_ == 0); \
            pflag = false; \
            if (first || __any(mt > 30.f)) { \
                const float delta = first ? mt : (mt > 0.f ? mt + 30.f : 0.f); \
                mhat += delta; pd = delta; pflag = true; \
                const float al = first ? 1.f : __builtin_amdgcn_exp2f(-delta); \
                lacc[0] *= al; \
                _Pragma("unroll") for (int r = 0; r < 16; ++r) { C0[r] -= delta; C1[r] -= delta; o0[r] *= al; o1[r] *= al; } \
            } \
            _Pragma("unroll") for (int r = 0; r < 16; ++r) { C0[r] = __builtin_amdgcn_exp2f(C0[r]); C1[r] = __builtin_amdgcn_exp2f(C1[r]); } \
            u32x4 w0, w1, w2, w3; \
            w0.x = pk2(C0[0], C0[1]); w0.y = pk2(C0[2], C0[3]); w0.z = pk2(C0[4], C0[5]); w0.w = pk2(C0[6], C0[7]); \
            w1.x = pk2(C0[8], C0[9]); w1.y = pk2(C0[10], C0[11]); w1.z = pk2(C0[12], C0[13]); w1.w = pk2(C0[14], C0[15]); \
            w2.x = pk2(C1[0], C1[1]); w2.y = pk2(C1[2], C1[3]); w2.z = pk2(C1[4], C1[5]); w2.w = pk2(C1[6], C1[7]); \
            w3.x = pk2(C1[8], C1[9]); w3.y = pk2(C1[10], C1[11]); w3.z = pk2(C1[12], C1[13]); w3.w = pk2(C1[14], C1[15]); \
            const bf16x8 pb0 = __builtin_bit_cast(bf16x8, w0), pb1 = __builtin_bit_cast(bf16x8, w1), pb2 = __builtin_bit_cast(bf16x8, w2), pb3 = __builtin_bit_cast(bf16x8, w3); \
            const LAS unsigned char* sl = lds + (i_ & 3) * 16384; \
            const bf16x8 va0 = *(const LAS bf16x8*)(sl + voff + v00), vb0 = *(const LAS bf16x8*)(sl + voff + 4096 + v00), va1 = *(const LAS bf16x8*)(sl + voff + v01), vb1 = *(const LAS bf16x8*)(sl + voff + 4096 + v01); \
            const bf16x8 va2 = *(const LAS bf16x8*)(sl + voff + v10), vb2 = *(const LAS bf16x8*)(sl + voff + 4096 + v10), va3 = *(const LAS bf16x8*)(sl + voff + v11), vb3 = *(const LAS bf16x8*)(sl + voff + 4096 + v11); \
            o0 = MFMA32(va0, pb0, o0); o1 = MFMA32(vb0, pb0, o1); lacc = MFMA32(ones, pb0, lacc); \
            o0 = MFMA32(va1, pb1, o0); o1 = MFMA32(vb1, pb1, o1); lacc = MFMA32(ones, pb1, lacc); \
            o0 = MFMA32(va2, pb2, o0); o1 = MFMA32(vb2, pb2, o1); lacc = MFMA32(ones, pb2, lacc); \
            o0 = MFMA32(va3, pb3, o0); o1 = MFMA32(vb3, pb3, o1); lacc = MFMA32(ones, pb3, lacc); \
        } } while (0)
    f32x16 sa0, sa1, sb0, sb1; bool pflag = false; float pd = 0.f;
    asm volatile("s_waitcnt vmcnt(4) lgkmcnt(0)\n\ts_barrier" ::: "memory");
    FOX_QK(sa0, sa1, 0);
    for (int i = 0; i < ntile; i += 2) {
        FOX_STEP(sa0, sa1, sb0, sb1, i);
        FOX_STEP(sb0, sb1, sa0, sa1, i + 1);
    }
#undef FOX_STEP
#undef FOX_QK
#undef FOX_DMA
    float l = (hi == 0) ? lacc[0] : 0.f;
    l += __shfl_xor(l, 32);
    const float inv = 1.f / l;
    bf16_t* op = ybr + (size_t)t * DM + 1536 + h * 64 + 4 * hi;
#pragma unroll
    for (int g = 0; g < 4; ++g) {
        u32x2 w; w.x = pk2(o0[4 * g] * inv, o0[4 * g + 1] * inv); w.y = pk2(o0[4 * g + 2] * inv, o0[4 * g + 3] * inv); *(u32x2*)(op + 8 * g) = w;
        w.x = pk2(o1[4 * g] * inv, o1[4 * g + 1] * inv); w.y = pk2(o1[4 * g + 2] * inv, o1[4 * g + 3] * inv); *(u32x2*)(op + 32 + 8 * g) = w;
    }
    asm volatile("s_waitcnt vmcnt(0) lgkmcnt(0)\n\ts_barrier" ::: "memory");
}

__device__ __forceinline__ void phase_mix1(const Params& p, int l, LAS unsigned char* lds, int wave_, int lane_, int G) {
    const int lane = lane_id(), wave = launder_s(wave_); (void)lane_;
    unsigned char* ws = launder_p(p.ws);
    LAS float* P2L = (LAS float*)(lds + LDS_P2);
    {
        const float* tot = (const float*)(ws + O_TOT2); const int h = wave;
        const float a0 = tot[(4 * lane) * 8 + h], a1 = tot[(4 * lane + 1) * 8 + h], a2 = tot[(4 * lane + 2) * 8 + h], a3 = tot[(4 * lane + 3) * 8 + h];
        const float incl = scan_sum(a0 + a1 + a2 + a3, lane); const float ex = incl - (a0 + a1 + a2 + a3);
        P2L[(4 * lane) * 8 + h] = ex; P2L[(4 * lane + 1) * 8 + h] = ex + a0; P2L[(4 * lane + 2) * 8 + h] = ex + a0 + a1; P2L[(4 * lane + 3) * 8 + h] = ex + a0 + a1 + a2;
    }
    __syncthreads();
    if (DBG_MIX & 1) {
        pg8::SimpleSched Sd{(const char*)(ws + O_POOL), (const char*)(ws + OW_BD), 512, 512, 64, 2, G, (int)blockIdx.x, 8};
        pg8::EpiPool E{(bf16_t*)(ws + O_YBR), p.pool_scale + (size_t)l * 512};
        pg8::gemm_phase(lds, 512, 512, Sd, E, wave);
    }
    const int gw = blockIdx.x * NWAVES + wave, NGW = G * NWAVES;
    const int q = lane & 31, hi = lane >> 5;
    if (DBG_MIX & 2) for (int task = gw; task < 4096; task += NGW) {
        const int vb = task & 3, h = (task >> 2) & 3, c = task >> 4;
        const bf16_t* Ap = (const bf16_t*)(ws + O_VTW) + (size_t)(h * 128 + 32 * vb + q) * S + c * 64 + 8 * hi;
        bf16x8 af[4];
#pragma unroll
        for (int ks = 0; ks < 4; ++ks) af[ks] = *(const bf16x8*)(Ap + 16 * ks);
        float* Uo = (float*)(ws + O_U) + ((size_t)(c * 4 + h) * 128 + 32 * vb) * 128;
#pragma unroll
        for (int kb = 0; kb < 4; ++kb) {
            const bf16_t* Bp = (const bf16_t*)(ws + O_KTM) + (size_t)(h * 128 + 32 * kb + q) * S + c * 64 + 8 * hi;
            f32x16 acc;
#pragma unroll
            for (int r = 0; r < 16; ++r) acc[r] = 0.f;
#pragma unroll
            for (int ks = 0; ks < 4; ++ks) acc = MFMA32(af[ks], *(const bf16x8*)(Bp + 16 * ks), acc);
#pragma unroll
            for (int r = 0; r < 16; ++r) Uo[(size_t)crow(r, hi) * 128 + 32 * kb + q] = acc[r];
        }
    }
    if (DBG_MIX & 4) for (int task = gw; task < 4096; task += NGW) {
        const int h = task & 7, qb = task >> 3;
        attn_unit<false>(h, qb, (const bf16_t*)(ws + O_R1), (const bf16_t*)(ws + O_VTS), nullptr, P2L, p.swa_sinks[l * 8 + h] * LOG2E, (bf16_t*)(ws + O_YBR), lane);
    }
    __syncthreads();
    if (DBG_MIX & 8) {
        const int h = blockIdx.x & 7;
        LAS float* clL = (LAS float*)(lds + 65536);
        { const f32x4* src = (const f32x4*)((const float*)(ws + O_CL2) + (size_t)h * S); const int tid = wave * 64 + lane;
#pragma unroll
          for (int j = 0; j < 8; ++j) *(LAS f32x4*)(clL + 4 * (tid + j * NTHR)) = src[tid + j * NTHR]; }
        __syncthreads();
        for (int pr = (blockIdx.x >> 3); pr < 32; pr += (G >> 3)) {
            fox_unit(h, 63 - pr, (const bf16_t*)(ws + O_R1), (const bf16_t*)(ws + O_VTF), clL, P2L, (bf16_t*)(ws + O_YBR), lds, wave, lane);
            fox_unit(h, pr, (const bf16_t*)(ws + O_R1), (const bf16_t*)(ws + O_VTF), clL, P2L, (bf16_t*)(ws + O_YBR), lds, wave, lane);
        }
    }
}

__device__ __forceinline__ void phase_scan(const Params& p, LAS unsigned char* lds, int wave_, int G) {
    unsigned char* ws = launder_p(p.ws); const int tid = launder_s(wave_) * 64 + lane_id();
    if ((int)blockIdx.x * NTHR >= 4 * 16512) return;
    LAS float* decL = (LAS float*)lds; LAS float* sclL = decL + 1024;
    {
        const int wv = tid >> 6, ln = tid & 63;
        if (wv < 4) {
            const int h = wv; const float* BL = (const float*)(ws + O_BLC); const float* DMX = (const float*)(ws + O_DMC);
            float bl[4], dm[4], B[5], M[5];
#pragma unroll
            for (int j = 0; j < 4; ++j) { bl[j] = BL[(4 * ln + j) * 4 + h]; dm[j] = DMX[(4 * ln + j) * 4 + h]; }
            const float s4 = (bl[0] + bl[1]) + (bl[2] + bl[3]);
            const float incl = scan_sum(s4, ln);
            B[0] = incl - s4; B[1] = B[0] + bl[0]; B[2] = B[1] + bl[1]; B[3] = B[2] + bl[2]; B[4] = B[3] + bl[3];
            float E[4];
#pragma unroll
            for (int j = 0; j < 4; ++j) E[j] = dm[j] - B[j];
            const float mx4 = fmaxf(fmaxf(E[0], E[1]), fmaxf(E[2], E[3]));
            const float inclm = scan_max(mx4, ln);
            const float up = __shfl_up(inclm, 1);
            M[0] = fmaxf(0.f, ln == 0 ? -INFINITY : up); M[1] = fmaxf(M[0], E[0]); M[2] = fmaxf(M[1], E[1]); M[3] = fmaxf(M[2], E[2]); M[4] = fmaxf(M[3], E[3]);
#pragma unroll
            for (int j = 0; j < 4; ++j) { const float mc = M[j] + B[j], mn = M[j + 1] + B[j + 1]; const int c = 4 * ln + j;
                decL[c * 4 + h] = __expf(bl[j] + mc - mn); sclL[c * 4 + h] = __expf(bl[j] + dm[j] - mn);
                if (blockIdx.x == 0) ((float*)(ws + O_MST))[c * 4 + h] = mc; }
        }
    }
    __syncthreads();
    const int e = blockIdx.x * NTHR + tid;
    if (e < 4 * 16512) {
        const int h = e / 16512, idx = e % 16512;
        float st = 0.f;
        if (idx < 16384) {
            const float* src = (const float*)(ws + O_U) + (size_t)h * 16384 + idx; bf16_t* dst = (bf16_t*)(ws + O_CST) + (size_t)h * 16384 + idx;
            for (int c0 = 0; c0 < 256; c0 += 32) {
                float u[32];
#pragma unroll
                for (int j = 0; j < 32; ++j) u[j] = src[(size_t)(c0 + j) * 65536];
#pragma unroll
                for (int j = 0; j < 32; ++j) { dst[(size_t)(c0 + j) * 65536] = f2bf(st); st = decL[(c0 + j) * 4 + h] * st + sclL[(c0 + j) * 4 + h] * u[j]; }
            }
        } else {
            const int k = idx - 16384;
            const float* src = (const float*)(ws + O_UN) + h * 128 + k; float* dst = (float*)(ws + O_NST) + h * 128 + k;
            for (int c0 = 0; c0 < 256; c0 += 8) {
                float u[8];
#pragma unroll
                for (int j = 0; j < 8; ++j) u[j] = src[(size_t)(c0 + j) * 512];
#pragma unroll
                for (int j = 0; j < 8; ++j) { dst[(size_t)(c0 + j) * 512] = st; st = decL[(c0 + j) * 4 + h] * st + sclL[(c0 + j) * 4 + h] * u[j]; }
            }
        }
    }
}

__device__ __forceinline__ void phase_mlout(const Params& p, int wave_, int lane_, int G) {
    const int lane = lane_id(), wave = launder_s(wave_); (void)lane_;
    unsigned char* ws = launder_p(p.ws);
    const int gw = blockIdx.x * NWAVES + wave, NGW = G * NWAVES;
    const int q = lane & 31, hi = lane >> 5;
    const int pim = 16 * ((q >> 2) & 1) + 4 * (q >> 3) + (q & 3);
    const bf16_t* QKC = (const bf16_t*)(ws + O_QKC); const bf16_t* Z = (const bf16_t*)(ws + O_R1);
    for (int task = gw; task < 2048; task += NGW) {
        const int tb = task & 1, h = (task >> 1) & 3, c = task >> 3;
        const int t = c * 64 + 32 * tb + q;
        bf16x8 qf[8];
#pragma unroll
        for (int kk = 0; kk < 8; ++kk) qf[kk] = *(const bf16x8*)(QKC + (size_t)t * 1024 + h * 128 + 16 * kk + 8 * hi);
        const float m_c = ((const float*)(ws + O_MST))[c * 4 + h];
        const float a_t = ((const float*)(ws + O_MLA))[h * S + t], b_t = ((const float*)(ws + O_MLB))[h * S + t];
        const float Mt = fmaxf(m_c, a_t), w_inter = __expf(m_c - Mt);
        f32x16 o[4];
#pragma unroll
        for (int vb = 0; vb < 4; ++vb) {
#pragma unroll
            for (int r = 0; r < 16; ++r) o[vb][r] = 0.f;
            const bf16_t* Cp = (const bf16_t*)(ws + O_CST) + ((size_t)(c * 4 + h) * 128 + 32 * vb + q) * 128 + 8 * hi;
#pragma unroll
            for (int kk = 0; kk < 8; ++kk) o[vb] = MFMA32(*(const bf16x8*)(Cp + 16 * kk), qf[kk], o[vb]);
#pragma unroll
            for (int r = 0; r < 16; ++r) o[vb][r] *= w_inter;
        }
        float nq = 0.f;
        {
            const float* np = (const float*)(ws + O_NST) + (size_t)(c * 4 + h) * 128 + 8 * hi;
#pragma unroll
            for (int kk = 0; kk < 8; ++kk) { const f32x4 n0 = *(const f32x4*)(np + 16 * kk), n1 = *(const f32x4*)(np + 16 * kk + 4);
                const bf16x8 qq = qf[kk];
                nq += n0[0] * bf2f((unsigned short)qq[0]) + n0[1] * bf2f((unsigned short)qq[1]) + n0[2] * bf2f((unsigned short)qq[2]) + n0[3] * bf2f((unsigned short)qq[3])
                    + n1[0] * bf2f((unsigned short)qq[4]) + n1[1] * bf2f((unsigned short)qq[5]) + n1[2] * bf2f((unsigned short)qq[6]) + n1[3] * bf2f((unsigned short)qq[7]); }
            nq += __shfl_xor(nq, 32);
        }
        float den = 0.f;
        for (int sb = 0; sb <= tb; ++sb) {
            const int s0 = c * 64 + 32 * sb;
            f32x16 acc;
#pragma unroll
            for (int r = 0; r < 16; ++r) acc[r] = 0.f;
            const bf16_t* Kp = QKC + (size_t)(s0 + pim) * 1024 + 512 + h * 128 + 8 * hi;
#pragma unroll
            for (int kk = 0; kk < 8; ++kk) acc = MFMA32(*(const bf16x8*)(Kp + 16 * kk), qf[kk], acc);
            const float* dp = (const float*)(ws + O_MLD) + (size_t)h * S + s0 + 16 * hi;
#pragma unroll
            for (int r = 0; r < 16; ++r) { const int s = s0 + 16 * hi + r; const float w = (s <= t) ? __expf(dp[r] - Mt) : 0.f; acc[r] *= w; den += acc[r]; }
            u32x4 w0, w1;
            w0.x = pk2(acc[0], acc[1]); w0.y = pk2(acc[2], acc[3]); w0.z = pk2(acc[4], acc[5]); w0.w = pk2(acc[6], acc[7]);
            w1.x = pk2(acc[8], acc[9]); w1.y = pk2(acc[10], acc[11]); w1.z = pk2(acc[12], acc[13]); w1.w = pk2(acc[14], acc[15]);
            const bf16x8 pb0 = __builtin_bit_cast(bf16x8, w0), pb1 = __builtin_bit_cast(bf16x8, w1);
#pragma unroll
            for (int vb = 0; vb < 4; ++vb) {
                const bf16_t* Vp = (const bf16_t*)(ws + O_VTM) + (size_t)(h * 128 + 32 * vb + q) * S + s0 + 16 * hi;
                o[vb] = MFMA32(*(const bf16x8*)Vp, pb0, o[vb]); o[vb] = MFMA32(*(const bf16x8*)(Vp + 8), pb1, o[vb]);
            }
        }
        den += __shfl_xor(den, 32);
        den += w_inter * nq;
        const float hd = fmaxf(fabsf(den), __expf(-(b_t + Mt))); const float inv = 1.f / hd;
        const bf16_t* opre = Z + (size_t)t * ZLD + ZC_OML + h * 128 + 4 * hi;
        bf16_t* op = (bf16_t*)(ws + O_YBR) + (size_t)t * DM + 1024 + h * 128 + 4 * hi;
#pragma unroll
        for (int vb = 0; vb < 4; ++vb)
#pragma unroll
            for (int g = 0; g < 4; ++g) {
                const u32x2 og = *(const u32x2*)(opre + 32 * vb + 8 * g);
                u32x2 w; w.x = pk2(sigmoidf_(bflo(og.x)) * o[vb][4 * g] * inv, sigmoidf_(bfhi(og.x)) * o[vb][4 * g + 1] * inv);
                w.y = pk2(sigmoidf_(bflo(og.y)) * o[vb][4 * g + 2] * inv, sigmoidf_(bfhi(og.y)) * o[vb][4 * g + 3] * inv);
                *(u32x2*)(op + 32 * vb + 8 * g) = w;
            }
    }
}


__device__ __forceinline__ void dbg_dump(float* out, const void* src, int mode, int wave, int G) {
    const int gt = blockIdx.x * NTHR + wave * 64 + lane_id(), NGT = G * NTHR;
    for (int i = gt; i < S * DM; i += NGT) out[i] = mode ? bf2f(((const bf16_t*)src)[i]) : ((const float*)src)[i];
}
#define DBG_AT(k, off, mode) do { if (DBG_STOP == (k) && l == 0) { GRID_SYNC(15); dbg_dump(p.out, p.ws + (off), (mode), wave, G); return; } } while (0)
#define XB_TMO      128
#define XB_XCNT(j)  (256  + 64 * (j))
#define XB_XSUB(j)  (1280 + 64 * (j))
#define XB_XGEN(j)  (2304 + 64 * (j))
#define XB_TOP      3328
#define XB_TOPGEN   3392
#define XB_SPIN_CAP (1u << 22)
__device__ __forceinline__ unsigned xb_ld(unsigned* p)              { return __hip_atomic_load(p, __ATOMIC_RELAXED, __HIP_MEMORY_SCOPE_AGENT); }
__device__ __forceinline__ unsigned xb_add(unsigned* p, unsigned v) { return __hip_atomic_fetch_add(p, v, __ATOMIC_RELAXED, __HIP_MEMORY_SCOPE_AGENT); }
__device__ __forceinline__ unsigned xb_xcc_id() { return (unsigned)__builtin_amdgcn_s_getreg((3 << 11) | 20) & 0xFu; }
#define XB_SPIN(cond, bar) do { unsigned _sp = 0; while (cond) { __builtin_amdgcn_s_sleep(1); \
    if ((++_sp & 255u) == 0u) { if (xb_ld(&(bar)[XB_TMO])) break; if (_sp > XB_SPIN_CAP) { atomicAdd(&(bar)[XB_TMO], 1u); break; } } } } while (0)
__device__ __forceinline__ void xcd_census(unsigned* bar, unsigned x, unsigned G, unsigned& nloc, unsigned& nx) {
    unsigned sum, cnt, mine, sp = 0u;
    for (;;) {
        sum = 0u; cnt = 0u; mine = 0u;
#pragma unroll
        for (unsigned j = 0; j < 16; ++j) { const unsigned c = xb_ld(&bar[XB_XCNT(j)]); sum += c; cnt += (c > 0u) ? 1u : 0u; mine = (j == x) ? c : mine; }
        if (sum == G) break;
        __builtin_amdgcn_s_sleep(1);
        if ((++sp & 255u) == 0u) { if (xb_ld(&bar[XB_TMO])) break; if (sp > XB_SPIN_CAP) { atomicAdd(&bar[XB_TMO], 1u); break; } }
    }
    nloc = mine > 0u ? mine : 1u; nx = cnt > 0u ? cnt : 1u;
}
__device__ __forceinline__ void grid_barrier(unsigned* bar, volatile LAS unsigned* st, unsigned G, int wave) {
    asm volatile("s_waitcnt vmcnt(0) lgkmcnt(0)" ::: "memory");
    __syncthreads();
    if (wave == 0 && lane_id() == 0) {
        const unsigned x = xb_xcc_id();
        unsigned nloc = st[0], nx = st[1];
        if (nloc == 0u) { xcd_census(bar, x, G, nloc, nx); st[0] = nloc; st[1] = nx; }
        const unsigned old = xb_add(&bar[XB_XSUB(x)], 1u);
        const unsigned gen = old / nloc;
        if (old + 1u == (gen + 1u) * nloc) {
            __builtin_amdgcn_fence(__ATOMIC_RELEASE, "agent");
            asm volatile("s_waitcnt vmcnt(0)" ::: "memory");
            const unsigned og = xb_add(&bar[XB_TOP], 1u);
            const unsigned tg = og / nx;
            if (og + 1u == (tg + 1u) * nx) xb_add(&bar[XB_TOPGEN], 1u);
            else XB_SPIN(xb_ld(&bar[XB_TOPGEN]) == tg, bar);
            __builtin_amdgcn_fence(__ATOMIC_ACQUIRE, "agent");
            xb_add(&bar[XB_XGEN(x)], 1u);
            asm volatile("s_waitcnt vmcnt(0)" ::: "memory");
        } else {
            XB_SPIN(xb_ld(&bar[XB_XGEN(x)]) == gen, bar);
            __builtin_amdgcn_fence(__ATOMIC_ACQUIRE, "agent");
            asm volatile("s_waitcnt vmcnt(0)" ::: "memory");
        }
    }
    __syncthreads();
}
#define GRID_SYNC(k) grid_barrier((unsigned*)(p.ws + O_CTL), (volatile LAS unsigned*)(lds + LDS_MISC + 2048), (unsigned)G, wave)
__global__ void __launch_bounds__(NTHR, 2) fwd_megakernel(Params p) {
    extern __shared__ __attribute__((aligned(16))) unsigned char lds_raw[];
    LAS unsigned char* lds = (LAS unsigned char*)lds_raw;
    cg::grid_group grid = cg::this_grid();
    const int wave = __builtin_amdgcn_readfirstlane((int)threadIdx.x >> 6), lane = 0;
    const int G = gridDim.x, bx = blockIdx.x;
    grid.sync();
    if (wave == 0 && lane_id() == 0) { volatile LAS unsigned* st = (volatile LAS unsigned*)(lds + LDS_MISC + 2048); st[0] = 0u; st[1] = 0u; (void)xb_add((unsigned*)(p.ws + O_CTL) + XB_XCNT(xb_xcc_id()), 1u); }
    __syncthreads();

    for (int l = 0; l < NL; ++l) {
        if (l == 0) { REPS(3) phase_weights(p, 0, lds, wave, lane, G);
            GRID_SYNC(0); }
        REPS(2) { unsigned char* ws = launder_p(p.ws); pg8::SimpleSched Sd{(const char*)(ws + O_HB), (const char*)(ws + OW_F1A), DM, DM, 64, 44, G, bx, 32}; pg8::EpiSwiGLU E{(bf16_t*)(ws + O_R1)}; pg8::gemm_phase(lds, DM, DM, Sd, E, wave); }
        GRID_SYNC(1);
        if (l == 0) { unsigned char* ws = launder_p(p.ws); pg8::SimpleSched Sd{(const char*)(ws + O_R1), (const char*)(ws + OW_F1B), FF, FF, 64, 8, G, bx, 88}; pg8::EpiResid<false> E{p.x, (float*)(ws + O_H), 0.5f, nullptr, nullptr, nullptr}; pg8::gemm_phase(lds, FF, FF, Sd, E, wave); }
        else { unsigned char* ws = launder_p(p.ws); pg8::SimpleSched Sd{(const char*)(ws + O_R1), (const char*)(ws + OW_F1B), FF, FF, 64, 8, G, bx, 88}; pg8::EpiResid<true> E{(const float*)(ws + O_H), (float*)(ws + O_H), 0.5f, (const float*)(ws + O_ST), p.ln_g + (size_t)(l * 3 - 1) * DM, p.ln_b + (size_t)(l * 3 - 1) * DM}; pg8::gemm_phase(lds, FF, FF, Sd, E, wave); }
        GRID_SYNC(2);
        REPS(7) { unsigned char* ws = launder_p(p.ws); const bool dummy = (REP_PHASE == 7) && (rep_ == 0); phase_ln((const float*)(ws + O_H), dummy ? (float*)(ws + O_YBR) : nullptr, (bf16_t*)(ws + (dummy ? O_U : O_HB)), (float*)(ws + O_ST), p.ln_g + (size_t)(l * 3 + 0) * DM, p.ln_b + (size_t)(l * 3 + 0) * DM, wave, lane, G); }
        GRID_SYNC(3);
        DBG_AT(1, O_H, 0);
        { unsigned char* ws = launder_p(p.ws); pg8::SimpleSched Sd{(const char*)(ws + O_HB), (const char*)(ws + OW_IN), DM, DM, 64, 20, G, bx, 32}; pg8::EpiInProj E{(bf16_t*)(ws + O_R1), (float*)(ws + O_ZG)}; pg8::gemm_phase(lds, DM, DM, Sd, E, wave); }
        GRID_SYNC(4);
        DBG_AT(2, O_R1, 1);
        phase_post(p, l, lds, wave, lane, G);
        GRID_SYNC(5);
        DBG_AT(3, O_QKC, 1);
        REPS(1) phase_mix1(p, l, lds, wave, lane, G);
        GRID_SYNC(6);
        DBG_AT(4, O_YBR, 1);
        REPS(6) phase_scan(p, lds, wave, G);
        GRID_SYNC(7);
        REPS(5) phase_mlout(p, wave, lane, G);
        GRID_SYNC(8);
        DBG_AT(5, O_YBR, 1);
        REPS(4) { unsigned char* ws = launder_p(p.ws); pg8::MergeSched Sd{(const char*)(ws + O_HB), (const char*)(ws + O_YBR), (const char*)(ws + OW_G), (const char*)(ws + OW_BC), G, bx};
          pg8::EpiMerge E{(u32x2*)(ws + O_GSC), (u32x4*)(ws + O_MSC), (bf16_t*)(ws + O_MERGED)}; pg8::gemm_phase(lds, DM, DM, Sd, E, wave); }
        GRID_SYNC(9);
        DBG_AT(6, O_MERGED, 1);
        { unsigned char* ws = launder_p(p.ws); pg8::SimpleSched Sd{(const char*)(ws + O_MERGED), (const char*)(ws + OW_O), DM, DM, 64, 8, G, bx, 32}; pg8::EpiResid<true> E{(const float*)(ws + O_H), (float*)(ws + O_H), 1.0f, (const float*)(ws + O_ST), p.ln_g + (size_t)(l * 3 + 0) * DM, p.ln_b + (size_t)(l * 3 + 0) * DM}; pg8::gemm_phase(lds, DM, DM, Sd, E, wave); }
        GRID_SYNC(10);
        { unsigned char* ws = launder_p(p.ws); phase_ln((const float*)(ws + O_H), nullptr, (bf16_t*)(ws + O_HB), (float*)(ws + O_ST), p.ln_g + (size_t)(l * 3 + 1) * DM, p.ln_b + (size_t)(l * 3 + 1) * DM, wave, lane, G); }
        GRID_SYNC(11);
        DBG_AT(7, O_H, 0);
        { unsigned char* ws = launder_p(p.ws); pg8::SimpleSched Sd{(const char*)(ws + O_HB), (const char*)(ws + OW_F2A), DM, DM, 64, 44, G, bx, 32}; pg8::EpiSwiGLU E{(bf16_t*)(ws + O_R1)}; pg8::gemm_phase(lds, DM, DM, Sd, E, wave); }
        GRID_SYNC(12);
        { unsigned char* ws = launder_p(p.ws); pg8::SimpleSched Sd{(const char*)(ws + O_R1), (const char*)(ws + OW_F2B), FF, FF, 64, 8, G, bx, 88}; pg8::EpiResid<true> E{(const float*)(ws + O_H), (float*)(ws + O_H), 0.5f, (const float*)(ws + O_ST), p.ln_g + (size_t)(l * 3 + 1) * DM, p.ln_b + (size_t)(l * 3 + 1) * DM}; pg8::gemm_phase(lds, FF, FF, Sd, E, wave); }
        GRID_SYNC(13);
        { unsigned char* ws = launder_p(p.ws); phase_ln((const float*)(ws + O_H), (l == NL - 1) ? p.out : nullptr, (l == NL - 1) ? nullptr : (bf16_t*)(ws + O_HB), (l == NL - 1) ? nullptr : (float*)(ws + O_ST), p.ln_g + (size_t)(l * 3 + 2) * DM, p.ln_b + (size_t)(l * 3 + 2) * DM, wave, lane, G); }
        if (l + 1 < NL) phase_weights(p, l + 1, lds, wave, lane, G);
        GRID_SYNC(14);
    }
}

extern "C" void kernel_launch(void* const* d_in, const int* in_sizes, int n_in, void* d_out, int out_size, void* d_ws, size_t ws_size, hipStream_t stream) {
    static int grid_blocks = 0;
    if (grid_blocks == 0) {
        if (n_in != 18 || ws_size < O_END) { fprintf(stderr, "kernel_launch: unexpected inputs (n_in %d, ws %zu, need %zu)\n", n_in, ws_size, (size_t)O_END); grid_blocks = -1; return; }
        int dev = 0, cus = 0, per_cu = 0;
        hipGetDevice(&dev);
        hipDeviceGetAttribute(&cus, hipDeviceAttributeMultiprocessorCount, dev);
        hipFuncSetAttribute((const void*)fwd_megakernel, hipFuncAttributeMaxDynamicSharedMemorySize, LDS_BYTES);
        hipOccupancyMaxActiveBlocksPerMultiprocessor(&per_cu, (const void*)fwd_megakernel, NTHR, LDS_BYTES);
        if (per_cu < 1) per_cu = 1;
        grid_blocks = cus * 1;
        (void)hipGetLastError();
    }
    if (grid_blocks < 0) return;
    Params p{};
    p.x = (const float*)d_in[0]; p.ln_g = (const float*)d_in[1]; p.ln_b = (const float*)d_in[2]; p.ffn1_w_in = (const float*)d_in[3]; p.ffn1_w_out = (const float*)d_in[4];
    p.w_in = (const float*)d_in[5]; p.pool_w = (const float*)d_in[6]; p.pool_scale = (const float*)d_in[7]; p.swa_sinks = (const float*)d_in[8]; p.mlstm_conv = (const float*)d_in[9];
    p.mlstm_i_bias = (const float*)d_in[10]; p.mlstm_f_bias = (const float*)d_in[11]; p.fox_f_bias = (const float*)d_in[12]; p.w_branch = (const float*)d_in[13]; p.w_gate = (const float*)d_in[14];
    p.w_out = (const float*)d_in[15]; p.ffn2_w_in = (const float*)d_in[16]; p.ffn2_w_out = (const float*)d_in[17]; p.out = (float*)d_out; p.ws = (unsigned char*)d_ws;
    (void)hipMemsetAsync((unsigned char*)d_ws + O_CTL, 0, 16384, stream);
    void* args[] = {&p};
    hipError_t e = hipLaunchCooperativeKernel((const void*)fwd_megakernel, dim3(grid_blocks), dim3(NTHR), args, LDS_BYTES, stream);
    if (e != hipSuccess) fprintf(stderr, "cooperative launch failed: %s (grid %d)\n", hipGetErrorString(e), grid_blocks);
}
```
